# Optimizing an MI355X kernel written in HIP

```python
import math
import jax
import jax.numpy as jnp
from jax import lax
import numpy as np

D_MODEL = 4096
BATCH = 1
SEQ = 8192
DEPTH = 2

MIX_WIDTH = D_MODEL
ATTN_WIDTH = MIX_WIDTH // 2
SSM_WIDTH = MIX_WIDTH - ATTN_WIDTH

HEAD_DIM = 128
N_HEADS = ATTN_WIDTH // HEAD_DIM
N_KV = 4
HEADS_PER_KV = N_HEADS // N_KV
KV_WIDTH = N_KV * HEAD_DIM
ROPE_THETA = 10000.0
CMP_LEN = 32
CMP_STRIDE = 16
SEL_BLOCK = 64
SEL_TOP = 16
WINDOW = 512
Q_BLOCK = 128
BIG = 1e9

SSM_HEAD_DIM = 64
SSM_HEADS = SSM_WIDTH // SSM_HEAD_DIM
SSM_GROUPS = 8
SSM_STATE = 128
CONV_WIDTH = 4
SSD_CHUNK = 256
CONV_DIM = SSM_WIDTH + 2 * SSM_GROUPS * SSM_STATE

D_FF = 4 * D_MODEL
EPS = 1e-5
NEG = -1e30

IN_SPLITS = (ATTN_WIDTH, KV_WIDTH, KV_WIDTH, KV_WIDTH, KV_WIDTH, KV_WIDTH, KV_WIDTH,
             3 * N_HEADS, SSM_WIDTH, CONV_DIM, SSM_HEADS)
IN_COLS = sum(IN_SPLITS)
IN_OFFSETS = tuple(int(v) for v in np.cumsum(IN_SPLITS)[:-1])

kernel_name = "hymba_nsa_ssd_hybrid_trunk"


def rms_norm(x, w):
    xf = x.astype(jnp.float32)
    y = xf * lax.rsqrt(jnp.mean(xf * xf, axis=-1, keepdims=True) + EPS)
    return (y * w.astype(jnp.float32)).astype(x.dtype)


def rope_tables(seq):
    inv = 1.0 / (ROPE_THETA ** (jnp.arange(0, HEAD_DIM, 2, dtype=jnp.float32) / HEAD_DIM))
    ang = jnp.arange(seq, dtype=jnp.float32)[:, None] * inv[None, :]
    ang = jnp.concatenate([ang, ang], axis=-1)
    return jnp.cos(ang), jnp.sin(ang)


def apply_rope(t, cos, sin):
    tf = t.astype(jnp.float32)
    half = HEAD_DIM // 2
    rot = jnp.concatenate([-tf[..., half:], tf[..., :half]], axis=-1)
    return (tf * cos[:, None, :] + rot * sin[:, None, :]).astype(t.dtype)


def masked_softmax(s, mask):
    s = jnp.where(mask, s, NEG)
    m = jnp.max(s, axis=-1, keepdims=True)
    p = jnp.exp(s - m) * mask
    return p / jnp.maximum(jnp.sum(p, axis=-1, keepdims=True), 1e-30)


def compress_blocks(t, pos, w1, w2):
    b, g, s, d = t.shape
    seg = t.reshape(b, g, s // CMP_STRIDE, CMP_STRIDE, d)
    blocks = jnp.concatenate([seg[:, :, :-1], seg[:, :, 1:]], axis=3)
    blocks = blocks + pos
    flat = blocks.reshape(b, g, blocks.shape[2], CMP_LEN * d)
    return jax.nn.silu(flat @ w1) @ w2


def nsa_mixer(q, k_c, v_c, k_s, v_s, k_w, v_w, gate_logits, cmp_pos, cmp_w1, cmp_w2, cos, sin):
    b, s, _ = q.shape
    q = apply_rope(q.reshape(b, s, N_HEADS, HEAD_DIM), cos, sin)
    q = q.reshape(b, s, N_KV, HEADS_PER_KV, HEAD_DIM).transpose(0, 2, 3, 1, 4)

    def heads(t, rope):
        t = t.reshape(b, s, N_KV, HEAD_DIM)
        if rope:
            t = apply_rope(t, cos, sin)
        return t.transpose(0, 2, 1, 3)

    kc = compress_blocks(heads(k_c, True), cmp_pos[0], cmp_w1[0], cmp_w2[0])
    vc = compress_blocks(heads(v_c, False), cmp_pos[1], cmp_w1[1], cmp_w2[1])
    n_cmp = kc.shape[2]
    n_sel = s // SEL_BLOCK
    top = min(SEL_TOP, n_sel)
    ks_blk = heads(k_s, True).reshape(b, N_KV, n_sel, SEL_BLOCK, HEAD_DIM)
    vs_blk = heads(v_s, False).reshape(b, N_KV, n_sel, SEL_BLOCK, HEAD_DIM)
    pad = ((0, 0), (0, 0), (WINDOW, 0), (0, 0))
    kw_pad = jnp.pad(heads(k_w, True), pad)
    vw_pad = jnp.pad(heads(v_w, False), pad)
    gates = jax.nn.sigmoid(gate_logits.astype(jnp.float32))
    gates = gates.reshape(b, s, 3, N_KV, HEADS_PER_KV).transpose(2, 0, 3, 4, 1)

    c_start = jnp.arange(n_cmp) * CMP_STRIDE
    c_end = c_start + CMP_LEN - 1
    j_start = jnp.arange(n_sel) * SEL_BLOCK
    overlap = ((c_start[:, None] < j_start[None, :] + SEL_BLOCK)
               & (c_start[:, None] + CMP_LEN > j_start[None, :])).astype(jnp.float32)
    bi = jnp.arange(b)[:, None, None, None]
    gi = jnp.arange(N_KV)[None, :, None, None]
    blk = jnp.arange(n_sel)[None, :]
    scale = HEAD_DIM ** -0.5

    def one_block(i):
        t0 = i * Q_BLOCK
        tpos = t0 + jnp.arange(Q_BLOCK)
        qb = lax.dynamic_slice_in_dim(q, t0, Q_BLOCK, axis=3)
        gb = lax.dynamic_slice_in_dim(gates, t0, Q_BLOCK, axis=4)
        sc = jnp.einsum('bgrqd,bgcd->bgrqc', qb, kc).astype(jnp.float32) * scale
        pc = masked_softmax(sc, c_end[None, :] <= tpos[:, None])
        o_cmp = jnp.einsum('bgrqc,bgcd->bgrqd', pc.astype(vc.dtype), vc)
        imp = jnp.einsum('bgrqc,cj->bgqj', pc, overlap)
        cur = (tpos // SEL_BLOCK)[:, None]
        forced = (blk == 0) | (blk == cur) | (blk == cur - 1)
        imp = jnp.where(forced, BIG, imp)
        imp = jnp.where(blk > cur, -BIG, imp)
        _, idx = lax.top_k(imp, top)
        ksel = ks_blk[bi, gi, idx].reshape(b, N_KV, Q_BLOCK, top * SEL_BLOCK, HEAD_DIM)
        vsel = vs_blk[bi, gi, idx].reshape(b, N_KV, Q_BLOCK, top * SEL_BLOCK, HEAD_DIM)
        kpos = (idx[..., None] * SEL_BLOCK + jnp.arange(SEL_BLOCK)).reshape(b, N_KV, Q_BLOCK, top * SEL_BLOCK)
        ss = jnp.einsum('bgrqd,bgqkd->bgrqk', qb, ksel).astype(jnp.float32) * scale
        ps = masked_softmax(ss, (kpos <= tpos[None, None, :, None])[:, :, None])
        o_sel = jnp.einsum('bgrqk,bgqkd->bgrqd', ps.astype(vsel.dtype), vsel)
        kwb = lax.dynamic_slice_in_dim(kw_pad, t0, Q_BLOCK + WINDOW, axis=2)
        vwb = lax.dynamic_slice_in_dim(vw_pad, t0, Q_BLOCK + WINDOW, axis=2)
        wpos = t0 - WINDOW + jnp.arange(Q_BLOCK + WINDOW)
        wmask = ((wpos[None, :] <= tpos[:, None]) & (wpos[None, :] > tpos[:, None] - WINDOW)
                 & (wpos[None, :] >= 0))
        sw = jnp.einsum('bgrqd,bgkd->bgrqk', qb, kwb).astype(jnp.float32) * scale
        pw = masked_softmax(sw, wmask)
        o_win = jnp.einsum('bgrqk,bgkd->bgrqd', pw.astype(vwb.dtype), vwb)
        o = gb[0][..., None] * o_cmp + gb[1][..., None] * o_sel + gb[2][..., None] * o_win
        return o.astype(q.dtype)

    out = lax.map(one_block, jnp.arange(s // Q_BLOCK))
    return out.transpose(1, 0, 4, 2, 3, 5).reshape(b, s, ATTN_WIDTH)


def ssd_scan(x, a, bm, cm):
    b, s, h, p = x.shape
    n = bm.shape[-1]
    chunk = math.gcd(s, SSD_CHUNK)
    nc = s // chunk
    r = h // SSM_GROUPS
    x = x.reshape(b, nc, chunk, SSM_GROUPS, r, p)
    a = a.reshape(b, nc, chunk, SSM_GROUPS, r).transpose(0, 3, 4, 1, 2)
    bm = bm.reshape(b, nc, chunk, SSM_GROUPS, n)
    cm = cm.reshape(b, nc, chunk, SSM_GROUPS, n)
    a_cs = jnp.cumsum(a, axis=-1)
    tril = jnp.tril(jnp.ones((chunk, chunk), dtype=bool))
    lmat = jnp.exp(jnp.where(tril, a_cs[..., :, None] - a_cs[..., None, :], -jnp.inf))
    cb = jnp.einsum('bclgn,bcsgn->bcgls', cm, bm)
    y_diag = jnp.einsum('bcgls,bgrcls,bcsgrp->bclgrp', cb, lmat, x)
    decay_states = jnp.exp(a_cs[..., -1:] - a_cs)
    states = jnp.einsum('bcsgn,bgrcs,bcsgrp->cbgrpn', bm, decay_states, x)
    chunk_decay = jnp.exp(a_cs[..., -1]).transpose(3, 0, 1, 2)

    def step(hc, inp):
        st, dec = inp
        return dec[..., None, None] * hc + st, hc

    h0 = jnp.zeros(states.shape[1:], jnp.float32)
    _, prev = lax.scan(step, h0, (states, chunk_decay))
    y_off = jnp.einsum('bclgn,cbgrpn,bgrcl->bclgrp', cm, prev, jnp.exp(a_cs))
    return (y_diag + y_off).reshape(b, s, h, p)


def ssd_mixer(z, xbc, dt, conv_w, conv_b, dt_bias, a_log, d_skip, norm_w):
    b, s, _ = xbc.shape
    xpad = jnp.pad(xbc, ((0, 0), (CONV_WIDTH - 1, 0), (0, 0)))
    conv = conv_b
    for k in range(CONV_WIDTH):
        conv = conv + xpad[:, k:k + s] * conv_w[k]
    xbc = jax.nn.silu(conv)
    xs, bm, cm = jnp.split(xbc, [SSM_WIDTH, SSM_WIDTH + SSM_GROUPS * SSM_STATE], axis=-1)
    xs = xs.reshape(b, s, SSM_HEADS, SSM_HEAD_DIM)
    bm = bm.reshape(b, s, SSM_GROUPS, SSM_STATE)
    cm = cm.reshape(b, s, SSM_GROUPS, SSM_STATE)
    dt = jax.nn.softplus(dt.astype(jnp.float32) + dt_bias.astype(jnp.float32))
    a = -jnp.exp(a_log.astype(jnp.float32))
    y = ssd_scan(xs * dt[..., None], dt * a, bm, cm)
    y = y + d_skip.astype(jnp.float32)[:, None] * xs
    y = y.reshape(b, s, SSM_WIDTH) * jax.nn.silu(z.astype(jnp.float32))
    yg = y.reshape(b, s, SSM_GROUPS, SSM_WIDTH // SSM_GROUPS)
    yg = yg * lax.rsqrt(jnp.mean(yg * yg, axis=-1, keepdims=True) + EPS)
    return (yg.reshape(b, s, SSM_WIDTH) * norm_w.astype(jnp.float32)).astype(z.dtype)


def setup_inputs(seed: int = 0) -> dict:
    key = jax.random.key(seed)
    ks = jax.random.split(key, 20)

    def normal(k, shape, scale):
        return jax.random.normal(k, shape, jnp.float32) * scale

    dt0 = jnp.exp(jax.random.uniform(ks[9], (DEPTH, SSM_HEADS), jnp.float32)
                  * (math.log(0.1) - math.log(0.001)) + math.log(0.001))
    return {
        'x': normal(ks[0], (BATCH, SEQ, D_MODEL), 1.0),
        'norm_mix': 1.0 + normal(ks[1], (DEPTH, D_MODEL), 0.02),
        'w_in': normal(ks[2], (DEPTH, D_MODEL, IN_COLS), D_MODEL ** -0.5),
        'cmp_pos': normal(ks[3], (DEPTH, 2, CMP_LEN, HEAD_DIM), 0.1),
        'cmp_w1': normal(ks[4], (DEPTH, 2, CMP_LEN * HEAD_DIM, HEAD_DIM), (CMP_LEN * HEAD_DIM) ** -0.5),
        'cmp_w2': normal(ks[5], (DEPTH, 2, HEAD_DIM, HEAD_DIM), HEAD_DIM ** -0.5),
        'attn_norm': 1.0 + normal(ks[6], (DEPTH, ATTN_WIDTH), 0.02),
        'conv_w': normal(ks[7], (DEPTH, CONV_WIDTH, CONV_DIM), CONV_WIDTH ** -0.5),
        'conv_b': normal(ks[8], (DEPTH, CONV_DIM), 0.01),
        'dt_bias': dt0 + jnp.log(-jnp.expm1(-dt0)),
        'a_log': jnp.log(jax.random.uniform(ks[10], (DEPTH, SSM_HEADS), jnp.float32, 1.0, 16.0)),
        'd_skip': 1.0 + normal(ks[11], (DEPTH, SSM_HEADS), 0.02),
        'ssm_norm': 1.0 + normal(ks[12], (DEPTH, SSM_WIDTH), 0.02),
        'w_out': normal(ks[13], (DEPTH, MIX_WIDTH, D_MODEL), MIX_WIDTH ** -0.5),
        'norm_mlp': 1.0 + normal(ks[14], (DEPTH, D_MODEL), 0.02),
        'w_up': normal(ks[15], (DEPTH, D_MODEL, D_FF), D_MODEL ** -0.5),
        'w_down': normal(ks[16], (DEPTH, D_FF, D_MODEL), D_FF ** -0.5),
        'norm_final': 1.0 + normal(ks[17], (D_MODEL,), 0.02),
    }


def reference(x, norm_mix, w_in, cmp_pos, cmp_w1, cmp_w2, attn_norm, conv_w, conv_b, dt_bias,
              a_log, d_skip, ssm_norm, w_out, norm_mlp, w_up, w_down, norm_final):
    seq = x.shape[1]
    cos, sin = rope_tables(seq)
    h = x
    for l in range(DEPTH):
        xn = rms_norm(h, norm_mix[l])
        proj = xn @ w_in[l]
        q, k_c, v_c, k_s, v_s, k_w, v_w, g_logits, z, xbc, dt = jnp.split(proj, IN_OFFSETS, axis=-1)
        attn = nsa_mixer(q, k_c, v_c, k_s, v_s, k_w, v_w, g_logits,
                         cmp_pos[l], cmp_w1[l], cmp_w2[l], cos, sin)
        attn = rms_norm(attn, attn_norm[l])
        ssm = ssd_mixer(z, xbc, dt, conv_w[l], conv_b[l], dt_bias[l], a_log[l], d_skip[l], ssm_norm[l])
        h = h + jnp.concatenate([attn, ssm], axis=-1) @ w_out[l]
        hn = rms_norm(h, norm_mlp[l])
        h = h + jnp.square(jax.nn.relu(hn @ w_up[l])) @ w_down[l]
    return rms_norm(h, norm_final)
```

```cpp
#include <hip/hip_runtime.h>
#include <cstdio>
#include <cstdint>
#include <cmath>
namespace pg8 {
#define PG8_LAS __attribute__((address_space(3)))
typedef unsigned short bf16_t;
typedef short bf16x8 __attribute__((ext_vector_type(8)));
typedef float f32x4 __attribute__((ext_vector_type(4)));
typedef unsigned u32x4 __attribute__((ext_vector_type(4)));
constexpr int BM = 256, BK = 64, HALF = 128, HTB = HALF * BK * 2  , STAGE_BYTES = 8 * HTB, NXCD = 8, WGM = 8;

__host__ __device__ __forceinline__ int lds_byte(int r, int c) { const int st = (r >> 4) * 2 + (c >> 5), rr = r & 15, cc = c & 31, ob = rr * 64 + cc * 2; return st * 1024 + (ob ^ (((ob >> 9) & 1) << 5)); }
__host__ __device__ __forceinline__ void stage_rc(int b, int& R, int& C) { const int st = b / 1024, sb = b % 1024, swz = sb ^ (((sb >> 9) & 1) << 5); R = (st >> 1) * 16 + swz / 64; C = (st & 1) * 32 + (swz % 64) / 2; }
__host__ __device__ __forceinline__ int perm32(int rho) { const int n = rho >> 4, i = rho & 15; return 8 * (i >> 2) + 4 * n + (i & 3); }

struct Unit { int pm, pn; };
struct Gemm { const bf16_t* A; const bf16_t* Bt; int M, N, K; };

struct StaticOrder {
    int nM, nN, nwg, G, c;
    __host__ __device__ void init(int M, int N, int G_, int c_) { nM = M / BM; nN = N / BM; nwg = nM * nN; G = G_; c = c_; }
    __host__ __device__ bool next(int i, Unit& u) const {
        const long L = (long)i * G + c; if (L >= nwg) return false;
        int wgid = (int)L; { const int q = nwg / NXCD, r = nwg % NXCD, xcd = wgid % NXCD, off = wgid / NXCD; wgid = (xcd < r ? xcd * (q + 1) : r * (q + 1) + (xcd - r) * q) + off; }
        const int nig = WGM * nN, gid = wgid / nig, fm = gid * WGM, gsz = (nM - fm) < WGM ? (nM - fm) : WGM;
        u.pm = fm + ((wgid % nig) % gsz); u.pn = (wgid % nig) / gsz; return true;
    }
    __device__ __forceinline__ void a_ready(const Unit&) const {}
    __device__ __forceinline__ void done(const Unit&) const {}
};

__device__ __forceinline__ unsigned cvt_pk_bf16(float lo, float hi) { unsigned r; asm volatile("v_cvt_pk_bf16_f32 %0, %1, %2" : "=v"(r) : "v"(lo), "v"(hi)); return r; }
typedef float f32x2 __attribute__((ext_vector_type(2)));
struct EpiProj {
    static constexpr bool PERM = true, AFTER_DRAIN = false;
    bf16_t* O; int ldc; const float* cosT; const float* sinT; float qscale;
    __device__ __forceinline__ void operator()(const f32x4 (&acc)[2][2][4][2], const Unit& u, int wr, int wc, int fr, int fq) const {
        const int row0 = u.pm * BM + wr * 64 + fr; const int colt = u.pn * BM; const int cw = wc * 32 + 8 * fq;
#pragma unroll
        for (int bj = 0; bj < 2; ++bj) {
            const int blk = 2 * u.pn + bj; const bool rope = blk < 16 || (blk < 40 && ((((blk - 16) >> 2) & 1) == 0)); const float sc = blk < 16 ? qscale : 1.f;
#pragma unroll
            for (int ai = 0; ai < 2; ++ai)
#pragma unroll
                for (int m = 0; m < 4; ++m) {
                    const int row = row0 + ai * HALF + m * 16;
                    f32x4 v0 = acc[ai][bj][m][0], v1 = acc[ai][bj][m][1];
                    if (rope) {
                        const f32x4 c4 = *(const f32x4*)(cosT + (size_t)row * 64 + (cw >> 1)), s4 = *(const f32x4*)(sinT + (size_t)row * 64 + (cw >> 1));
                        f32x4 r0, r1;
                        r0[0] = v0[0] * c4[0] - v0[1] * s4[0]; r0[1] = v0[1] * c4[0] + v0[0] * s4[0];
                        r0[2] = v0[2] * c4[1] - v0[3] * s4[1]; r0[3] = v0[3] * c4[1] + v0[2] * s4[1];
                        r1[0] = v1[0] * c4[2] - v1[1] * s4[2]; r1[1] = v1[1] * c4[2] + v1[0] * s4[2];
                        r1[2] = v1[2] * c4[3] - v1[3] * s4[3]; r1[3] = v1[3] * c4[3] + v1[2] * s4[3];
                        v0 = r0; v1 = r1;
                    }
                    v0 = v0 * sc; v1 = v1 * sc;
                    u32x4 w; w.x = cvt_pk_bf16(v0[0], v0[1]); w.y = cvt_pk_bf16(v0[2], v0[3]); w.z = cvt_pk_bf16(v1[0], v1[1]); w.w = cvt_pk_bf16(v1[2], v1[3]);
                    *(u32x4*)(O + (size_t)row * ldc + colt + bj * HALF + cw) = w;
                }
        }
    }
};
struct EpiResid {
    static constexpr bool PERM = false, AFTER_DRAIN = false;
    const float* base; float* out; int ldc;
    __device__ __forceinline__ void operator()(const f32x4 (&acc)[2][2][4][2], const Unit& u, int wr, int wc, int fr, int fq) const {
        const int row0 = u.pm * BM + wr * 64 + fr, col0 = u.pn * BM + wc * 32 + 4 * fq;
#pragma unroll
        for (int ai = 0; ai < 2; ++ai)
#pragma unroll
            for (int m = 0; m < 4; ++m) { const size_t off = (size_t)(row0 + ai * HALF + m * 16) * ldc + col0;
#pragma unroll
                for (int bj = 0; bj < 2; ++bj)
#pragma unroll
                    for (int n = 0; n < 2; ++n) { const f32x4 b = *(const f32x4*)(base + off + bj * HALF + n * 16); *(f32x4*)(out + off + bj * HALF + n * 16) = b + acc[ai][bj][m][n]; } }
    }
};
struct EpiRelu2 {
    static constexpr bool PERM = true, AFTER_DRAIN = false;
    bf16_t* O; int ldc;
    __device__ __forceinline__ void operator()(const f32x4 (&acc)[2][2][4][2], const Unit& u, int wr, int wc, int fr, int fq) const {
        const int row0 = u.pm * BM + wr * 64 + fr; const int col0 = u.pn * BM + wc * 32 + 8 * fq;
#pragma unroll
        for (int ai = 0; ai < 2; ++ai)
#pragma unroll
            for (int m = 0; m < 4; ++m) { bf16_t* rowp = O + (size_t)(row0 + ai * HALF + m * 16) * ldc + col0;
#pragma unroll
                for (int bj = 0; bj < 2; ++bj) { f32x4 v0 = acc[ai][bj][m][0], v1 = acc[ai][bj][m][1];
#pragma unroll
                    for (int e = 0; e < 4; ++e) { const float a = fmaxf(v0[e], 0.f), b = fmaxf(v1[e], 0.f); v0[e] = a * a; v1[e] = b * b; }
                    u32x4 w; w.x = cvt_pk_bf16(v0[0], v0[1]); w.y = cvt_pk_bf16(v0[2], v0[3]); w.z = cvt_pk_bf16(v1[0], v1[1]); w.w = cvt_pk_bf16(v1[2], v1[3]);
                    *(u32x4*)(rowp + bj * HALF) = w; } }
    }
};

template <class Epi, class Sched, bool ALIGN_EPI = false, bool SP2 = false>
__device__ __forceinline__ void gemm_phase(PG8_LAS unsigned char* lds, const Gemm g, const Sched& S, const Epi& E) {
    int tid_o = threadIdx.x; asm volatile("" : "+v"(tid_o));
    const int tid = tid_o, wid = __builtin_amdgcn_readfirstlane(tid >> 6), lane = tid & 63, wr = wid >> 2, wc = wid & 3, fr = lane & 15, fq = lane >> 4;
    const int K = g.K, nt = K / BK;
    unsigned voffA[2], voffB[2];
#pragma unroll
    for (int i = 0; i < 2; ++i) { int R, C; stage_rc(tid * 16 + i * 8192, R, C); const int Rb = Epi::PERM ? ((R & ~31) + perm32(R & 31)) : R;
        voffA[i] = (unsigned)(R * K + C) * 2u; voffB[i] = (unsigned)(Rb * K + C) * 2u; }
    const size_t kstep = (size_t)(BK * 2);
    const size_t hstep = (size_t)HALF * K * 2;
    const size_t tstep = 2 * hstep;
    const unsigned ldsw = (unsigned)wid * 1024u;
    const int aoff = lds_byte(wr * 64 + fr, fq * 8), boff = lds_byte(wc * 32 + fr, fq * 8);
#define PG8_SA(b, h) (((b) * 2 + (h)) * HTB)
#define PG8_SB(b, h) ((4 + (b) * 2 + (h)) * HTB)
#define PG8_STAGE(bufoff, gbase, voff) do { _Pragma("unroll") for (int _i = 0; _i < 2; ++_i) \
        __builtin_amdgcn_global_load_lds((const unsigned*)((const char*)(gbase) + (voff)[_i]), (PG8_LAS unsigned*)(lds + (bufoff) + ldsw + _i * 8192), 16, 0, 0); } while (0)
#define PG8_LDA(dst, b, h) do { _Pragma("unroll") for (int m = 0; m < 4; ++m) _Pragma("unroll") for (int k = 0; k < 2; ++k) dst[m][k] = *(const PG8_LAS bf16x8*)(lds + PG8_SA(b, h) + aoff + m * 2048 + k * 1024); } while (0)
#define PG8_LDB(dst, b, h) do { _Pragma("unroll") for (int n = 0; n < 2; ++n) _Pragma("unroll") for (int k = 0; k < 2; ++k) dst[n][k] = *(const PG8_LAS bf16x8*)(lds + PG8_SB(b, h) + boff + n * 2048 + k * 1024); } while (0)
#define PG8_MMA(ai, bj, At, Bt) do { __builtin_amdgcn_s_setprio(1); _Pragma("unroll") for (int m = 0; m < 4; ++m) _Pragma("unroll") for (int n = 0; n < 2; ++n) _Pragma("unroll") for (int k = 0; k < 2; ++k) \
        acc[ai][bj][m][n] = __builtin_amdgcn_mfma_f32_16x16x32_bf16(Bt[n][k], At[m][k], acc[ai][bj][m][n], 0, 0, 0); __builtin_amdgcn_s_setprio(0); } while (0)
#define PG8_WAIT_V(n) asm volatile("s_waitcnt vmcnt(" #n ")" ::: "memory")
#define PG8_WAIT_L(n) asm volatile("s_waitcnt lgkmcnt(" #n ")" ::: "memory")
#define PG8_BAR __builtin_amdgcn_s_barrier()
#define PG8_SCHED __builtin_amdgcn_sched_barrier(0)
    Unit cur, nxt; int ui = 0;
    if (!S.next(0, cur)) return;
    f32x4 acc[2][2][4][2];
#pragma unroll
    for (int a = 0; a < 2; ++a)
#pragma unroll
        for (int b = 0; b < 2; ++b)
#pragma unroll
            for (int m = 0; m < 4; ++m)
#pragma unroll
                for (int n = 0; n < 2; ++n) acc[a][b][m][n] = (f32x4){0.f, 0.f, 0.f, 0.f};
    bf16x8 At[4][2], B0[2][2], B1[2][2];
    const char* cA = (const char*)g.A + (size_t)cur.pm * tstep; const char* cB = (const char*)g.Bt + (size_t)cur.pn * tstep;
    S.a_ready(cur);
    if constexpr (SP2) {
        PG8_STAGE(PG8_SB(0, 0), cB, voffB); PG8_STAGE(PG8_SB(0, 1), cB + hstep, voffB); PG8_STAGE(PG8_SA(0, 0), cA, voffA); PG8_STAGE(PG8_SA(0, 1), cA + hstep, voffA);
        if (wr == 1) PG8_BAR;
        PG8_WAIT_V(2); PG8_BAR;
        PG8_STAGE(PG8_SB(1, 0), cB + kstep, voffB); PG8_STAGE(PG8_SA(1, 0), cA + kstep, voffA); PG8_STAGE(PG8_SB(1, 1), cB + hstep + kstep, voffB);
        PG8_WAIT_V(6); PG8_BAR;
    } else {
        PG8_STAGE(PG8_SB(0, 0), cB, voffB); PG8_STAGE(PG8_SA(0, 0), cA, voffA); PG8_STAGE(PG8_SB(0, 1), cB + hstep, voffB); PG8_STAGE(PG8_SA(0, 1), cA + hstep, voffA);
        if (wr == 1) PG8_BAR;
        PG8_WAIT_V(4); PG8_BAR;
        PG8_STAGE(PG8_SB(1, 0), cB + kstep, voffB); PG8_STAGE(PG8_SA(1, 0), cA + kstep, voffA); PG8_STAGE(PG8_SB(1, 1), cB + hstep + kstep, voffB);
        PG8_WAIT_V(6); PG8_BAR;
    }
    for (;;) {
        const bool has_next = S.next(ui + 1, nxt);
        const char* nA = has_next ? (const char*)g.A + (size_t)nxt.pm * tstep : cA; const char* nB = has_next ? (const char*)g.Bt + (size_t)nxt.pn * tstep : cB;
        for (int t = 0; t < nt; t += 2) {
            const bool last = (t == nt - 2);
            const char* a1 = cA + (size_t)(t + 1) * kstep;
            const char* a2 = last ? nA : cA + (size_t)(t + 2) * kstep; const char* b2 = last ? nB : cB + (size_t)(t + 2) * kstep;
            const char* a3 = a2 + kstep; const char* b3 = b2 + kstep;
            if (last && has_next) S.a_ready(nxt);
            if constexpr (SP2) {
            PG8_LDB(B0, 0, 0); PG8_LDB(B1, 0, 1); PG8_SCHED; PG8_LDA(At, 0, 0); PG8_STAGE(PG8_SA(1, 1), a1 + hstep, voffA);
            PG8_WAIT_V(8); PG8_WAIT_L(0); PG8_BAR; PG8_MMA(0, 0, At, B0); PG8_MMA(0, 1, At, B1); PG8_BAR; PG8_SCHED;
            PG8_LDA(At, 0, 1); PG8_STAGE(PG8_SB(0, 0), b2, voffB); PG8_STAGE(PG8_SB(0, 1), b2 + hstep, voffB); PG8_STAGE(PG8_SA(0, 0), a2, voffA);
            PG8_WAIT_V(8); PG8_WAIT_L(0); PG8_BAR; PG8_MMA(1, 0, At, B0); PG8_MMA(1, 1, At, B1); PG8_BAR; PG8_SCHED;
            PG8_LDB(B0, 1, 0); PG8_LDB(B1, 1, 1); PG8_SCHED; PG8_LDA(At, 1, 0); PG8_STAGE(PG8_SA(0, 1), a2 + hstep, voffA);
            PG8_WAIT_V(8); PG8_WAIT_L(0); PG8_BAR; PG8_MMA(0, 0, At, B0); PG8_MMA(0, 1, At, B1); PG8_BAR; PG8_SCHED;
            PG8_LDA(At, 1, 1); PG8_STAGE(PG8_SB(1, 0), b3, voffB); PG8_STAGE(PG8_SB(1, 1), b3 + hstep, voffB); PG8_STAGE(PG8_SA(1, 0), a3, voffA);
            PG8_WAIT_V(8); PG8_WAIT_L(0); PG8_BAR; PG8_MMA(1, 0, At, B0); PG8_MMA(1, 1, At, B1); PG8_BAR; PG8_SCHED;
            } else {
            PG8_LDB(B0, 0, 0); PG8_SCHED; PG8_LDA(At, 0, 0); PG8_STAGE(PG8_SA(1, 1), a1 + hstep, voffA);
            PG8_WAIT_L(8); PG8_BAR; PG8_WAIT_L(0); PG8_MMA(0, 0, At, B0); PG8_BAR; PG8_SCHED;
            PG8_LDB(B1, 0, 1); PG8_STAGE(PG8_SB(0, 0), b2, voffB);
            PG8_BAR; PG8_WAIT_L(0); PG8_MMA(0, 1, At, B1); PG8_BAR;
            PG8_LDA(At, 0, 1); PG8_STAGE(PG8_SA(0, 0), a2, voffA);
            PG8_BAR; PG8_WAIT_L(0); PG8_MMA(1, 0, At, B0); PG8_BAR; PG8_SCHED;
            PG8_STAGE(PG8_SB(0, 1), b2 + hstep, voffB);
            PG8_WAIT_V(6); PG8_BAR; PG8_MMA(1, 1, At, B1); PG8_BAR;
            PG8_LDB(B0, 1, 0); PG8_SCHED; PG8_LDA(At, 1, 0); PG8_STAGE(PG8_SA(0, 1), a2 + hstep, voffA);
            PG8_WAIT_L(8); PG8_BAR; PG8_WAIT_L(0); PG8_MMA(0, 0, At, B0); PG8_BAR; PG8_SCHED;
            PG8_LDB(B1, 1, 1); PG8_STAGE(PG8_SB(1, 0), b3, voffB);
            PG8_BAR; PG8_WAIT_L(0); PG8_MMA(0, 1, At, B1); PG8_BAR;
            PG8_LDA(At, 1, 1); PG8_STAGE(PG8_SA(1, 0), a3, voffA);
            PG8_BAR; PG8_WAIT_L(0); PG8_MMA(1, 0, At, B0); PG8_BAR; PG8_SCHED;
            PG8_STAGE(PG8_SB(1, 1), b3 + hstep, voffB);
            PG8_WAIT_V(6); PG8_BAR; PG8_MMA(1, 1, At, B1); PG8_BAR;
            }
        }
        if constexpr (ALIGN_EPI) { if (wr == 0) PG8_BAR; }
        if constexpr (!Epi::AFTER_DRAIN) { E(acc, cur, wr, wc, fr, fq); S.done(cur); }
        if (!has_next) break;
#pragma unroll
        for (int a = 0; a < 2; ++a)
#pragma unroll
            for (int b = 0; b < 2; ++b)
#pragma unroll
                for (int m = 0; m < 4; ++m)
#pragma unroll
                    for (int n = 0; n < 2; ++n) acc[a][b][m][n] = (f32x4){0.f, 0.f, 0.f, 0.f};
        cur = nxt; cA = nA; cB = nB; ++ui;
        if constexpr (ALIGN_EPI) { if (wr == 1) PG8_BAR; }
    }
    PG8_WAIT_V(0);
    if constexpr (!ALIGN_EPI) { if (wr == 0) PG8_BAR; }
    PG8_BAR;
    if constexpr (Epi::AFTER_DRAIN) { E.fused(acc, cur, wr, wc, fr, fq, lds, wid, lane); S.done(cur); }
#undef PG8_SA
#undef PG8_SB
#undef PG8_STAGE
#undef PG8_LDA
#undef PG8_LDB
#undef PG8_MMA
#undef PG8_WAIT_V
#undef PG8_WAIT_L
#undef PG8_BAR
#undef PG8_SCHED
}
}

constexpr int NWAVES = 8;
constexpr int S = 8192, DM = 4096, FF = 16384, DEPTH = 2;
constexpr int NSRC = 11344, NPROJ = 11520;
constexpr int OFF_Q = 0, OFF_KC = 2048, OFF_VC = 2560, OFF_KS = 3072, OFF_VS = 3584, OFF_KW = 4096, OFF_VW = 4608, OFF_Z = 5120, OFF_XBC = 7168, OFF_G = 11264, OFF_DT = 11312;
constexpr int NH = 16, NKV = 4, HD = 128, NCMP = 511, NSEL = 128, SELTOP = 16, WIN = 512;
constexpr int SSM_W = 2048, SSM_H = 32, SSM_P = 64, SSM_G = 8, SSM_N = 128, CONVD = 4096, CHUNK = 256, NCHUNK = S / CHUNK;
constexpr float EPS = 1e-5f;
constexpr float QSCALE = 0.08838834764831845f * 1.4426950408889634f;

constexpr size_t MiB = 1u << 20;
constexpr size_t WS_CTL = 0, CTL_ZERO_BYTES = 1 * MiB;
constexpr size_t SZ_WIN = (size_t)NPROJ * DM * 2, SZ_WO = (size_t)DM * DM * 2, SZ_WUP = (size_t)FF * DM * 2, SZ_WDN = (size_t)DM * FF * 2;
constexpr size_t WS_WIN = 2 * MiB;
constexpr size_t WS_WO = WS_WIN + DEPTH * SZ_WIN;
constexpr size_t WS_WUP = WS_WO + DEPTH * SZ_WO;
constexpr size_t WS_WDN = WS_WUP + DEPTH * SZ_WUP;
constexpr size_t WS_H = WS_WDN + DEPTH * SZ_WDN;
constexpr size_t WS_XN = WS_H + (size_t)S * DM * 4;
constexpr size_t WS_PROJ = WS_XN + (size_t)S * DM * 2;
constexpr size_t WS_ACT = WS_PROJ + (size_t)S * NPROJ * 2;
constexpr size_t WS_CAT = WS_ACT + (size_t)S * FF * 2;
constexpr size_t WS_ATT = WS_CAT + (size_t)S * DM * 2;
constexpr size_t WS_XBC = WS_ATT + (size_t)S * 2048 * 4;
constexpr size_t WS_Y = WS_XBC + (size_t)S * CONVD * 2;
constexpr size_t WS_ST = WS_Y + (size_t)S * 2048 * 4;
constexpr size_t WS_PREV = WS_ST + (size_t)NCHUNK * SSM_H * SSM_P * SSM_N * 4;
constexpr size_t WS_KC = WS_PREV + (size_t)NCHUNK * SSM_H * SSM_P * SSM_N * 4;
constexpr size_t WS_VC = WS_KC + (size_t)NKV * 512 * HD * 2;
constexpr size_t WS_DT = WS_VC + (size_t)NKV * 512 * HD * 2;
constexpr size_t WS_ADT = WS_DT + (size_t)S * 32 * 4;
constexpr size_t WS_COS = WS_ADT + (size_t)S * 32 * 4;
constexpr size_t WS_SIN = WS_COS + (size_t)S * 64 * 4;
constexpr size_t WS_BMP = WS_SIN + (size_t)S * 64 * 4;
constexpr size_t WS_END = WS_BMP + (size_t)S * 16 * 4;
constexpr int CW_BAR = 4096;

constexpr int RING_OFF = 0, RING_BYTES = 131072;
constexpr int LDSCTL_OFF = RING_BYTES, MISC_OFF = LDSCTL_OFF + 320;
constexpr int LDS_BYTES = 147456;

#define GAS __attribute__((address_space(1)))
#define LAS __attribute__((address_space(3)))
typedef unsigned short bf16;
typedef unsigned v4u __attribute__((ext_vector_type(4)));
typedef float f32x4 __attribute__((ext_vector_type(4)));
typedef short bf16x8 __attribute__((ext_vector_type(8)));
typedef GAS unsigned gu32;
typedef GAS unsigned long long gu64;
#define RLX_AGENT __ATOMIC_RELAXED, __HIP_MEMORY_SCOPE_AGENT
#define LDS_WAIT() asm volatile("s_waitcnt lgkmcnt(0)" ::: "memory")
#define VM_WAIT() asm volatile("s_waitcnt vmcnt(0)" ::: "memory")
__device__ __forceinline__ unsigned long long rt() { return __builtin_amdgcn_s_memrealtime(); }
__device__ __forceinline__ unsigned f2bf(float f) { unsigned u = __builtin_bit_cast(unsigned, f); return (u + 0x7fffu + ((u >> 16) & 1u)) >> 16; }
__device__ __forceinline__ unsigned pk2(float lo, float hi) { return f2bf(lo) | (f2bf(hi) << 16); }

#define XB_TMO      128
#define XB_XCNT(j)  (256  + 64 * (j))
#define XB_XSUB(j)  (1280 + 64 * (j))
#define XB_XGEN(j)  (2304 + 64 * (j))
#define XB_TOP      3328
#define XB_TOPGEN   3392
#define XCD_BAR_WORDS 3456
#define XB_SPIN_CAP (1u << 18)

__device__ __forceinline__ unsigned xb_ld(unsigned* p)              { return __hip_atomic_load(p, __ATOMIC_RELAXED, __HIP_MEMORY_SCOPE_AGENT); }
__device__ __forceinline__ unsigned xb_add(unsigned* p, unsigned v) { return __hip_atomic_fetch_add(p, v, __ATOMIC_RELAXED, __HIP_MEMORY_SCOPE_AGENT); }
__device__ __forceinline__ unsigned xb_xcc_id() { return (unsigned)__builtin_amdgcn_s_getreg((3 << 11) | 20) & 0xFu; }
#define XB_SPIN(cond, bar) do { unsigned _sp = 0; while (cond) { __builtin_amdgcn_s_sleep(1); \
    if ((++_sp & 255u) == 0u) { if (xb_ld(&(bar)[XB_TMO])) break; if (_sp > XB_SPIN_CAP) { atomicAdd(&(bar)[XB_TMO], 1u); break; } } } } while (0)

struct XcdBarrier {
    unsigned* bar; unsigned x;
    volatile LAS unsigned* st;
};

__device__ __forceinline__ XcdBarrier xcd_barrier_post(unsigned* bar, volatile LAS unsigned* st) {
    XcdBarrier b; b.bar = bar; b.x = xb_xcc_id(); b.st = st;
    if (threadIdx.x == 0) (void)xb_add(&bar[XB_XCNT(b.x)], 1u);
    return b;
}
__device__ __forceinline__ void xcd_barrier_complete(unsigned* bar, unsigned x, unsigned& nloc, unsigned& nx) {
    const unsigned G = gridDim.x * gridDim.y * gridDim.z;
    unsigned sum, cnt, mine, sp = 0u;
    for (;;) {
        sum = 0u; cnt = 0u; mine = 0u;
#pragma unroll
        for (unsigned j = 0; j < 16; ++j) { const unsigned c = xb_ld(&bar[XB_XCNT(j)]); sum += c; cnt += (c > 0u) ? 1u : 0u; mine = (j == x) ? c : mine; }
        if (sum == G) break;
        __builtin_amdgcn_s_sleep(1);
        if ((++sp & 255u) == 0u) { if (xb_ld(&bar[XB_TMO])) break; if (sp > XB_SPIN_CAP) { atomicAdd(&bar[XB_TMO], 1u); break; } }
    }
    nloc = mine > 0u ? mine : 1u; nx = cnt > 0u ? cnt : 1u;
}

__device__ __forceinline__ void xcd_barrier(const XcdBarrier& b) {
    asm volatile("s_waitcnt vmcnt(0)" ::: "memory");
    __syncthreads();
    if (threadIdx.x == 0) {
        unsigned* bar = b.bar;
        __builtin_amdgcn_s_waitcnt(0);
        unsigned nloc = b.st[0], nx = b.st[1];
        if (nloc == 0u) { xcd_barrier_complete(bar, b.x, nloc, nx); b.st[0] = nloc; b.st[1] = nx; }
        const unsigned old = xb_add(&bar[XB_XSUB(b.x)], 1u);
        const unsigned gen = old / nloc;
        if (old + 1u == (gen + 1u) * nloc) {
            __builtin_amdgcn_fence(__ATOMIC_RELEASE, "agent");
            asm volatile("s_waitcnt vmcnt(0)" ::: "memory");
            const unsigned og = xb_add(&bar[XB_TOP], 1u);
            const unsigned tg = og / nx;
            if (og + 1u == (tg + 1u) * nx) xb_add(&bar[XB_TOPGEN], 1u);
            else XB_SPIN(xb_ld(&bar[XB_TOPGEN]) == tg, bar);
            __builtin_amdgcn_fence(__ATOMIC_ACQUIRE, "agent");
            xb_add(&bar[XB_XGEN(b.x)], 1u);
            asm volatile("s_waitcnt vmcnt(0)" ::: "memory");
        } else {
            XB_SPIN(xb_ld(&bar[XB_XGEN(b.x)]) == gen, bar);
            __builtin_amdgcn_fence(__ATOMIC_ACQUIRE, "agent");
            asm volatile("s_waitcnt vmcnt(0)" ::: "memory");
        }
    }
    __syncthreads();
}


__device__ __forceinline__ float bf2f(unsigned short b) { return __builtin_bit_cast(float, (unsigned)b << 16); }
__device__ __forceinline__ float bflo(unsigned w) { return __builtin_bit_cast(float, w << 16); }
__device__ __forceinline__ float bfhi(unsigned w) { return __builtin_bit_cast(float, w & 0xffff0000u); }
__device__ __forceinline__ float wave_sum(float v) {
#pragma unroll
    for (int o = 1; o < 64; o <<= 1) v += __shfl_xor(v, o);
    return v;
}
__device__ __forceinline__ float wave_max(float v) {
#pragma unroll
    for (int o = 1; o < 64; o <<= 1) v = fmaxf(v, __shfl_xor(v, o));
    return v;
}

struct Frame {
    LAS unsigned char* lds;
    volatile LAS unsigned* MISC;
    gu32* ctl;
    int tid, lane, wave;
    int vcu, G;
};

__device__ __forceinline__ int src_col_in(int c) {
    if (c < 5120) { const int blk = c >> 7, p = c & 127; const bool rope = blk < 16 || ((((blk - 16) >> 2) & 1) == 0); const int d = rope ? (p >> 1) + 64 * (p & 1) : p; return blk * 128 + d; }
    if (c < OFF_G) return c + 48;
    if (c < OFF_DT) return 5120 + (c - OFF_G);
    if (c < NSRC) return c;
    return -1;
}
template <bool MAP, bool KS>
__device__ __forceinline__ void p0_transpose_item(const float* W, int K, int Nsrc, int nblk, bf16* WT, const float* ksA, const float* ksB, int ksplit, LAS float* scr, int item, int lane) {
    const int kb = item / nblk, nb = item % nblk, k0 = 64 * kb, n0 = 32 * nb;
    const int nr = n0 + (lane & 31); const int sc = MAP ? src_col_in(nr) : nr;
#pragma unroll 8
    for (int i = 0; i < 32; ++i) { const int kk = 2 * i + (lane >> 5); const int k = k0 + kk;
        float v = sc >= 0 ? W[(size_t)k * Nsrc + sc] : 0.f;
        if (KS) v *= (k < ksplit ? ksA[k] : ksB[k - ksplit]);
        scr[kk * 33 + (lane & 31)] = v; }
    LDS_WAIT(); asm volatile("" ::: "memory");
    const int c = lane & 7;
#pragma unroll
    for (int j = 0; j < 4; ++j) { const int n = (lane >> 3) + 8 * j; const LAS float* s = scr + (8 * c) * 33 + n;
        v4u o; o.x = pk2(s[0 * 33], s[1 * 33]); o.y = pk2(s[2 * 33], s[3 * 33]); o.z = pk2(s[4 * 33], s[5 * 33]); o.w = pk2(s[6 * 33], s[7 * 33]);
        *(GAS v4u*)(WT + (size_t)(n0 + n) * K + k0 + 8 * c) = o; }
    LDS_WAIT(); asm volatile("" ::: "memory");
}

__device__ __forceinline__ void rms_row_to_bf16(const float* xrow, bf16* orow, int lane) {
    const GAS f32x4* xr = (const GAS f32x4*)xrow + lane;
    f32x4 v[16]; float s = 0.f;
#pragma unroll
    for (int j = 0; j < 16; ++j) { v[j] = xr[64 * j]; s += (v[j].x * v[j].x + v[j].y * v[j].y) + (v[j].z * v[j].z + v[j].w * v[j].w); }
    const float rstd = 1.f / sqrtf(wave_sum(s) * (1.f / DM) + EPS);
    GAS unsigned long long* o8 = (GAS unsigned long long*)orow + lane;
#pragma unroll
    for (int j = 0; j < 16; ++j) o8[64 * j] = (unsigned long long)pk2(v[j].x * rstd, v[j].y * rstd) | ((unsigned long long)pk2(v[j].z * rstd, v[j].w * rstd) << 32);
}

struct Args { const float* in[18]; float* out; unsigned char* ws; };


struct KeyCmp { int nv; __device__ __forceinline__ int operator()(int c, int k) const { const int i = 64 * c + k; return i < nv ? i : -1; } };
struct KeySel { const LAS int* blks; int t; __device__ __forceinline__ int operator()(int c, int k) const { const int b = blks[c]; const int key = b * 64 + k; return (b >= 0 && key <= t) ? key : -1; } };
struct KeyWin { int t; __device__ __forceinline__ int operator()(int c, int k) const { const int key = t - (WIN - 1) + 64 * c + k; return key >= 0 ? key : -1; } };
template <class KeyFn>
__device__ __forceinline__ void attend_scalar(const KeyFn& keyfn, int nch, const bf16* Kb, const bf16* Vb, int ld, LAS float* sc, const LAS float* qs, int lane, float (&o)[4][2], float (&l)[4]) {
    float m[4] = {-INFINITY, -INFINITY, -INFINITY, -INFINITY};
    for (int c = 0; c < nch; ++c) {
        const int idx = keyfn(c, lane); float a[4] = {0.f, 0.f, 0.f, 0.f};
        if (idx >= 0) { const GAS v4u* kr = (const GAS v4u*)(Kb + (size_t)idx * ld);
            for (int kk = 0; kk < 16; ++kk) { const v4u w = kr[kk]; float f[8] = {bflo(w.x), bfhi(w.x), bflo(w.y), bfhi(w.y), bflo(w.z), bfhi(w.z), bflo(w.w), bfhi(w.w)};
#pragma unroll
                for (int r = 0; r < 4; ++r) { const LAS float* q = qs + r * 128 + kk * 8;
#pragma unroll
                    for (int j = 0; j < 8; ++j) a[r] += f[j] * q[j]; } } }
#pragma unroll
        for (int r = 0; r < 4; ++r) { const float s = idx >= 0 ? a[r] : -INFINITY; sc[r * 1024 + c * 64 + lane] = s; m[r] = fmaxf(m[r], s); }
    }
    float ls[4];
#pragma unroll
    for (int r = 0; r < 4; ++r) { m[r] = wave_max(m[r]); if (m[r] == -INFINITY) m[r] = 0.f; ls[r] = 0.f; }
    for (int c = 0; c < nch; ++c)
#pragma unroll
        for (int r = 0; r < 4; ++r) { const float p = exp2f(sc[r * 1024 + c * 64 + lane] - m[r]); sc[r * 1024 + c * 64 + lane] = p; ls[r] += p; }
#pragma unroll
    for (int r = 0; r < 4; ++r) { l[r] = wave_sum(ls[r]); o[r][0] = 0.f; o[r][1] = 0.f; }
    LDS_WAIT(); asm volatile("" ::: "memory");
    for (int c = 0; c < nch; ++c)
        for (int k = 0; k < 64; ++k) { const int ik = keyfn(c, k);
            if (ik >= 0) { const unsigned w = *(const GAS unsigned*)(Vb + (size_t)ik * ld + 2 * lane); const float f0 = bflo(w), f1 = bfhi(w);
#pragma unroll
                for (int r = 0; r < 4; ++r) { const float p = sc[r * 1024 + c * 64 + k]; o[r][0] += p * f0; o[r][1] += p * f1; } } }
}

__global__ void __launch_bounds__(NWAVES * 64, 2) hybrid_fwd(Args args) {
    extern __shared__ __attribute__((aligned(16))) unsigned char lds[];
    Frame F;
    F.lds = (LAS unsigned char*)lds;
    F.MISC = (volatile LAS unsigned*)(F.lds + MISC_OFF);
    F.tid = threadIdx.x; F.lane = F.tid & 63; F.wave = __builtin_amdgcn_readfirstlane(F.tid >> 6);
    F.G = gridDim.x; { const int bx = blockIdx.x; F.vcu = (F.G % 8 == 0) ? (bx % 8) * (F.G / 8) + bx / 8 : bx; }
    unsigned char* ws = args.ws;
    F.ctl = (gu32*)(ws + WS_CTL);
    for (int u = F.tid; u < (LDS_BYTES - LDSCTL_OFF) / 4; u += NWAVES * 64) ((LAS unsigned*)(F.lds + LDSCTL_OFF))[u] = 0u;
    __syncthreads();
    (void)xcd_barrier_post((unsigned*)(F.ctl + CW_BAR), F.MISC + 8);
#define GRID_BAR() do { unsigned char* wsb_ = args.ws; asm volatile("" : "+s"(wsb_)); XcdBarrier b_; b_.bar = (unsigned*)((gu32*)(wsb_ + WS_CTL) + CW_BAR); b_.x = xb_xcc_id(); b_.st = (volatile LAS unsigned*)(F.lds + MISC_OFF) + 8; xcd_barrier(b_); } while (0)
#define PHASE_IDS() int tid_l_ = threadIdx.x; asm volatile("" : "+v"(tid_l_)); const int tid = tid_l_, lane = tid & 63, wave = __builtin_amdgcn_readfirstlane(tid >> 6); \
    const int gw = F.vcu * NWAVES + wave, NGW = F.G * NWAVES, gt = F.vcu * (NWAVES * 64) + tid, NGT = F.G * NWAVES * 64; (void)gw; (void)NGW; (void)gt; (void)NGT; (void)lane

    const float* x_in = args.in[0];
    bf16* XN = (bf16*)(ws + WS_XN); float* COS = (float*)(ws + WS_COS); float* SIN = (float*)(ws + WS_SIN);
    {
        PHASE_IDS();
        LAS float* scr = (LAS float*)(F.lds + RING_OFF + wave * 16384);
        constexpr int I_IN = (DM / 64) * (NPROJ / 32), I_O = (DM / 64) * (DM / 32), I_UP = (DM / 64) * (FF / 32), I_DN = (FF / 64) * (DM / 32);
        constexpr int I_L = I_IN + I_O + I_UP + I_DN;
        for (int it = gw; it < DEPTH * I_L; it += NGW) {
            const int l = it / I_L; int r = it % I_L;
            if (r < I_IN) { p0_transpose_item<true, true>(args.in[2] + (size_t)l * DM * NSRC, DM, NSRC, NPROJ / 32, (bf16*)(ws + WS_WIN + l * SZ_WIN), args.in[1] + l * DM, args.in[1] + l * DM, DM, scr, r, lane); continue; } r -= I_IN;
            if (r < I_O) { p0_transpose_item<false, true>(args.in[13] + (size_t)l * DM * DM, DM, DM, DM / 32, (bf16*)(ws + WS_WO + l * SZ_WO), args.in[6] + l * 2048, args.in[12] + l * 2048, 2048, scr, r, lane); continue; } r -= I_O;
            if (r < I_UP) { p0_transpose_item<false, true>(args.in[15] + (size_t)l * DM * FF, DM, FF, FF / 32, (bf16*)(ws + WS_WUP + l * SZ_WUP), args.in[14] + l * DM, args.in[14] + l * DM, DM, scr, r, lane); continue; } r -= I_UP;
            p0_transpose_item<false, false>(args.in[16] + (size_t)l * FF * DM, FF, DM, DM / 32, (bf16*)(ws + WS_WDN + l * SZ_WDN), args.in[16], args.in[16], 0, scr, r, lane);
        }
        for (int e = gt; e < S * 64; e += NGT) { const int t = e >> 6, i = e & 63;
            const float inv = 1.0f / powf(10000.0f, (float)i * (1.0f / 64.0f)); const float ang = (float)t * inv;
            COS[e] = cosf(ang); SIN[e] = sinf(ang); }
        for (int m = gw; m < S; m += NGW) rms_row_to_bf16(x_in + (size_t)m * DM, XN + (size_t)m * DM, lane);
    }
    GRID_BAR();

    for (int L = 0; L < DEPTH; ++L) {
        asm volatile("" : "+s"(ws));
        float* Hres = (float*)(ws + WS_H);
        bf16* XN = (bf16*)(ws + WS_XN); bf16* PROJ = (bf16*)(ws + WS_PROJ); bf16* ACT = (bf16*)(ws + WS_ACT); bf16* CAT = (bf16*)(ws + WS_CAT);
        float* ATT = (float*)(ws + WS_ATT); bf16* XBC = (bf16*)(ws + WS_XBC); float* Y = (float*)(ws + WS_Y);
        bf16* KC = (bf16*)(ws + WS_KC); bf16* VC = (bf16*)(ws + WS_VC); float* DT = (float*)(ws + WS_DT); float* ADT = (float*)(ws + WS_ADT);
        float* COS = (float*)(ws + WS_COS); float* SIN = (float*)(ws + WS_SIN); unsigned* BMP = (unsigned*)(ws + WS_BMP);

        const float* hbase = (L == 0) ? x_in : Hres;
        {
            pg8::Gemm g{XN, (const bf16*)(ws + WS_WIN + L * SZ_WIN), S, NPROJ, DM}; pg8::StaticOrder So; So.init(S, NPROJ, F.G, (int)blockIdx.x);
            pg8::EpiProj E{PROJ, NPROJ, COS, SIN, QSCALE};
            pg8::gemm_phase<pg8::EpiProj, pg8::StaticOrder, true, true>(F.lds + RING_OFF, g, So, E);
        }
        GRID_BAR();
        {
            PHASE_IDS();
            LAS float* xs = (LAS float*)(F.lds + RING_OFF);
            LAS float* part = xs + 4096;
            LAS float* hid = part + 512;
            const float* cpos = args.in[3] + (size_t)L * 2 * 32 * 128; const float* cw1 = args.in[4] + (size_t)L * 2 * 4096 * 128; const float* cw2 = args.in[5] + (size_t)L * 2 * 128 * 128;
            for (int it = F.vcu; it < 2 * NKV * NCMP; it += F.G) {
                const int kv = it / (NKV * NCMP), g = (it / NCMP) % NKV, i = it % NCMP;
                const int coff = (kv == 0 ? OFF_KC : OFF_VC) + g * 128;
                for (int e = tid; e < 4096; e += NWAVES * 64) { const int l = e >> 7, d = e & 127; const int p = (kv == 0) ? (2 * (d & 63) + (d >> 6)) : d;
                    xs[e] = bf2f(PROJ[(size_t)(16 * i + l) * NPROJ + coff + p]) + cpos[(kv * 32 + l) * 128 + d]; }
                __syncthreads();
                { const int n = tid & 127, kq = tid >> 7; const float* w = cw1 + ((size_t)kv * 4096 + kq * 1024) * 128 + n; float a = 0.f;
                    for (int k = 0; k < 1024; ++k) a += xs[kq * 1024 + k] * w[(size_t)k * 128];
                    part[kq * 128 + n] = a; }
                __syncthreads();
                if (tid < 128) { const float a = (part[tid] + part[128 + tid]) + (part[256 + tid] + part[384 + tid]); hid[tid] = a / (1.f + expf(-a)); }
                __syncthreads();
                if (tid < 128) { const float* w2 = cw2 + (size_t)kv * 128 * 128 + tid; float a = 0.f;
                    for (int n = 0; n < 128; ++n) a += hid[n] * w2[n * 128];
                    const int p = (kv == 0) ? (2 * (tid & 63) + (tid >> 6)) : tid;
                    (kv == 0 ? KC : VC)[((size_t)g * 512 + i) * 128 + p] = (bf16)f2bf(a); }
                __syncthreads();
            }
            const float* cvw = args.in[7] + (size_t)L * 4 * CONVD; const float* cvb = args.in[8] + (size_t)L * CONVD;
            for (int e = gt; e < S * (CONVD / 8); e += NGT) { const int t = e / (CONVD / 8), c0 = (e % (CONVD / 8)) * 8;
                float a[8];
#pragma unroll
                for (int j = 0; j < 8; ++j) a[j] = cvb[c0 + j];
#pragma unroll
                for (int k = 0; k < 4; ++k) { const int tt = t - 3 + k; if (tt >= 0) { const v4u w = *(const GAS v4u*)(PROJ + (size_t)tt * NPROJ + OFF_XBC + c0);
                    const float f[8] = {bflo(w.x), bfhi(w.x), bflo(w.y), bfhi(w.y), bflo(w.z), bfhi(w.z), bflo(w.w), bfhi(w.w)};
#pragma unroll
                    for (int j = 0; j < 8; ++j) a[j] += f[j] * cvw[k * CONVD + c0 + j]; } }
#pragma unroll
                for (int j = 0; j < 8; ++j) a[j] = a[j] / (1.f + expf(-a[j]));
                v4u o; o.x = pk2(a[0], a[1]); o.y = pk2(a[2], a[3]); o.z = pk2(a[4], a[5]); o.w = pk2(a[6], a[7]);
                *(GAS v4u*)(XBC + (size_t)t * CONVD + c0) = o; }
            const float* dtb = args.in[9] + L * 32; const float* alog = args.in[10] + L * 32;
            for (int e = gt; e < S * 32; e += NGT) { const int t = e >> 5, h = e & 31;
                const float xr = bf2f(PROJ[(size_t)t * NPROJ + OFF_DT + h]) + dtb[h];
                const float sp = xr > 20.f ? xr : log1pf(expf(xr));
                DT[e] = sp; ADT[e] = -sp * expf(alog[h]); }
        }
        GRID_BAR();
        {
            PHASE_IDS();
            if (wave < 4) {
                LAS float* sc = (LAS float*)(F.lds + RING_OFF + wave * 21504);
                LAS float* qs = sc + 4096;
                LAS float* Pl = qs + 512;
                LAS float* impL = Pl + 512;
                LAS int* blks = (LAS int*)(impL + 128);
                const int gw4 = F.vcu * 4 + wave, NGW4 = F.G * 4;
                for (int it = gw4; it < S * NKV; it += NGW4) {
                    const int t = it >> 2, g = it & 3;
                    { const int r = lane >> 4, p0 = (lane & 15) * 8; const v4u w = *(const GAS v4u*)(PROJ + (size_t)t * NPROJ + OFF_Q + (4 * g + r) * 128 + p0);
                      LAS float* q = qs + r * 128 + p0; q[0] = bflo(w.x); q[1] = bfhi(w.x); q[2] = bflo(w.y); q[3] = bfhi(w.y); q[4] = bflo(w.z); q[5] = bfhi(w.z); q[6] = bflo(w.w); q[7] = bfhi(w.w); }
                    LDS_WAIT(); asm volatile("" ::: "memory");
                    float gate[3][4];
#pragma unroll
                    for (int b = 0; b < 3; ++b)
#pragma unroll
                        for (int r = 0; r < 4; ++r) { const float z = bf2f(PROJ[(size_t)t * NPROJ + OFF_G + b * 16 + 4 * g + r]); gate[b][r] = 1.f / (1.f + expf(-z)); }
                    float tot[4][2], o[4][2], l[4];
                    const int nv = t < 31 ? 0 : ((t - 31) / 16 + 1 < NCMP ? (t - 31) / 16 + 1 : NCMP);
                    { const KeyCmp kf{nv};
                      attend_scalar(kf, 8, KC + (size_t)g * 512 * 128, VC + (size_t)g * 512 * 128, 128, sc, qs, lane, o, l); }
#pragma unroll
                    for (int r = 0; r < 4; ++r) { const float li = l[r] > 0.f ? 1.f / l[r] : 0.f; tot[r][0] = gate[0][r] * o[r][0] * li; tot[r][1] = gate[0][r] * o[r][1] * li; }
                    for (int c = 0; c < 8; ++c) { float a = 0.f;
#pragma unroll
                        for (int r = 0; r < 4; ++r) a += sc[r * 1024 + c * 64 + lane] * (l[r] > 0.f ? 1.f / l[r] : 0.f);
                        Pl[c * 64 + lane] = a; }
                    LDS_WAIT(); asm volatile("" ::: "memory");
                    const int cur = t >> 6; float impv[2];
#pragma unroll
                    for (int e = 0; e < 2; ++e) { const int j = lane + 64 * e; float a = 0.f;
                        for (int i = 4 * j - 1; i <= 4 * j + 3; ++i) if (i >= 0) a += Pl[i];
                        impv[e] = a; impL[j] = a; }
                    LDS_WAIT(); asm volatile("" ::: "memory");
                    const int nforced = cur >= 2 ? 3 : cur + 1; const int nfree = SELTOP - nforced;
                    unsigned long long msel[2];
#pragma unroll
                    for (int e = 0; e < 2; ++e) { const int j = lane + 64 * e; const bool forced = (j == 0) || (j == cur) || (j == cur - 1); const bool valid = j <= cur; const bool cand = valid && !forced;
                        int rank = 0;
                        for (int j2 = 1; j2 < cur - 1; ++j2) { const float v2 = impL[j2]; rank += (v2 > impv[e] || (v2 == impv[e] && j2 < j)) ? 1 : 0; }
                        const bool selected = (forced && valid) || (cand && rank < nfree);
                        msel[e] = __ballot(selected); }
                    if (lane < 4) { const unsigned long long mm = (lane >> 1) ? msel[1] : msel[0]; BMP[(size_t)t * 16 + g * 4 + lane] = (unsigned)(mm >> (32 * (lane & 1))); }
                    { unsigned long long m0 = msel[0], m1 = msel[1];
                      for (int c = 0; c < 16; ++c) { int b = -1; if (m0) { b = __builtin_ctzll(m0); m0 &= m0 - 1; } else if (m1) { b = 64 + __builtin_ctzll(m1); m1 &= m1 - 1; }
                          if (lane == 0) blks[c] = b; } }
                    LDS_WAIT(); asm volatile("" ::: "memory");
                    { const KeySel kf{blks, t};
                      attend_scalar(kf, 16, PROJ + OFF_KS + g * 128, PROJ + OFF_VS + g * 128, NPROJ, sc, qs, lane, o, l); }
#pragma unroll
                    for (int r = 0; r < 4; ++r) { const float li = l[r] > 0.f ? 1.f / l[r] : 0.f; tot[r][0] += gate[1][r] * o[r][0] * li; tot[r][1] += gate[1][r] * o[r][1] * li; }
                    { const KeyWin kf{t};
                      attend_scalar(kf, 8, PROJ + OFF_KW + g * 128, PROJ + OFF_VW + g * 128, NPROJ, sc, qs, lane, o, l); }
#pragma unroll
                    for (int r = 0; r < 4; ++r) { const float li = l[r] > 0.f ? 1.f / l[r] : 0.f; tot[r][0] += gate[2][r] * o[r][0] * li; tot[r][1] += gate[2][r] * o[r][1] * li;
                        float* op = ATT + (size_t)t * 2048 + (4 * g + r) * 128 + 2 * lane; op[0] = tot[r][0]; op[1] = tot[r][1]; }
                }
            }
            if (F.vcu < SSM_H && F.G >= SSM_H) {
                const int h = F.vcu, g = h >> 2, p = wave * 8 + (lane >> 3), nc = lane & 7;
                float st[16];
#pragma unroll
                for (int n = 0; n < 16; ++n) st[n] = 0.f;
                for (int t = 0; t < S; ++t) {
                    const float dec = expf(ADT[t * 32 + h]); const float xv = bf2f(XBC[(size_t)t * CONVD + h * 64 + p]) * DT[t * 32 + h];
                    const GAS v4u* bp = (const GAS v4u*)(XBC + (size_t)t * CONVD + 2048 + g * 128 + nc * 16); const GAS v4u* cp = (const GAS v4u*)(XBC + (size_t)t * CONVD + 3072 + g * 128 + nc * 16);
                    const v4u b0 = bp[0], b1 = bp[1], c0 = cp[0], c1 = cp[1];
                    const float bb[16] = {bflo(b0.x), bfhi(b0.x), bflo(b0.y), bfhi(b0.y), bflo(b0.z), bfhi(b0.z), bflo(b0.w), bfhi(b0.w), bflo(b1.x), bfhi(b1.x), bflo(b1.y), bfhi(b1.y), bflo(b1.z), bfhi(b1.z), bflo(b1.w), bfhi(b1.w)};
                    const float cc[16] = {bflo(c0.x), bfhi(c0.x), bflo(c0.y), bfhi(c0.y), bflo(c0.z), bfhi(c0.z), bflo(c0.w), bfhi(c0.w), bflo(c1.x), bfhi(c1.x), bflo(c1.y), bfhi(c1.y), bflo(c1.z), bfhi(c1.z), bflo(c1.w), bfhi(c1.w)};
                    float yv = 0.f;
#pragma unroll
                    for (int n = 0; n < 16; ++n) { st[n] = dec * st[n] + xv * bb[n]; yv += cc[n] * st[n]; }
                    yv += __shfl_xor(yv, 1); yv += __shfl_xor(yv, 2); yv += __shfl_xor(yv, 4);
                    if (nc == 0) Y[(size_t)t * 2048 + h * 64 + p] = yv;
                }
            }
        }
        GRID_BAR();
        {
            PHASE_IDS();
            for (int t = gw; t < S; t += NGW) {
                const GAS f32x4* xr = (const GAS f32x4*)(ATT + (size_t)t * 2048) + lane; f32x4 v[8]; float s = 0.f;
#pragma unroll
                for (int j = 0; j < 8; ++j) { v[j] = xr[64 * j]; s += (v[j].x * v[j].x + v[j].y * v[j].y) + (v[j].z * v[j].z + v[j].w * v[j].w); }
                const float rstd = 1.f / sqrtf(wave_sum(s) * (1.f / 2048.f) + EPS);
                GAS unsigned long long* o8 = (GAS unsigned long long*)(CAT + (size_t)t * DM) + lane;
#pragma unroll
                for (int j = 0; j < 8; ++j) o8[64 * j] = (unsigned long long)pk2(v[j].x * rstd, v[j].y * rstd) | ((unsigned long long)pk2(v[j].z * rstd, v[j].w * rstd) << 32);
            }
            const float* dsk = args.in[11] + L * 32;
            for (int it = gw; it < S * SSM_G; it += NGW) { const int t = it >> 3, g = it & 7, c = g * 256 + 4 * lane, h = c >> 6;
                const f32x4 yv = *(const GAS f32x4*)(Y + (size_t)t * 2048 + c);
                const unsigned long long xw = *(const GAS unsigned long long*)(XBC + (size_t)t * CONVD + c); const unsigned long long zw = *(const GAS unsigned long long*)(PROJ + (size_t)t * NPROJ + OFF_Z + c);
                const float xv[4] = {bflo((unsigned)xw), bfhi((unsigned)xw), bflo((unsigned)(xw >> 32)), bfhi((unsigned)(xw >> 32))};
                const float zv[4] = {bflo((unsigned)zw), bfhi((unsigned)zw), bflo((unsigned)(zw >> 32)), bfhi((unsigned)(zw >> 32))};
                float y[4]; float s = 0.f; const float dk = dsk[h];
#pragma unroll
                for (int j = 0; j < 4; ++j) { y[j] = (yv[j] + dk * xv[j]) * (zv[j] / (1.f + expf(-zv[j]))); s += y[j] * y[j]; }
                const float rstd = 1.f / sqrtf(wave_sum(s) * (1.f / 256.f) + EPS);
                *(GAS unsigned long long*)(CAT + (size_t)t * DM + 2048 + c) = (unsigned long long)pk2(y[0] * rstd, y[1] * rstd) | ((unsigned long long)pk2(y[2] * rstd, y[3] * rstd) << 32);
            }
        }
        GRID_BAR();
        {
            pg8::Gemm g{CAT, (const bf16*)(ws + WS_WO + L * SZ_WO), S, DM, DM}; pg8::StaticOrder So; So.init(S, DM, F.G, (int)blockIdx.x);
            pg8::EpiResid E{hbase, Hres, DM};
            pg8::gemm_phase<pg8::EpiResid, pg8::StaticOrder, true, true>(F.lds + RING_OFF, g, So, E);
        }
        GRID_BAR();
        { PHASE_IDS(); for (int m = gw; m < S; m += NGW) rms_row_to_bf16(Hres + (size_t)m * DM, XN + (size_t)m * DM, lane); }
        GRID_BAR();
        {
            pg8::Gemm g{XN, (const bf16*)(ws + WS_WUP + L * SZ_WUP), S, FF, DM}; pg8::StaticOrder So; So.init(S, FF, F.G, (int)blockIdx.x);
            pg8::EpiRelu2 E{ACT, FF};
            pg8::gemm_phase<pg8::EpiRelu2, pg8::StaticOrder, true, true>(F.lds + RING_OFF, g, So, E);
        }
        GRID_BAR();
        {
            pg8::Gemm g{ACT, (const bf16*)(ws + WS_WDN + L * SZ_WDN), S, DM, FF}; pg8::StaticOrder So; So.init(S, DM, F.G, (int)blockIdx.x);
            pg8::EpiResid E{Hres, Hres, DM};
            pg8::gemm_phase<pg8::EpiResid, pg8::StaticOrder, true, true>(F.lds + RING_OFF, g, So, E);
        }
        GRID_BAR();
        if (L + 1 < DEPTH) { PHASE_IDS(); for (int m = gw; m < S; m += NGW) rms_row_to_bf16(Hres + (size_t)m * DM, XN + (size_t)m * DM, lane); GRID_BAR(); }
        else {
            PHASE_IDS();
            const float* nf = args.in[17];
            for (int m = gw; m < S; m += NGW) {
                const GAS f32x4* xr = (const GAS f32x4*)(Hres + (size_t)m * DM) + lane; f32x4 v[16]; float s = 0.f;
#pragma unroll
                for (int j = 0; j < 16; ++j) { v[j] = xr[64 * j]; s += (v[j].x * v[j].x + v[j].y * v[j].y) + (v[j].z * v[j].z + v[j].w * v[j].w); }
                const float rstd = 1.f / sqrtf(wave_sum(s) * (1.f / DM) + EPS);
                GAS f32x4* o4 = (GAS f32x4*)(args.out + (size_t)m * DM) + lane; const GAS f32x4* w4 = (const GAS f32x4*)nf + lane;
#pragma unroll
                for (int j = 0; j < 16; ++j) o4[64 * j] = v[j] * rstd * w4[64 * j];
            }
        }
    }
}

extern "C" void kernel_launch(void* const* d_in, const int* in_sizes, int n_in, void* d_out, int out_size, void* d_ws, size_t ws_size, hipStream_t stream) {
    static int grid = 0;
    if (grid == 0) {
        if (n_in != 18 || in_sizes[0] != S * DM || out_size != S * DM || ws_size < WS_END) { fprintf(stderr, "kernel_launch: shape/workspace mismatch: n_in %d in0 %d out %d ws %zu (need %zu)\n", n_in, n_in > 0 ? in_sizes[0] : -1, out_size, ws_size, (size_t)WS_END); grid = -1; return; }
        int dev = 0, cus = 0, per_cu = 0;
        if (hipGetDevice(&dev) != hipSuccess || hipDeviceGetAttribute(&cus, hipDeviceAttributeMultiprocessorCount, dev) != hipSuccess) { grid = -1; return; }
        if (hipFuncSetAttribute((const void*)hybrid_fwd, hipFuncAttributeMaxDynamicSharedMemorySize, LDS_BYTES) != hipSuccess) { fprintf(stderr, "kernel_launch: hipFuncSetAttribute failed\n"); grid = -1; return; }
        if (hipOccupancyMaxActiveBlocksPerMultiprocessor(&per_cu, (const void*)hybrid_fwd, NWAVES * 64, LDS_BYTES) != hipSuccess || per_cu < 1) fprintf(stderr, "kernel_launch: occupancy query reports %d\n", per_cu);
        (void)hipGetLastError();
        grid = cus;
    }
    if (grid < 0) return;
    if (hipMemsetAsync((char*)d_ws + WS_CTL, 0, CTL_ZERO_BYTES, stream) != hipSuccess) return;
    Args a{};
    for (int i = 0; i < 18; ++i) a.in[i] = (const float*)d_in[i];
    a.out = (float*)d_out; a.ws = (unsigned char*)d_ws;
    hipLaunchKernelGGL(hybrid_fwd, dim3(grid), dim3(NWAVES * 64), LDS_BYTES, stream, a);
}
```

```cpp
#include <hip/hip_runtime.h>
#include <cstdio>
#include <cstdint>
#include <cmath>
#ifndef REP_ATTN
#define REP_ATTN 1
#endif
#ifndef REP_UP
#define REP_UP 1
#endif
#ifndef REP_CMP
#define REP_CMP 1
#endif
#ifndef REP_PRO
#define REP_PRO 1
#endif
#ifndef REP_SSD
#define REP_SSD 1
#endif
#ifndef REP_LIGHT
#define REP_LIGHT 1
#endif
#ifndef REP_RMS
#define REP_RMS 1
#endif
#ifndef REP_CONV
#define REP_CONV 1
#endif
#ifndef REP_AN
#define REP_AN 1
#endif
#ifndef REP_SCAN
#define REP_SCAN 1
#endif
#ifndef REP_PROJ
#define REP_PROJ 1
#endif
#ifndef REP_BAR
#define REP_BAR 0
#endif
#ifndef REP_FIN
#define REP_FIN 1
#endif
#ifndef REP_SSD3
#define REP_SSD3 1
#endif
namespace pg8 {
#define PG8_LAS __attribute__((address_space(3)))
typedef unsigned short bf16_t;
typedef short bf16x8 __attribute__((ext_vector_type(8)));
typedef float f32x4 __attribute__((ext_vector_type(4)));
typedef unsigned u32x4 __attribute__((ext_vector_type(4)));
typedef int i32x4 __attribute__((ext_vector_type(4)));
typedef int i32x8 __attribute__((ext_vector_type(8)));
constexpr int BM = 256, BK = 64, HALF = 128, HTB = HALF * BK * 2  , STAGE_BYTES = 8 * HTB, NXCD = 8, WGM = 8;

__host__ __device__ __forceinline__ int lds_byte(int r, int c) { const int st = (r >> 4) * 2 + (c >> 5), rr = r & 15, cc = c & 31, ob = rr * 64 + cc * 2; return st * 1024 + (ob ^ (((ob >> 9) & 1) << 5)); }
__host__ __device__ __forceinline__ void stage_rc(int b, int& R, int& C) { const int st = b / 1024, sb = b % 1024, swz = sb ^ (((sb >> 9) & 1) << 5); R = (st >> 1) * 16 + swz / 64; C = (st & 1) * 32 + (swz % 64) / 2; }
__host__ __device__ __forceinline__ int perm32(int rho) { const int n = rho >> 4, i = rho & 15; return 8 * (i >> 2) + 4 * n + (i & 3); }

struct Unit { int pm, pn; };
struct Gemm { const bf16_t* A; const bf16_t* Bt; int M, N, K; };

struct StaticOrder {
    int nM, nN, nwg, G, c;
    __host__ __device__ void init(int M, int N, int G_, int c_) { nM = M / BM; nN = N / BM; nwg = nM * nN; G = G_; c = c_; }
    __host__ __device__ bool next(int i, Unit& u) const {
        const long L = (long)i * G + c; if (L >= nwg) return false;
        int wgid = (int)L; { const int q = nwg / NXCD, r = nwg % NXCD, xcd = wgid % NXCD, off = wgid / NXCD; wgid = (xcd < r ? xcd * (q + 1) : r * (q + 1) + (xcd - r) * q) + off; }
        const int nig = WGM * nN, gid = wgid / nig, fm = gid * WGM, gsz = (nM - fm) < WGM ? (nM - fm) : WGM;
        u.pm = fm + ((wgid % nig) % gsz); u.pn = (wgid % nig) / gsz; return true;
    }
    __device__ __forceinline__ void a_ready(const Unit&) const {}
    __device__ __forceinline__ void done(const Unit&) const {}
};

__device__ __forceinline__ unsigned cvt_pk_bf16(float lo, float hi) { unsigned r; asm volatile("v_cvt_pk_bf16_f32 %0, %1, %2" : "=v"(r) : "v"(lo), "v"(hi)); return r; }
typedef float f32x2 __attribute__((ext_vector_type(2)));
struct EpiProj {
    static constexpr bool PERM = true, AFTER_DRAIN = false;
    bf16_t* O; int ldc; const float* cosT; const float* sinT; float qscale; float osc; int pn0;
    template <bool ROPE>
    __device__ __forceinline__ void body(const f32x4 (&acc)[2][2][4][2], int row0, int colt, int cw, float sc) const {
        f32x4 ca[8], sa[8];
#define EPIPROJ_LD(g) do { const int row_ = row0 + ((g) >> 2) * HALF + ((g) & 3) * 16; ca[g] = *(const f32x4*)(cosT + (size_t)row_ * 64 + (cw >> 1)); sa[g] = *(const f32x4*)(sinT + (size_t)row_ * 64 + (cw >> 1)); } while (0)
        if (ROPE) { EPIPROJ_LD(0); EPIPROJ_LD(1); EPIPROJ_LD(2); EPIPROJ_LD(3); asm volatile("" ::: "memory"); }
#pragma unroll
        for (int g = 0; g < 8; ++g) { const int ai = g >> 2, m = g & 3; const int row = row0 + ai * HALF + m * 16;
            if (ROPE && g == 2) { asm volatile("" ::: "memory"); EPIPROJ_LD(4); EPIPROJ_LD(5); EPIPROJ_LD(6); EPIPROJ_LD(7); asm volatile("" ::: "memory"); }
#pragma unroll
            for (int bj = 0; bj < 2; ++bj) {
                f32x4 v0 = acc[ai][bj][m][0], v1 = acc[ai][bj][m][1];
                if (ROPE) { const f32x4 cc = ca[g], ss = sa[g]; f32x4 r0, r1;
                    r0[0] = v0[0] * cc[0] - v0[1] * ss[0]; r0[1] = v0[1] * cc[0] + v0[0] * ss[0];
                    r0[2] = v0[2] * cc[1] - v0[3] * ss[1]; r0[3] = v0[3] * cc[1] + v0[2] * ss[1];
                    r1[0] = v1[0] * cc[2] - v1[1] * ss[2]; r1[1] = v1[1] * cc[2] + v1[0] * ss[2];
                    r1[2] = v1[2] * cc[3] - v1[3] * ss[3]; r1[3] = v1[3] * cc[3] + v1[2] * ss[3];
                    v0 = r0; v1 = r1; }
                v0 = v0 * sc; v1 = v1 * sc;
                u32x4 w; w.x = cvt_pk_bf16(v0[0], v0[1]); w.y = cvt_pk_bf16(v0[2], v0[3]); w.z = cvt_pk_bf16(v1[0], v1[1]); w.w = cvt_pk_bf16(v1[2], v1[3]);
                *(u32x4*)(O + (size_t)row * ldc + colt + bj * HALF + cw) = w; } }
#undef EPIPROJ_LD
    }
    __device__ __forceinline__ void operator()(const f32x4 (&acc)[2][2][4][2], const Unit& u, int wr, int wc, int fr, int fq) const {
        const int row0 = u.pm * BM + wr * 64 + fr; const int colt = (u.pn + pn0) * BM; const int cw = wc * 32 + 8 * fq;
        const int blk0 = 2 * (u.pn + pn0);
        const bool rope = blk0 < 16 || (blk0 < 40 && ((((blk0 - 16) >> 2) & 1) == 0)); const float sc = (blk0 < 16 ? qscale : 1.f) * osc;
        if (rope) body<true>(acc, row0, colt, cw, sc); else body<false>(acc, row0, colt, cw, sc);
    }
};
struct EpiResid {
    static constexpr bool PERM = false, AFTER_DRAIN = false;
    const float* base; float* out; int ldc; float scale;
    __device__ __forceinline__ void operator()(const f32x4 (&acc)[2][2][4][2], const Unit& u, int wr, int wc, int fr, int fq) const {
        const int row0 = u.pm * BM + wr * 64 + fr, col0 = u.pn * BM + wc * 32 + 4 * fq;
        f32x4 cur[2][2], nxt[2][2];
        { const size_t off = (size_t)row0 * ldc + col0;
#pragma unroll
          for (int bj = 0; bj < 2; ++bj)
#pragma unroll
              for (int n = 0; n < 2; ++n) cur[bj][n] = *(const f32x4*)(base + off + bj * HALF + n * 16); }
#pragma unroll
        for (int gi = 0; gi < 8; ++gi) { const int ai = gi >> 2, m = gi & 3; const size_t off = (size_t)(row0 + ai * HALF + m * 16) * ldc + col0;
            if (gi < 7) { const int ai2 = (gi + 1) >> 2, m2 = (gi + 1) & 3; const size_t off2 = (size_t)(row0 + ai2 * HALF + m2 * 16) * ldc + col0;
#pragma unroll
                for (int bj = 0; bj < 2; ++bj)
#pragma unroll
                    for (int n = 0; n < 2; ++n) nxt[bj][n] = *(const f32x4*)(base + off2 + bj * HALF + n * 16); }
            asm volatile("" ::: "memory");
#pragma unroll
            for (int bj = 0; bj < 2; ++bj)
#pragma unroll
                for (int n = 0; n < 2; ++n) *(f32x4*)(out + off + bj * HALF + n * 16) = cur[bj][n] + acc[ai][bj][m][n] * scale;
            asm volatile("" ::: "memory");
#pragma unroll
            for (int bj = 0; bj < 2; ++bj)
#pragma unroll
                for (int n = 0; n < 2; ++n) cur[bj][n] = nxt[bj][n]; }
    }
};

template <bool BASE_F32>
struct EpiResidH {
    static constexpr bool PERM = true, AFTER_DRAIN = false;
    const void* base; bf16_t* out; int ldc; float scale;
    __device__ __forceinline__ void ld(f32x4 (&d)[2][2], size_t off) const {
#pragma unroll
        for (int bj = 0; bj < 2; ++bj) {
            if (BASE_F32) { const float* b = (const float*)base + off + bj * HALF; d[bj][0] = *(const f32x4*)b; d[bj][1] = *(const f32x4*)(b + 4); }
            else { const u32x4 w = *(const u32x4*)((const bf16_t*)base + off + bj * HALF);
                d[bj][0] = (f32x4){__uint_as_float(w.x << 16), __uint_as_float(w.x & 0xffff0000u), __uint_as_float(w.y << 16), __uint_as_float(w.y & 0xffff0000u)};
                d[bj][1] = (f32x4){__uint_as_float(w.z << 16), __uint_as_float(w.z & 0xffff0000u), __uint_as_float(w.w << 16), __uint_as_float(w.w & 0xffff0000u)}; } }
    }
    __device__ __forceinline__ void operator()(const f32x4 (&acc)[2][2][4][2], const Unit& u, int wr, int wc, int fr, int fq) const {
        const int row0 = u.pm * BM + wr * 64 + fr, col0 = u.pn * BM + wc * 32 + 8 * fq;
        f32x4 cur[2][2], nxt[2][2];
        ld(cur, (size_t)row0 * ldc + col0);
#pragma unroll
        for (int gi = 0; gi < 8; ++gi) { const int ai = gi >> 2, m = gi & 3; const size_t off = (size_t)(row0 + ai * HALF + m * 16) * ldc + col0;
            if (gi < 7) { const int ai2 = (gi + 1) >> 2, m2 = (gi + 1) & 3; ld(nxt, (size_t)(row0 + ai2 * HALF + m2 * 16) * ldc + col0); }
            asm volatile("" ::: "memory");
#pragma unroll
            for (int bj = 0; bj < 2; ++bj) { const f32x4 v0 = cur[bj][0] + acc[ai][bj][m][0] * scale, v1 = cur[bj][1] + acc[ai][bj][m][1] * scale;
                u32x4 w; w.x = cvt_pk_bf16(v0[0], v0[1]); w.y = cvt_pk_bf16(v0[2], v0[3]); w.z = cvt_pk_bf16(v1[0], v1[1]); w.w = cvt_pk_bf16(v1[2], v1[3]);
                *(u32x4*)(out + off + bj * HALF) = w; }
            asm volatile("" ::: "memory");
#pragma unroll
            for (int bj = 0; bj < 2; ++bj) { cur[bj][0] = nxt[bj][0]; cur[bj][1] = nxt[bj][1]; } }
    }
};
struct EpiRelu2 {
    static constexpr bool PERM = true, AFTER_DRAIN = false;
    bf16_t* O; int ldc;
    __device__ __forceinline__ void operator()(const f32x4 (&acc)[2][2][4][2], const Unit& u, int wr, int wc, int fr, int fq) const {
        const int row0 = u.pm * BM + wr * 64 + fr; const int col0 = u.pn * BM + wc * 32 + 8 * fq;
#pragma unroll
        for (int ai = 0; ai < 2; ++ai)
#pragma unroll
            for (int m = 0; m < 4; ++m) { bf16_t* rowp = O + (size_t)(row0 + ai * HALF + m * 16) * ldc + col0;
#pragma unroll
                for (int bj = 0; bj < 2; ++bj) { f32x4 v0 = acc[ai][bj][m][0], v1 = acc[ai][bj][m][1];
#pragma unroll
                    for (int e = 0; e < 4; ++e) { const float a = fmaxf(v0[e], 0.f), b = fmaxf(v1[e], 0.f); v0[e] = a * a; v1[e] = b * b; }
                    u32x4 w; w.x = cvt_pk_bf16(v0[0], v0[1]); w.y = cvt_pk_bf16(v0[2], v0[3]); w.z = cvt_pk_bf16(v1[0], v1[1]); w.w = cvt_pk_bf16(v1[2], v1[3]);
                    *(u32x4*)(rowp + bj * HALF) = w; } }
    }
};

__device__ __forceinline__ unsigned pk4_fp8(float a, float b, float c, float d) {
    a = fminf(fmaxf(a, -448.f), 448.f); b = fminf(fmaxf(b, -448.f), 448.f); c = fminf(fmaxf(c, -448.f), 448.f); d = fminf(fmaxf(d, -448.f), 448.f);
    int w = __builtin_amdgcn_cvt_pk_fp8_f32(a, b, 0, false); w = __builtin_amdgcn_cvt_pk_fp8_f32(c, d, w, true); return (unsigned)w; }
struct EpiRelu2F8 {
    static constexpr bool PERM = true, AFTER_DRAIN = false;
    unsigned char* O; int ldc; float sc;
    __device__ __forceinline__ void operator()(const f32x4 (&acc)[2][2][4][2], const Unit& u, int wr, int wc, int fr, int fq) const {
        const int row0 = u.pm * BM + wr * 64 + fr; const int col0 = u.pn * BM + wc * 32 + 8 * fq;
        const int odd = fq & 1;
#pragma unroll
        for (int ai = 0; ai < 2; ++ai)
#pragma unroll
            for (int bj = 0; bj < 2; ++bj) { unsigned lo[4], hi[4];
#pragma unroll
                for (int m = 0; m < 4; ++m) { f32x4 v0 = acc[ai][bj][m][0], v1 = acc[ai][bj][m][1];
#pragma unroll
                    for (int e = 0; e < 4; ++e) { const float a = fmaxf(v0[e] * sc, 0.f), b = fmaxf(v1[e] * sc, 0.f); v0[e] = a * a; v1[e] = b * b; }
                    lo[m] = pk4_fp8(v0[0], v0[1], v0[2], v0[3]); hi[m] = pk4_fp8(v1[0], v1[1], v1[2], v1[3]); }
#pragma unroll
                for (int mp = 0; mp < 4; mp += 2) {
                    auto rl = __builtin_amdgcn_permlane16_swap(lo[mp], lo[mp + 1], false, false); auto rh = __builtin_amdgcn_permlane16_swap(hi[mp], hi[mp + 1], false, false);
                    u32x4 w; w.x = rl[0]; w.y = rh[0]; w.z = rl[1]; w.w = rh[1];
                    *(u32x4*)(O + (size_t)(row0 + ai * HALF + (mp + odd) * 16) * ldc + col0 + bj * HALF - 8 * odd) = w; } }
    }
};
template <class Epi, class Sched, bool ALIGN_EPI = false, bool SP2 = false, bool F8 = false>
__device__ __forceinline__ void gemm_phase(PG8_LAS unsigned char* lds, const Gemm g, const Sched& S, const Epi& E) {
    int tid_o = threadIdx.x; asm volatile("" : "+v"(tid_o));
    const int tid = tid_o, wid = __builtin_amdgcn_readfirstlane(tid >> 6), lane = tid & 63, wr = wid >> 2, wc = wid & 3, fr = lane & 15, fq = lane >> 4;
    const int K = g.K, nt = K / BK;
    unsigned voffA[2], voffB[2];
#pragma unroll
    for (int i = 0; i < 2; ++i) { int R, C; stage_rc(tid * 16 + i * 8192, R, C); const int Rb = Epi::PERM ? ((R & ~31) + perm32(R & 31)) : R;
        voffA[i] = (unsigned)(R * K + C) * 2u; voffB[i] = (unsigned)(Rb * K + C) * 2u; }
    const size_t kstep = (size_t)(BK * 2);
    const size_t hstep = (size_t)HALF * K * 2;
    const size_t tstep = 2 * hstep;
    const unsigned ldsw = (unsigned)wid * 1024u;
    const int aoff = lds_byte(wr * 64 + fr, fq * 8), boff = lds_byte(wc * 32 + fr, fq * 8);
#define PG8_SA(b, h) (((b) * 2 + (h)) * HTB)
#define PG8_SB(b, h) ((4 + (b) * 2 + (h)) * HTB)
#define PG8_STAGE(bufoff, gbase, voff) do { _Pragma("unroll") for (int _i = 0; _i < 2; ++_i) \
        __builtin_amdgcn_global_load_lds((const unsigned*)((const char*)(gbase) + (voff)[_i]), (PG8_LAS unsigned*)(lds + (bufoff) + ldsw + _i * 8192), 16, 0, 0); } while (0)
#define PG8_LDA(dst, b, h) do { if constexpr (F8) { _Pragma("unroll") for (int m = 0; m < 4; ++m) { const i32x4 x0_ = *(const PG8_LAS i32x4*)(lds + PG8_SA(b, h) + aoff + m * 2048), x1_ = *(const PG8_LAS i32x4*)(lds + PG8_SA(b, h) + aoff + m * 2048 + 1024); \
        dst##8[m] = __builtin_shufflevector(x0_, x1_, 0, 1, 2, 3, 4, 5, 6, 7); } } else { _Pragma("unroll") for (int m = 0; m < 4; ++m) _Pragma("unroll") for (int k = 0; k < 2; ++k) dst[m][k] = *(const PG8_LAS bf16x8*)(lds + PG8_SA(b, h) + aoff + m * 2048 + k * 1024); } } while (0)
#define PG8_LDB(dst, b, h) do { if constexpr (F8) { _Pragma("unroll") for (int n = 0; n < 2; ++n) { const i32x4 x0_ = *(const PG8_LAS i32x4*)(lds + PG8_SB(b, h) + boff + n * 2048), x1_ = *(const PG8_LAS i32x4*)(lds + PG8_SB(b, h) + boff + n * 2048 + 1024); \
        dst##8[n] = __builtin_shufflevector(x0_, x1_, 0, 1, 2, 3, 4, 5, 6, 7); } } else { _Pragma("unroll") for (int n = 0; n < 2; ++n) _Pragma("unroll") for (int k = 0; k < 2; ++k) dst[n][k] = *(const PG8_LAS bf16x8*)(lds + PG8_SB(b, h) + boff + n * 2048 + k * 1024); } } while (0)
#define PG8_CAT(x0, x1) __builtin_shufflevector(__builtin_bit_cast(i32x4, x0), __builtin_bit_cast(i32x4, x1), 0, 1, 2, 3, 4, 5, 6, 7)
#define PG8_MMA(ai, bj, At, Bt) do { __builtin_amdgcn_s_setprio(1); if constexpr (F8) { _Pragma("unroll") for (int m = 0; m < 4; ++m) _Pragma("unroll") for (int n = 0; n < 2; ++n) \
        asm volatile("v_mfma_scale_f32_16x16x128_f8f6f4 %0, %1, %2, %0, %3, %3 op_sel_hi:[0,0,0]" : "+v"(acc[ai][bj][m][n]) : "v"(Bt##8[n]), "v"(At##8[m]), "v"(f8scale)); } else { \
        _Pragma("unroll") for (int m = 0; m < 4; ++m) _Pragma("unroll") for (int n = 0; n < 2; ++n) _Pragma("unroll") for (int k = 0; k < 2; ++k) \
        acc[ai][bj][m][n] = __builtin_amdgcn_mfma_f32_16x16x32_bf16(Bt[n][k], At[m][k], acc[ai][bj][m][n], 0, 0, 0); } __builtin_amdgcn_s_setprio(0); } while (0)
#define PG8_WAIT_V(n) asm volatile("s_waitcnt vmcnt(" #n ")" ::: "memory")
#define PG8_WAIT_L(n) asm volatile("s_waitcnt lgkmcnt(" #n ")" ::: "memory")
#define PG8_BAR __builtin_amdgcn_s_barrier()
#define PG8_SCHED __builtin_amdgcn_sched_barrier(0)
    Unit cur, nxt; int ui = 0;
    if (!S.next(0, cur)) return;
    f32x4 acc[2][2][4][2];
#pragma unroll
    for (int a = 0; a < 2; ++a)
#pragma unroll
        for (int b = 0; b < 2; ++b)
#pragma unroll
            for (int m = 0; m < 4; ++m)
#pragma unroll
                for (int n = 0; n < 2; ++n) acc[a][b][m][n] = (f32x4){0.f, 0.f, 0.f, 0.f};
    int f8scale = 0x7F7F7F7F; asm volatile("" : "+v"(f8scale));
    bf16x8 At[4][2], B0[2][2], B1[2][2]; i32x8 At8[4], B08[2], B18[2];
    const char* cA = (const char*)g.A + (size_t)cur.pm * tstep; const char* cB = (const char*)g.Bt + (size_t)cur.pn * tstep;
    S.a_ready(cur);
    if constexpr (SP2) {
        PG8_STAGE(PG8_SB(0, 0), cB, voffB); PG8_STAGE(PG8_SB(0, 1), cB + hstep, voffB); PG8_STAGE(PG8_SA(0, 0), cA, voffA); PG8_STAGE(PG8_SA(0, 1), cA + hstep, voffA);
        if (wr == 1) PG8_BAR;
        PG8_WAIT_V(2); PG8_BAR;
        PG8_STAGE(PG8_SB(1, 0), cB + kstep, voffB); PG8_STAGE(PG8_SA(1, 0), cA + kstep, voffA); PG8_STAGE(PG8_SB(1, 1), cB + hstep + kstep, voffB);
        PG8_WAIT_V(6); PG8_BAR;
    } else {
        PG8_STAGE(PG8_SB(0, 0), cB, voffB); PG8_STAGE(PG8_SA(0, 0), cA, voffA); PG8_STAGE(PG8_SB(0, 1), cB + hstep, voffB); PG8_STAGE(PG8_SA(0, 1), cA + hstep, voffA);
        if (wr == 1) PG8_BAR;
        PG8_WAIT_V(4); PG8_BAR;
        PG8_STAGE(PG8_SB(1, 0), cB + kstep, voffB); PG8_STAGE(PG8_SA(1, 0), cA + kstep, voffA); PG8_STAGE(PG8_SB(1, 1), cB + hstep + kstep, voffB);
        PG8_WAIT_V(6); PG8_BAR;
    }
    for (;;) {
        const bool has_next = S.next(ui + 1, nxt);
        const char* nA = has_next ? (const char*)g.A + (size_t)nxt.pm * tstep : cA; const char* nB = has_next ? (const char*)g.Bt + (size_t)nxt.pn * tstep : cB;
        for (int t = 0; t < nt; t += 2) {
            const bool last = (t == nt - 2);
            const char* a1 = cA + (size_t)(t + 1) * kstep;
            const char* a2 = last ? nA : cA + (size_t)(t + 2) * kstep; const char* b2 = last ? nB : cB + (size_t)(t + 2) * kstep;
            const char* a3 = a2 + kstep; const char* b3 = b2 + kstep;
            if (last && has_next) S.a_ready(nxt);
            if constexpr (SP2) {
            PG8_LDB(B0, 0, 0); PG8_LDB(B1, 0, 1); PG8_SCHED; PG8_LDA(At, 0, 0); PG8_STAGE(PG8_SA(1, 1), a1 + hstep, voffA);
            PG8_WAIT_V(8); PG8_WAIT_L(0); PG8_BAR; PG8_MMA(0, 0, At, B0); PG8_MMA(0, 1, At, B1); PG8_BAR; PG8_SCHED;
            PG8_LDA(At, 0, 1); PG8_STAGE(PG8_SB(0, 0), b2, voffB); PG8_STAGE(PG8_SB(0, 1), b2 + hstep, voffB); PG8_STAGE(PG8_SA(0, 0), a2, voffA);
            PG8_WAIT_V(8); PG8_WAIT_L(0); PG8_BAR; PG8_MMA(1, 0, At, B0); PG8_MMA(1, 1, At, B1); PG8_BAR; PG8_SCHED;
            PG8_LDB(B0, 1, 0); PG8_LDB(B1, 1, 1); PG8_SCHED; PG8_LDA(At, 1, 0); PG8_STAGE(PG8_SA(0, 1), a2 + hstep, voffA);
            PG8_WAIT_V(8); PG8_WAIT_L(0); PG8_BAR; PG8_MMA(0, 0, At, B0); PG8_MMA(0, 1, At, B1); PG8_BAR; PG8_SCHED;
            PG8_LDA(At, 1, 1); PG8_STAGE(PG8_SB(1, 0), b3, voffB); PG8_STAGE(PG8_SB(1, 1), b3 + hstep, voffB); PG8_STAGE(PG8_SA(1, 0), a3, voffA);
            PG8_WAIT_V(8); PG8_WAIT_L(0); PG8_BAR; PG8_MMA(1, 0, At, B0); PG8_MMA(1, 1, At, B1); PG8_BAR; PG8_SCHED;
            } else {
            PG8_LDB(B0, 0, 0); PG8_SCHED; PG8_LDA(At, 0, 0); PG8_STAGE(PG8_SA(1, 1), a1 + hstep, voffA);
            PG8_WAIT_L(8); PG8_BAR; PG8_WAIT_L(0); PG8_MMA(0, 0, At, B0); PG8_BAR; PG8_SCHED;
            PG8_LDB(B1, 0, 1); PG8_STAGE(PG8_SB(0, 0), b2, voffB);
            PG8_BAR; PG8_WAIT_L(0); PG8_MMA(0, 1, At, B1); PG8_BAR;
            PG8_LDA(At, 0, 1); PG8_STAGE(PG8_SA(0, 0), a2, voffA);
            PG8_BAR; PG8_WAIT_L(0); PG8_MMA(1, 0, At, B0); PG8_BAR; PG8_SCHED;
            PG8_STAGE(PG8_SB(0, 1), b2 + hstep, voffB);
            PG8_WAIT_V(6); PG8_BAR; PG8_MMA(1, 1, At, B1); PG8_BAR;
            PG8_LDB(B0, 1, 0); PG8_SCHED; PG8_LDA(At, 1, 0); PG8_STAGE(PG8_SA(0, 1), a2 + hstep, voffA);
            PG8_WAIT_L(8); PG8_BAR; PG8_WAIT_L(0); PG8_MMA(0, 0, At, B0); PG8_BAR; PG8_SCHED;
            PG8_LDB(B1, 1, 1); PG8_STAGE(PG8_SB(1, 0), b3, voffB);
            PG8_BAR; PG8_WAIT_L(0); PG8_MMA(0, 1, At, B1); PG8_BAR;
            PG8_LDA(At, 1, 1); PG8_STAGE(PG8_SA(1, 0), a3, voffA);
            PG8_BAR; PG8_WAIT_L(0); PG8_MMA(1, 0, At, B0); PG8_BAR; PG8_SCHED;
            PG8_STAGE(PG8_SB(1, 1), b3 + hstep, voffB);
            PG8_WAIT_V(6); PG8_BAR; PG8_MMA(1, 1, At, B1); PG8_BAR;
            }
        }
        if constexpr (ALIGN_EPI) { if (wr == 0) PG8_BAR; }
        if constexpr (F8) asm volatile("s_nop 15\n\ts_nop 15" ::: "memory");
        if constexpr (!Epi::AFTER_DRAIN) { E(acc, cur, wr, wc, fr, fq); S.done(cur); }
        if (!has_next) break;
#pragma unroll
        for (int a = 0; a < 2; ++a)
#pragma unroll
            for (int b = 0; b < 2; ++b)
#pragma unroll
                for (int m = 0; m < 4; ++m)
#pragma unroll
                    for (int n = 0; n < 2; ++n) acc[a][b][m][n] = (f32x4){0.f, 0.f, 0.f, 0.f};
        cur = nxt; cA = nA; cB = nB; ++ui;
        if constexpr (ALIGN_EPI) { if (wr == 1) PG8_BAR; }
    }
    PG8_WAIT_V(0);
    if constexpr (!ALIGN_EPI) { if (wr == 0) PG8_BAR; }
    PG8_BAR;
    if constexpr (Epi::AFTER_DRAIN) { E.fused(acc, cur, wr, wc, fr, fq, lds, wid, lane); S.done(cur); }
#undef PG8_SA
#undef PG8_SB
#undef PG8_STAGE
#undef PG8_LDA
#undef PG8_LDB
#undef PG8_MMA
#undef PG8_CAT
#undef PG8_WAIT_V
#undef PG8_WAIT_L
#undef PG8_BAR
#undef PG8_SCHED
}
}

constexpr int NWAVES = 8;
constexpr int S = 8192, DM = 4096, FF = 16384, DEPTH = 2;
constexpr int NSRC = 11344, NPROJ = 11520;
constexpr int OFF_Q = 0, OFF_KC = 2048, OFF_VC = 2560, OFF_KS = 3072, OFF_VS = 3584, OFF_KW = 4096, OFF_VW = 4608, OFF_XBC = 5120, OFF_Z = 9216, OFF_G = 11264, OFF_DT = 11312;
constexpr int NH = 16, NKV = 4, HD = 128, NCMP = 511, NSEL = 128, SELTOP = 16, WIN = 512;
constexpr int SSM_W = 2048, SSM_H = 32, SSM_P = 64, SSM_G = 8, SSM_N = 128, CONVD = 4096, CHUNK = 256, NCHUNK = S / CHUNK;
constexpr float EPS = 1e-5f;
constexpr float QSCALE = 0.08838834764831845f * 1.4426950408889634f;

constexpr size_t MiB = 1u << 20;
constexpr size_t WS_CTL = 0, CTL_ZERO_BYTES = 1 * MiB;
constexpr size_t SZ_WIN = (size_t)NPROJ * DM * 2, SZ_WO = (size_t)DM * DM * 2, SZ_WUP = (size_t)FF * DM * 2, SZ_WDN = (size_t)DM * FF * 2;
constexpr size_t WS_WIN = 2 * MiB;
constexpr size_t WS_WO = WS_WIN + DEPTH * SZ_WIN;
constexpr size_t WS_WUP = WS_WO + DEPTH * SZ_WO;
constexpr size_t WS_WDN = WS_WUP + DEPTH * SZ_WUP;
constexpr size_t WS_H = WS_WDN + DEPTH * SZ_WDN;
constexpr size_t WS_XN = WS_H + (size_t)S * DM * 4;
constexpr size_t WS_PROJ = WS_XN + (size_t)S * DM * 2;
constexpr size_t WS_ACT = WS_PROJ + (size_t)S * NPROJ * 2;
constexpr size_t WS_CAT = WS_ACT + (size_t)S * FF * 2;
constexpr size_t WS_ATT = WS_CAT + (size_t)S * DM * 2;
constexpr size_t WS_XBC = WS_ATT + (size_t)S * 2048 * 4;
constexpr size_t WS_Y = WS_XBC + (size_t)S * CONVD * 2;
constexpr size_t WS_ST = WS_Y + (size_t)S * 2048 * 4;
constexpr size_t WS_PREV = WS_ST + (size_t)NCHUNK * SSM_H * SSM_P * SSM_N * 4;
constexpr size_t WS_KC = WS_PREV + (size_t)NCHUNK * SSM_H * SSM_P * SSM_N * 4;
constexpr size_t WS_VC = WS_KC + (size_t)NKV * 512 * HD * 2;
constexpr size_t WS_DT = WS_VC + (size_t)NKV * 512 * HD * 2;
constexpr size_t WS_ADT = WS_DT + (size_t)S * 32 * 4;
constexpr size_t WS_COS = WS_ADT + (size_t)S * 32 * 4;
constexpr size_t WS_SIN = WS_COS + (size_t)S * 64 * 4;
constexpr size_t WS_BMP = WS_SIN + (size_t)S * 64 * 4;
constexpr size_t WS_ACSG = WS_BMP + (size_t)S * 16 * 4;
constexpr size_t WS_DEC = WS_ACSG + (size_t)S * 32 * 4;
constexpr size_t WS_W1T = WS_DEC + 4096;
constexpr size_t WS_W2T = WS_W1T + (size_t)DEPTH * 2 * 128 * 4096 * 2;
constexpr size_t WS_B1P = WS_W2T + (size_t)DEPTH * 2 * 128 * 128 * 2;
constexpr size_t WS_END = WS_B1P + (size_t)DEPTH * 2 * 16 * 128 * 4;
constexpr int CW_BAR = 4096, CW_P1 = 8192;
constexpr int P1_SPLIT = 10240;

constexpr int RING_OFF = 0, RING_BYTES = 131072;
constexpr int LDSCTL_OFF = 143360, MISC_OFF = LDSCTL_OFF + 320;
constexpr int LDS_BYTES = 147456;

#define GAS __attribute__((address_space(1)))
#define LAS __attribute__((address_space(3)))
typedef unsigned short bf16;
typedef unsigned v4u __attribute__((ext_vector_type(4)));
typedef float f32x4 __attribute__((ext_vector_type(4)));
typedef short bf16x8 __attribute__((ext_vector_type(8)));
typedef GAS unsigned gu32;
typedef GAS unsigned long long gu64;
#define RLX_AGENT __ATOMIC_RELAXED, __HIP_MEMORY_SCOPE_AGENT
#define LDS_WAIT() asm volatile("s_waitcnt lgkmcnt(0)" ::: "memory")
#define VM_WAIT() asm volatile("s_waitcnt vmcnt(0)" ::: "memory")
__device__ __forceinline__ unsigned long long rt() { return __builtin_amdgcn_s_memrealtime(); }
__device__ __forceinline__ unsigned f2bf(float f) { unsigned u = __builtin_bit_cast(unsigned, f); return (u + 0x7fffu + ((u >> 16) & 1u)) >> 16; }
__device__ __forceinline__ unsigned pk2(float lo, float hi) { return f2bf(lo) | (f2bf(hi) << 16); }

#define XB_TMO      128
#define XB_XCNT(j)  (256  + 64 * (j))
#define XB_XSUB(j)  (1280 + 64 * (j))
#define XB_XGEN(j)  (2304 + 64 * (j))
#define XB_TOP      3328
#define XB_TOPGEN   3392
#define XCD_BAR_WORDS 3456
#define XB_SPIN_CAP (1u << 18)

__device__ __forceinline__ unsigned xb_ld(unsigned* p)              { return __hip_atomic_load(p, __ATOMIC_RELAXED, __HIP_MEMORY_SCOPE_AGENT); }
__device__ __forceinline__ unsigned xb_add(unsigned* p, unsigned v) { return __hip_atomic_fetch_add(p, v, __ATOMIC_RELAXED, __HIP_MEMORY_SCOPE_AGENT); }
__device__ __forceinline__ unsigned xb_xcc_id() { return (unsigned)__builtin_amdgcn_s_getreg((3 << 11) | 20) & 0xFu; }
#define XB_SPIN(cond, bar) do { unsigned _sp = 0; while (cond) { __builtin_amdgcn_s_sleep(1); \
    if ((++_sp & 255u) == 0u) { if (xb_ld(&(bar)[XB_TMO])) break; if (_sp > XB_SPIN_CAP) { atomicAdd(&(bar)[XB_TMO], 1u); break; } } } } while (0)

__device__ __forceinline__ int bx_l() { int b = (int)blockIdx.x; asm volatile("" : "+s"(b)); return b; }
struct XcdBarrier {
    unsigned* bar; unsigned x;
    volatile LAS unsigned* st;
};

__device__ __forceinline__ XcdBarrier xcd_barrier_post(unsigned* bar, volatile LAS unsigned* st) {
    XcdBarrier b; b.bar = bar; b.x = xb_xcc_id(); b.st = st;
    if (threadIdx.x == 0) (void)xb_add(&bar[XB_XCNT(b.x)], 1u);
    return b;
}
__device__ __forceinline__ void xcd_barrier_complete(unsigned* bar, unsigned x, unsigned& nloc, unsigned& nx) {
    const unsigned G = gridDim.x * gridDim.y * gridDim.z;
    unsigned sum, cnt, mine, sp = 0u;
    for (;;) {
        sum = 0u; cnt = 0u; mine = 0u;
#pragma unroll
        for (unsigned j = 0; j < 16; ++j) { const unsigned c = xb_ld(&bar[XB_XCNT(j)]); sum += c; cnt += (c > 0u) ? 1u : 0u; mine = (j == x) ? c : mine; }
        if (sum == G) break;
        __builtin_amdgcn_s_sleep(1);
        if ((++sp & 255u) == 0u) { if (xb_ld(&bar[XB_TMO])) break; if (sp > XB_SPIN_CAP) { atomicAdd(&bar[XB_TMO], 1u); break; } }
    }
    nloc = mine > 0u ? mine : 1u; nx = cnt > 0u ? cnt : 1u;
}

__device__ __forceinline__ void xcd_barrier(const XcdBarrier& b) {
    asm volatile("s_waitcnt vmcnt(0)" ::: "memory");
    __syncthreads();
    if (threadIdx.x == 0) {
        unsigned* bar = b.bar;
        __builtin_amdgcn_s_waitcnt(0);
        unsigned nloc = b.st[0], nx = b.st[1];
        if (nloc == 0u) { xcd_barrier_complete(bar, b.x, nloc, nx); b.st[0] = nloc; b.st[1] = nx; }
        const unsigned old = xb_add(&bar[XB_XSUB(b.x)], 1u);
        const unsigned gen = old / nloc;
        if (old + 1u == (gen + 1u) * nloc) {
            __builtin_amdgcn_fence(__ATOMIC_RELEASE, "agent");
            asm volatile("s_waitcnt vmcnt(0)" ::: "memory");
            const unsigned og = xb_add(&bar[XB_TOP], 1u);
            const unsigned tg = og / nx;
            if (og + 1u == (tg + 1u) * nx) xb_add(&bar[XB_TOPGEN], 1u);
            else XB_SPIN(xb_ld(&bar[XB_TOPGEN]) == tg, bar);
            __builtin_amdgcn_fence(__ATOMIC_ACQUIRE, "agent");
            xb_add(&bar[XB_XGEN(b.x)], 1u);
            asm volatile("s_waitcnt vmcnt(0)" ::: "memory");
        } else {
            XB_SPIN(xb_ld(&bar[XB_XGEN(b.x)]) == gen, bar);
            __builtin_amdgcn_fence(__ATOMIC_ACQUIRE, "agent");
            asm volatile("s_waitcnt vmcnt(0)" ::: "memory");
        }
    }
    __syncthreads();
}


__device__ __forceinline__ float bf2f(unsigned short b) { return __builtin_bit_cast(float, (unsigned)b << 16); }
__device__ __forceinline__ float bflo(unsigned w) { return __builtin_bit_cast(float, w << 16); }
__device__ __forceinline__ float bfhi(unsigned w) { return __builtin_bit_cast(float, w & 0xffff0000u); }
__device__ __forceinline__ float wave_sum(float v) {
#pragma unroll
    for (int o = 1; o < 64; o <<= 1) v += __shfl_xor(v, o);
    return v;
}
__device__ __forceinline__ float wave_max(float v) {
#pragma unroll
    for (int o = 1; o < 64; o <<= 1) v = fmaxf(v, __shfl_xor(v, o));
    return v;
}

struct Frame {
    LAS unsigned char* lds;
    volatile LAS unsigned* MISC;
    gu32* ctl;
    int tid, lane, wave;
    int vcu, G;
};

__device__ __forceinline__ int src_col_in(int c) {
    if (c < 5120) { const int blk = c >> 7, p = c & 127; const bool rope = blk < 16 || ((((blk - 16) >> 2) & 1) == 0); const int d = rope ? (p >> 1) + 64 * (p & 1) : p; return blk * 128 + d; }
    if (c < OFF_Z) return c + 2096;
    if (c < OFF_G) return c - 4048;
    if (c < OFF_DT) return 5120 + (c - OFF_G);
    if (c < NSRC) return c;
    return -1;
}
__device__ __forceinline__ int nat_dim(int p) { return (p >> 1) + 64 * (p & 1); }
template <int MAP, bool KS, bool KPERM = false>
__device__ __forceinline__ void p0_transpose_item(const float* W, int K, int Nsrc, int nblk, bf16* WT, const float* ksA, const float* ksB, int ksplit, LAS float* scr, int item, int lane) {
    const int kb = item / nblk, nb = item % nblk, k0 = 64 * kb, n0 = 32 * nb;
    const int nr = n0 + (lane & 31); const int sc = MAP == 1 ? src_col_in(nr) : (MAP == 2 ? nat_dim(nr) : nr);
    float v[32];
#pragma unroll
    for (int i = 0; i < 32; ++i) { const int k = k0 + 2 * i + (lane >> 5); const int ksrc = KPERM ? ((k & ~127) + nat_dim(k & 127)) : k;
        v[i] = sc >= 0 ? W[(size_t)ksrc * Nsrc + sc] : 0.f; }
#pragma unroll
    for (int i = 0; i < 32; ++i) { const int kk = 2 * i + (lane >> 5); const int k = k0 + kk;
        if (KS) v[i] *= (k < ksplit ? ksA[k] : ksB[k - ksplit]);
        scr[kk * 33 + (lane & 31)] = v[i]; }
    LDS_WAIT(); asm volatile("" ::: "memory");
    const int c = lane & 7;
#pragma unroll
    for (int j = 0; j < 4; ++j) { const int n = (lane >> 3) + 8 * j; const LAS float* s = scr + (8 * c) * 33 + n;
        v4u o; o.x = pk2(s[0 * 33], s[1 * 33]); o.y = pk2(s[2 * 33], s[3 * 33]); o.z = pk2(s[4 * 33], s[5 * 33]); o.w = pk2(s[6 * 33], s[7 * 33]);
        *(GAS v4u*)(WT + (size_t)(n0 + n) * K + k0 + 8 * c) = o; }
    LDS_WAIT(); asm volatile("" ::: "memory");
}

template <bool KS, int MAP = 0>
__device__ __forceinline__ void p0_transpose_item_f8(const float* W, int K, int Nsrc, int nblk, unsigned char* WT, float wscale, const float* ksA, const float* ksB, int ksplit, LAS float* scr, int item, int lane) {
    const int pr = item >> 1, kb = 2 * (pr / nblk) + (item & 1), nb = pr % nblk, k0 = 64 * kb, n0 = 32 * nb;
    const int nr = n0 + (lane & 31); const int sc = MAP == 1 ? src_col_in(nr) : nr;
    float v[32];
#pragma unroll
    for (int i = 0; i < 32; ++i) v[i] = sc >= 0 ? W[(size_t)(k0 + 2 * i + (lane >> 5)) * Nsrc + sc] : 0.f;
#pragma unroll
    for (int i = 0; i < 32; ++i) { const int k = k0 + 2 * i + (lane >> 5); float x = v[i] * wscale; if (KS) x *= (k < ksplit ? ksA[k] : ksB[k - ksplit]); scr[(2 * i + (lane >> 5)) * 33 + (lane & 31)] = x; }
    LDS_WAIT(); asm volatile("" ::: "memory");
    const int c = lane & 7;
#pragma unroll
    for (int j = 0; j < 4; ++j) { const int n = (lane >> 3) + 8 * j; const LAS float* s = scr + (8 * c) * 33 + n;
        const unsigned long long o = (unsigned long long)pg8::pk4_fp8(s[0 * 33], s[1 * 33], s[2 * 33], s[3 * 33]) | ((unsigned long long)pg8::pk4_fp8(s[4 * 33], s[5 * 33], s[6 * 33], s[7 * 33]) << 32);
        *(GAS unsigned long long*)(WT + (size_t)(n0 + n) * K + k0 + 8 * c) = o; }
    LDS_WAIT(); asm volatile("" ::: "memory");
}
__device__ __forceinline__ void rms_row_to_bf16(const float* xrow, bf16* orow, int lane) {
    const GAS f32x4* xr = (const GAS f32x4*)xrow + lane;
    f32x4 v[16]; float s = 0.f;
#pragma unroll
    for (int j = 0; j < 16; ++j) { v[j] = xr[64 * j]; s += (v[j].x * v[j].x + v[j].y * v[j].y) + (v[j].z * v[j].z + v[j].w * v[j].w); }
    const float rstd = 1.f / sqrtf(wave_sum(s) * (1.f / DM) + EPS);
    GAS unsigned long long* o8 = (GAS unsigned long long*)orow + lane;
#pragma unroll
    for (int j = 0; j < 16; ++j) o8[64 * j] = (unsigned long long)pk2(v[j].x * rstd, v[j].y * rstd) | ((unsigned long long)pk2(v[j].z * rstd, v[j].w * rstd) << 32);
}
constexpr float XN8_SCALE = 4.f, WUP8_SCALE = 64.f;
__device__ __forceinline__ void rms_rowh_to_fp8(const bf16* xrow, unsigned char* orow, int lane) {
    const GAS v4u* xr = (const GAS v4u*)xrow + lane;
    v4u v[8]; float s = 0.f;
#pragma unroll
    for (int j = 0; j < 8; ++j) { v[j] = xr[64 * j]; const float a0 = bflo(v[j].x), a1 = bfhi(v[j].x), a2 = bflo(v[j].y), a3 = bfhi(v[j].y), a4 = bflo(v[j].z), a5 = bfhi(v[j].z), a6 = bflo(v[j].w), a7 = bfhi(v[j].w);
        s += ((a0 * a0 + a1 * a1) + (a2 * a2 + a3 * a3)) + ((a4 * a4 + a5 * a5) + (a6 * a6 + a7 * a7)); }
    const float rstd = XN8_SCALE / sqrtf(wave_sum(s) * (1.f / DM) + EPS);
    GAS unsigned long long* o8 = (GAS unsigned long long*)orow + lane;
#pragma unroll
    for (int j = 0; j < 8; ++j) o8[64 * j] = (unsigned long long)pg8::pk4_fp8(bflo(v[j].x) * rstd, bfhi(v[j].x) * rstd, bflo(v[j].y) * rstd, bfhi(v[j].y) * rstd) | ((unsigned long long)pg8::pk4_fp8(bflo(v[j].z) * rstd, bfhi(v[j].z) * rstd, bflo(v[j].w) * rstd, bfhi(v[j].w) * rstd) << 32);
}
constexpr int PROJ_F8_FROM = 1;
constexpr int WO_F8_FROM = 1;
__device__ __forceinline__ void rms_row_to_fp8(const float* xrow, unsigned char* orow, int lane) {
    const GAS f32x4* xr = (const GAS f32x4*)xrow + lane;
    f32x4 v[16]; float s = 0.f;
#pragma unroll
    for (int j = 0; j < 16; ++j) { v[j] = xr[64 * j]; s += (v[j].x * v[j].x + v[j].y * v[j].y) + (v[j].z * v[j].z + v[j].w * v[j].w); }
    const float rstd = XN8_SCALE / sqrtf(wave_sum(s) * (1.f / DM) + EPS);
    GAS unsigned* o4 = (GAS unsigned*)orow + lane;
#pragma unroll
    for (int j = 0; j < 16; ++j) o4[64 * j] = pg8::pk4_fp8(v[j].x * rstd, v[j].y * rstd, v[j].z * rstd, v[j].w * rstd);
}

typedef float f32x16 __attribute__((ext_vector_type(16)));
typedef short s16x4 __attribute__((ext_vector_type(4)));
__device__ __forceinline__ int crow(int r, int hi) { return (r & 3) + 8 * (r >> 2) + 4 * hi; }
__device__ __forceinline__ unsigned cvtpk(float lo, float hi) { unsigned r; asm volatile("v_cvt_pk_bf16_f32 %0, %1, %2" : "=v"(r) : "v"(lo), "v"(hi)); return r; }
__device__ __forceinline__ void stage4_tr(LAS bf16* dst  , int ld, v4u w0, v4u w1, v4u w2, v4u w3, float d0, float d1, float d2, float d3) {
    const unsigned a0[4] = {w0.x, w0.y, w0.z, w0.w}, a1[4] = {w1.x, w1.y, w1.z, w1.w}, a2[4] = {w2.x, w2.y, w2.z, w2.w}, a3[4] = {w3.x, w3.y, w3.z, w3.w};
#pragma unroll
    for (int jj = 0; jj < 4; ++jj) {
        const unsigned long long lo = (unsigned long long)cvtpk(bflo(a0[jj]) * d0, bflo(a1[jj]) * d1) | ((unsigned long long)cvtpk(bflo(a2[jj]) * d2, bflo(a3[jj]) * d3) << 32);
        const unsigned long long hi = (unsigned long long)cvtpk(bfhi(a0[jj]) * d0, bfhi(a1[jj]) * d1) | ((unsigned long long)cvtpk(bfhi(a2[jj]) * d2, bfhi(a3[jj]) * d3) << 32);
        *(LAS unsigned long long*)(dst + (2 * jj) * ld) = lo; *(LAS unsigned long long*)(dst + (2 * jj + 1) * ld) = hi; }
}
constexpr int SSD_LD = 264;
constexpr int SSD_XT2 = 0, SSD_BN = 2 * 64 * SSD_LD * 2, SSD_ACS = SSD_BN + 256 * 256, SSD_DTL = SSD_ACS + 4096, SSD_LDS_END = SSD_DTL + 4096;
constexpr int SSD_BT = 0, SSD_XT = 128 * SSD_LD * 2;
static_assert(SSD_LDS_END <= LDSCTL_OFF && SSD_XT + 64 * SSD_LD * 2 <= SSD_ACS, "ssd lds");
__device__ __forceinline__ void ssd1_unit(LAS unsigned char* lds, int c, int g, const bf16* XBC, const bf16* PROJ, const float* dtb, const float* alog, bf16* Y, float* ST, float* DEC, float* ACSG, int tid_in) {
    int tid = tid_in; asm volatile("" : "+v"(tid));
    const int lane = tid & 63, wave = __builtin_amdgcn_readfirstlane(tid >> 6), l32 = lane & 31, hi = lane >> 5;
    LAS bf16* XT2 = (LAS bf16*)(lds + SSD_XT2); LAS unsigned char* BN = lds + SSD_BN; LAS float* acs = (LAS float*)(lds + SSD_ACS); LAS float* dtl = (LAS float*)(lds + SSD_DTL);
    const int t0 = c * CHUNK;
    __syncthreads();
    if (wave < 4) { const int h = 4 * g + wave; float a[4], run = 0.f; const float nA = -expf(alog[h]), db = dtb[h];
#pragma unroll
        for (int i = 0; i < 4; ++i) { const float xr = bf2f(PROJ[(size_t)(t0 + 4 * lane + i) * NPROJ + OFF_DT + h]) + db; const float sp = xr > 20.f ? xr : log1pf(expf(xr));
            a[i] = sp * nA; run += a[i]; a[i] = run; dtl[wave * 256 + 4 * lane + i] = sp; }
        float inc = run;
#pragma unroll
        for (int d = 1; d < 64; d <<= 1) { const float v = __shfl_up(inc, d); if (lane >= d) inc += v; }
        const float excl = inc - run;
#pragma unroll
        for (int i = 0; i < 4; ++i) { const float v = a[i] + excl; acs[wave * 256 + 4 * lane + i] = v; ACSG[(size_t)(t0 + 4 * lane + i) * 32 + h] = v; }
        if (lane == 63) DEC[c * 32 + h] = expf(inc);
    }
#pragma unroll
    for (int i = 0; i < 8; ++i) { const int idx = tid + 512 * i, s = idx >> 4, ch = idx & 15;
        const v4u w = *(const GAS v4u*)(XBC + (size_t)(t0 + s) * CONVD + 2048 + g * 128 + 8 * ch);
        *(LAS v4u*)(BN + s * 256 + ((ch ^ (s & 7)) << 4)) = w; }
    __syncthreads();
#pragma unroll 1
    for (int rd = 0; rd < 2; ++rd) {
        { const int s0 = 4 * lane;
#pragma unroll
          for (int cq = 0; cq < 2; ++cq) { const int cb = 8 * (2 * wave + cq), hq = cb >> 6, pb = cb & 63;
            const bf16* xp = XBC + (size_t)(t0 + s0) * CONVD + (4 * g + 2 * rd) * 64 + cb;
            const v4u w0 = *(const GAS v4u*)xp, w1 = *(const GAS v4u*)(xp + CONVD), w2 = *(const GAS v4u*)(xp + 2 * CONVD), w3 = *(const GAS v4u*)(xp + 3 * CONVD);
            const f32x4 dv = *(const LAS f32x4*)(dtl + (2 * rd + hq) * 256 + s0);
            stage4_tr(XT2 + (hq * 64 + pb) * SSD_LD + s0, SSD_LD, w0, w1, w2, w3, dv[0], dv[1], dv[2], dv[3]); } }
        __syncthreads();
        { const int hq = wave >> 2, hh = 2 * rd + hq, h = 4 * g + hh;
#pragma unroll 1
          for (int task = 0; task < 2; ++task) {
            const int lt = task ? 7 - (wave & 3) : (wave & 3); const int lloc = 32 * lt + l32, lrow = t0 + lloc;
            bf16x8 cf[8];
#pragma unroll
            for (int kk = 0; kk < 8; ++kk) cf[kk] = *(const GAS bf16x8*)(XBC + (size_t)lrow * CONVD + 3072 + g * 128 + 16 * kk + 8 * hi);
            const float acl = acs[hh * 256 + lloc];
            f32x16 ya0 = {}, ya1 = {};
            for (int j = 0; j <= lt; ++j) {
                f32x16 gt = {};
                { const int s = 32 * j + l32; const LAS unsigned char* brow = BN + s * 256; const int sw = s & 7;
#pragma unroll
                  for (int kk = 0; kk < 8; ++kk) { const bf16x8 a = *(const LAS bf16x8*)(brow + (((2 * kk + hi) ^ sw) << 4)); gt = __builtin_amdgcn_mfma_f32_32x32x16_bf16(a, cf[kk], gt, 0, 0, 0); } }
                float e[16];
#pragma unroll
                for (int q = 0; q < 4; ++q) { const f32x4 av = *(const LAS f32x4*)(acs + hh * 256 + 32 * j + 8 * q + 4 * hi);
#pragma unroll
                    for (int i = 0; i < 4; ++i) { const int r = 4 * q + i, s = 32 * j + crow(r, hi); const float ev = __expf(fminf(acl - av[i], 0.f)); e[r] = (s <= lloc) ? gt[r] * ev : 0.f; } }
                v4u w0 = {cvtpk(e[0], e[1]), cvtpk(e[2], e[3]), cvtpk(e[4], e[5]), cvtpk(e[6], e[7])}, w1 = {cvtpk(e[8], e[9]), cvtpk(e[10], e[11]), cvtpk(e[12], e[13]), cvtpk(e[14], e[15])};
                const bf16x8 pk0 = __builtin_bit_cast(bf16x8, w0), pk1 = __builtin_bit_cast(bf16x8, w1);
#pragma unroll
                for (int pt = 0; pt < 2; ++pt) {
                    const LAS bf16* xr = XT2 + (hq * 64 + 32 * pt + l32) * SSD_LD + 32 * j + 4 * hi;
                    const s16x4 a0 = *(const LAS s16x4*)(xr), a1 = *(const LAS s16x4*)(xr + 8), a2 = *(const LAS s16x4*)(xr + 16), a3 = *(const LAS s16x4*)(xr + 24);
                    const bf16x8 af0 = {a0[0], a0[1], a0[2], a0[3], a1[0], a1[1], a1[2], a1[3]}, af1 = {a2[0], a2[1], a2[2], a2[3], a3[0], a3[1], a3[2], a3[3]};
                    if (pt == 0) { ya0 = __builtin_amdgcn_mfma_f32_32x32x16_bf16(af0, pk0, ya0, 0, 0, 0); ya0 = __builtin_amdgcn_mfma_f32_32x32x16_bf16(af1, pk1, ya0, 0, 0, 0); }
                    else { ya1 = __builtin_amdgcn_mfma_f32_32x32x16_bf16(af0, pk0, ya1, 0, 0, 0); ya1 = __builtin_amdgcn_mfma_f32_32x32x16_bf16(af1, pk1, ya1, 0, 0, 0); }
                }
            }
            bf16* yrow = Y + (size_t)lrow * 2048 + h * 64 + 4 * hi;
#pragma unroll
            for (int q = 0; q < 4; ++q) { *(GAS unsigned long long*)(yrow + 8 * q) = (unsigned long long)cvtpk(ya0[4 * q], ya0[4 * q + 1]) | ((unsigned long long)cvtpk(ya0[4 * q + 2], ya0[4 * q + 3]) << 32);
                                          *(GAS unsigned long long*)(yrow + 32 + 8 * q) = (unsigned long long)cvtpk(ya1[4 * q], ya1[4 * q + 1]) | ((unsigned long long)cvtpk(ya1[4 * q + 2], ya1[4 * q + 3]) << 32); }
          } }
        __syncthreads();
    }
    LAS bf16* BT = (LAS bf16*)(lds + SSD_BT); LAS bf16* XT = (LAS bf16*)(lds + SSD_XT);
    { const int s0 = 4 * lane;
#pragma unroll
      for (int cq = 0; cq < 2; ++cq) { const int nb = 8 * (2 * wave + cq);
        const bf16* bp = XBC + (size_t)(t0 + s0) * CONVD + 2048 + g * 128 + nb;
        const v4u w0 = *(const GAS v4u*)bp, w1 = *(const GAS v4u*)(bp + CONVD), w2 = *(const GAS v4u*)(bp + 2 * CONVD), w3 = *(const GAS v4u*)(bp + 3 * CONVD);
        stage4_tr(BT + nb * SSD_LD + s0, SSD_LD, w0, w1, w2, w3, 1.f, 1.f, 1.f, 1.f); } }
    for (int hh = 0; hh < 4; ++hh) {
        const int h = 4 * g + hh;
        { const float aend = acs[hh * 256 + 255]; const int s0 = 4 * lane, pb = 8 * wave;
          const bf16* xp = XBC + (size_t)(t0 + s0) * CONVD + h * 64 + pb;
          const v4u w0 = *(const GAS v4u*)xp, w1 = *(const GAS v4u*)(xp + CONVD), w2 = *(const GAS v4u*)(xp + 2 * CONVD), w3 = *(const GAS v4u*)(xp + 3 * CONVD);
          const f32x4 dv = *(const LAS f32x4*)(dtl + hh * 256 + s0), av = *(const LAS f32x4*)(acs + hh * 256 + s0);
          stage4_tr(XT + pb * SSD_LD + s0, SSD_LD, w0, w1, w2, w3, dv[0] * __expf(aend - av[0]), dv[1] * __expf(aend - av[1]), dv[2] * __expf(aend - av[2]), dv[3] * __expf(aend - av[3])); }
        __syncthreads();
        { const int pt = wave >> 2, nt = wave & 3; f32x16 acc = {};
          const LAS bf16* ar = XT + (32 * pt + l32) * SSD_LD + 8 * hi; const LAS bf16* br = BT + (32 * nt + l32) * SSD_LD + 8 * hi;
#pragma unroll
          for (int kk = 0; kk < 16; ++kk) { const bf16x8 a = *(const LAS bf16x8*)(ar + 16 * kk), b = *(const LAS bf16x8*)(br + 16 * kk); acc = __builtin_amdgcn_mfma_f32_32x32x16_bf16(a, b, acc, 0, 0, 0); }
          float* sp = ST + ((size_t)(c * 32 + h) * 64 + 32 * pt) * 128 + 32 * nt + l32;
#pragma unroll
          for (int r = 0; r < 16; ++r) sp[(size_t)crow(r, hi) * 128] = acc[r]; }
        __syncthreads();
    }
}
constexpr int S3_LD = 68;
__device__ __forceinline__ void ssd3_unit(LAS unsigned char* lds, int c, int g, const bf16* XBC, const bf16* PROJ, const bf16* Y, bf16* Y2, const bf16* PREV, const float* ACSG, const float* dsk, unsigned char* CAT, bool cat_f8, int tid_in) {
    int tid = tid_in; asm volatile("" : "+v"(tid));
    const int lane = tid & 63, wave = __builtin_amdgcn_readfirstlane(tid >> 6), l32 = lane & 31, hi = lane >> 5;
    LAS float* T = (LAS float*)(lds + 65536) + wave * (32 * S3_LD);
    const int t0 = c * CHUNK; const int lrow = t0 + 32 * wave + l32;
    asm volatile("s_waitcnt vmcnt(0) lgkmcnt(0)" ::: "memory"); __builtin_amdgcn_s_barrier();
    { const int sr = tid >> 4, spc = tid & 15, slc = spc ^ (sr & 7);
      const char* psrc = (const char*)(PREV + ((size_t)(c * 32 + 4 * g) * 64 + sr) * 128 + 8 * slc);
#pragma unroll
      for (int q = 0; q < 8; ++q)
          __builtin_amdgcn_global_load_lds((const unsigned*)(psrc + (size_t)q * (32 * 128 * 2)), (LAS unsigned*)(lds + q * 8192 + wave * 1024), 16, 0, 0); }
    const int q8 = (lane & 7) * 8, tl0 = lane >> 3;
    bf16x8 cf[8];
#pragma unroll
    for (int kk = 0; kk < 8; ++kk) cf[kk] = *(const GAS bf16x8*)(XBC + (size_t)lrow * CONVD + 3072 + g * 128 + 16 * kk + 8 * hi);
    float ss[4] = {0.f, 0.f, 0.f, 0.f};
    asm volatile("s_waitcnt vmcnt(0)" ::: "memory"); __builtin_amdgcn_s_barrier(); asm volatile("" ::: "memory");
    const int sw = l32 & 7;
#pragma unroll
    for (int hh = 0; hh < 4; ++hh) { const int h = 4 * g + hh; const float dk = dsk[h];
        f32x16 acc0 = {}, acc1 = {};
        const LAS unsigned char* pr = lds + hh * 16384 + l32 * 256;
#pragma unroll
        for (int kk = 0; kk < 8; ++kk) { const int cx = ((2 * kk + hi) ^ sw) << 4; const bf16x8 w0 = *(const LAS bf16x8*)(pr + cx), w1 = *(const LAS bf16x8*)(pr + 8192 + cx);
            acc0 = __builtin_amdgcn_mfma_f32_32x32x16_bf16(cf[kk], w0, acc0, 0, 0, 0);
            acc1 = __builtin_amdgcn_mfma_f32_32x32x16_bf16(cf[kk], w1, acc1, 0, 0, 0); }
        asm volatile("" ::: "memory");
#pragma unroll
        for (int r = 0; r < 16; ++r) { T[crow(r, hi) * S3_LD + l32] = acc0[r]; T[crow(r, hi) * S3_LD + 32 + l32] = acc1[r]; }
        asm volatile("s_waitcnt lgkmcnt(0)" ::: "memory");
#pragma unroll
        for (int ip = 0; ip < 2; ++ip) {
            v4u yw[2]; v4u xw[2], zw[2]; float ea[2];
#pragma unroll
            for (int ii = 0; ii < 2; ++ii) { const int i = 2 * ip + ii; const int t = t0 + 32 * wave + tl0 + 8 * i; const int ch = h * 64 + q8;
                yw[ii] = *(const GAS v4u*)(Y + (size_t)t * 2048 + ch);
                xw[ii] = *(const GAS v4u*)(XBC + (size_t)t * CONVD + ch); zw[ii] = *(const GAS v4u*)(PROJ + (size_t)t * NPROJ + OFF_Z + ch); ea[ii] = __expf(ACSG[(size_t)t * 32 + h]); }
#pragma unroll
            for (int ii = 0; ii < 2; ++ii) { const int i = 2 * ip + ii; const LAS f32x4* tp = (const LAS f32x4*)(T + (tl0 + 8 * i) * S3_LD + q8); const f32x4 a0 = tp[0], a1 = tp[1];
                const float xv[8] = {bflo(xw[ii].x), bfhi(xw[ii].x), bflo(xw[ii].y), bfhi(xw[ii].y), bflo(xw[ii].z), bfhi(xw[ii].z), bflo(xw[ii].w), bfhi(xw[ii].w)};
                const float zv[8] = {bflo(zw[ii].x), bfhi(zw[ii].x), bflo(zw[ii].y), bfhi(zw[ii].y), bflo(zw[ii].z), bfhi(zw[ii].z), bflo(zw[ii].w), bfhi(zw[ii].w)};
                const float ydv[8] = {bflo(yw[ii].x), bfhi(yw[ii].x), bflo(yw[ii].y), bfhi(yw[ii].y), bflo(yw[ii].z), bfhi(yw[ii].z), bflo(yw[ii].w), bfhi(yw[ii].w)};
                float y[8];
#pragma unroll
                for (int j = 0; j < 8; ++j) { const float a = j < 4 ? a0[j & 3] : a1[j & 3], yd = ydv[j];
                    float v = a * ea[ii] + yd + dk * xv[j]; v *= zv[j] / (1.f + __expf(-zv[j])); y[j] = v; ss[i] += v * v; }
                *(GAS v4u*)(Y2 + (size_t)(t0 + 32 * wave + tl0 + 8 * i) * 2048 + h * 64 + q8) = (v4u){cvtpk(y[0], y[1]), cvtpk(y[2], y[3]), cvtpk(y[4], y[5]), cvtpk(y[6], y[7])}; }
            asm volatile("" ::: "memory");
        }
        asm volatile("s_waitcnt lgkmcnt(0)" ::: "memory");
    }
    asm volatile("s_waitcnt vmcnt(0)" ::: "memory");
    float rs[4];
#pragma unroll
    for (int i = 0; i < 4; ++i) { float s = ss[i]; s += __shfl_xor(s, 1); s += __shfl_xor(s, 2); s += __shfl_xor(s, 4); rs[i] = 1.f / sqrtf(s * (1.f / 256.f) + EPS); }
#pragma unroll
    for (int hh = 0; hh < 4; ++hh)
#pragma unroll
        for (int i = 0; i < 4; ++i) { const int t = t0 + 32 * wave + tl0 + 8 * i; const float r = rs[i];
            const unsigned long long* yp = (const unsigned long long*)(Y2 + (size_t)t * 2048 + (4 * g + hh) * 64 + q8);
            const unsigned long long u0 = __hip_atomic_load(yp, __ATOMIC_RELAXED, __HIP_MEMORY_SCOPE_AGENT), u1 = __hip_atomic_load(yp + 1, __ATOMIC_RELAXED, __HIP_MEMORY_SCOPE_AGENT);
            const v4u w = {(unsigned)u0, (unsigned)(u0 >> 32), (unsigned)u1, (unsigned)(u1 >> 32)};
            if (cat_f8) {
            const unsigned long long o = (unsigned long long)pg8::pk4_fp8(bflo(w.x) * r, bfhi(w.x) * r, bflo(w.y) * r, bfhi(w.y) * r) | ((unsigned long long)pg8::pk4_fp8(bflo(w.z) * r, bfhi(w.z) * r, bflo(w.w) * r, bfhi(w.w) * r) << 32);
            *(GAS unsigned long long*)(CAT + (size_t)t * DM + 2048 + (4 * g + hh) * 64 + q8) = o; }
            else *(GAS v4u*)((bf16*)CAT + (size_t)t * DM + 2048 + (4 * g + hh) * 64 + q8) = (v4u){cvtpk(bflo(w.x) * r, bfhi(w.x) * r), cvtpk(bflo(w.y) * r, bfhi(w.y) * r), cvtpk(bflo(w.z) * r, bfhi(w.z) * r), cvtpk(bflo(w.w) * r, bfhi(w.w) * r)}; }
}

#define KSWZ(row, colB) ((row) * 256 + ((colB) ^ (((row) & 7) << 4)))
#define SBAR() __builtin_amdgcn_sched_barrier(0)
__device__ __forceinline__ int v_st(int k, int c) { const int kk = (k & ~0xC) | ((k & 4) << 1) | ((k & 8) >> 1); return ((kk >> 3) * 4 + (c >> 5)) * 512 + ((kk & 7) * 32 + (c & 31)) * 2; }
__device__ __forceinline__ int v_rd_base(int lane) { return ((lane & 3) << 3) | (((lane >> 2) & 3) << 6) | (((lane >> 4) & 1) << 5) | (((lane >> 5) & 1) << 8); }
constexpr int v_rd_off(int d0, int ks, int half) { return d0 * 512 + ks * 4096 + half * 2048; }
constexpr int AT_K = 0, AT_V = 49152, AT_WS = 98304, AT_IMP = AT_WS + 2048, AT_IMPLD = 129, AT_CARRY = AT_IMP + 64 * AT_IMPLD * 4, AT_BM = AT_CARRY + 2048, AT_END = AT_BM + 1024;
static_assert(AT_END <= LDSCTL_OFF, "attention lds");
constexpr float AT_THR = 11.5f;

__device__ __forceinline__ void at_qkt(f32x16& p0, f32x16& p1, const LAS unsigned char* Kt, int l32, int hi, const bf16x8 (&qr)[8], const f32x16& cinit) {
    const LAS unsigned char* kb[4];
#pragma unroll
    for (int dd = 0; dd < 4; ++dd) kb[dd] = Kt + KSWZ(l32, (dd * 16 + hi * 8) * 2);
#pragma unroll
    for (int d0 = 0; d0 < 8; ++d0) { const LAS unsigned char* a = kb[d0 & 3] + (d0 >> 2) * 128;
        const bf16x8 b0 = *(const LAS bf16x8*)a, b1 = *(const LAS bf16x8*)(a + 32 * 256);
        if (d0 == 0) { p0 = __builtin_amdgcn_mfma_f32_32x32x16_bf16(b0, qr[0], cinit, 0, 0, 0); p1 = __builtin_amdgcn_mfma_f32_32x32x16_bf16(b1, qr[0], cinit, 0, 0, 0); }
        else { p0 = __builtin_amdgcn_mfma_f32_32x32x16_bf16(b0, qr[d0], p0, 0, 0, 0); p1 = __builtin_amdgcn_mfma_f32_32x32x16_bf16(b1, qr[d0], p1, 0, 0, 0); } }
}
__device__ __forceinline__ void at_pv(f32x16 (&o)[4], int vb, bf16x8 pa0, bf16x8 pa1, bf16x8 pa2, bf16x8 pa3) {
#define TRRD(dst, off) asm volatile("ds_read_b64_tr_b16 %0, %1 offset:%2" : "=&v"(dst) : "v"(vb), "i"(off) : "memory")
#define PV_D0(d0) do { s16x4 l0, l1, l2, l3, h0, h1, h2, h3; constexpr int b_ = v_rd_off(d0, 0, 0); \
        TRRD(l0, b_); TRRD(h0, b_ + 2048); TRRD(l1, b_ + 4096); TRRD(h1, b_ + 6144); TRRD(l2, b_ + 8192); TRRD(h2, b_ + 10240); TRRD(l3, b_ + 12288); TRRD(h3, b_ + 14336); \
        asm volatile("s_waitcnt lgkmcnt(0)" ::: "memory"); SBAR(); \
        o[d0] = __builtin_amdgcn_mfma_f32_32x32x16_bf16(pa0, (bf16x8){l0[0], l0[1], l0[2], l0[3], h0[0], h0[1], h0[2], h0[3]}, o[d0], 0, 0, 0); \
        o[d0] = __builtin_amdgcn_mfma_f32_32x32x16_bf16(pa1, (bf16x8){l1[0], l1[1], l1[2], l1[3], h1[0], h1[1], h1[2], h1[3]}, o[d0], 0, 0, 0); \
        o[d0] = __builtin_amdgcn_mfma_f32_32x32x16_bf16(pa2, (bf16x8){l2[0], l2[1], l2[2], l2[3], h2[0], h2[1], h2[2], h2[3]}, o[d0], 0, 0, 0); \
        o[d0] = __builtin_amdgcn_mfma_f32_32x32x16_bf16(pa3, (bf16x8){l3[0], l3[1], l3[2], l3[3], h3[0], h3[1], h3[2], h3[3]}, o[d0], 0, 0, 0); } while (0)
    PV_D0(0); PV_D0(1); PV_D0(2); PV_D0(3);
#undef PV_D0
#undef TRRD
}
__device__ __forceinline__ float max3f(float a, float b, float c) { float r; asm("v_max3_f32 %0, %1, %2, %3" : "=v"(r) : "v"(a), "v"(b), "v"(c)); return r; }
__device__ __forceinline__ float at_softmax(f32x16& p0, f32x16& p1, float& m_reg, f32x16& negm, float& l_reg, bf16x8& pa0, bf16x8& pa1, bf16x8& pa2, bf16x8& pa3, bool rowsel, bool use_rowsel) {
    float ma = max3f(p0[0], p0[1], p0[2]), mb = max3f(p0[3], p0[4], p0[5]), mc = max3f(p0[6], p0[7], p0[8]), md = max3f(p0[9], p0[10], p0[11]);
    ma = max3f(ma, p0[12], p0[13]); mb = max3f(mb, p0[14], p0[15]); mc = max3f(mc, p1[0], p1[1]); md = max3f(md, p1[2], p1[3]);
    ma = max3f(ma, p1[4], p1[5]); mb = max3f(mb, p1[6], p1[7]); mc = max3f(mc, p1[8], p1[9]); md = max3f(md, p1[10], p1[11]);
    ma = max3f(ma, p1[12], p1[13]); mb = max3f(mb, p1[14], p1[15]);
    float pmax = fmaxf(max3f(ma, mb, mc), md);
    if (use_rowsel && !rowsel) pmax = -__builtin_inff();
    { auto rr = __builtin_amdgcn_permlane32_swap(__float_as_uint(pmax), __float_as_uint(pmax), false, false); pmax = fmaxf(__uint_as_float(rr[0]), __uint_as_float(rr[1])); }
    float alpha = 1.f;
    if (!__all(pmax <= AT_THR)) {
        const float d = fmaxf(pmax, 0.f); alpha = __builtin_amdgcn_exp2f(-d); m_reg += d;
#pragma unroll
        for (int r = 0; r < 16; ++r) { p0[r] -= d; p1[r] -= d; negm[r] = -m_reg; }
    }
    float s0 = 0.f, s1 = 0.f, s2 = 0.f, s3 = 0.f;
#pragma unroll
    for (int r = 0; r < 16; r += 4) { p0[r] = __builtin_amdgcn_exp2f(p0[r]); p0[r + 1] = __builtin_amdgcn_exp2f(p0[r + 1]); p0[r + 2] = __builtin_amdgcn_exp2f(p0[r + 2]); p0[r + 3] = __builtin_amdgcn_exp2f(p0[r + 3]);
        s0 += p0[r]; s1 += p0[r + 1]; s2 += p0[r + 2]; s3 += p0[r + 3]; }
#pragma unroll
    for (int r = 0; r < 16; r += 4) { p1[r] = __builtin_amdgcn_exp2f(p1[r]); p1[r + 1] = __builtin_amdgcn_exp2f(p1[r + 1]); p1[r + 2] = __builtin_amdgcn_exp2f(p1[r + 2]); p1[r + 3] = __builtin_amdgcn_exp2f(p1[r + 3]);
        s0 += p1[r]; s1 += p1[r + 1]; s2 += p1[r + 2]; s3 += p1[r + 3]; }
    float ps = (s0 + s1) + (s2 + s3);
    if (use_rowsel && !rowsel) ps = 0.f;
    { auto rr = __builtin_amdgcn_permlane32_swap(__float_as_uint(ps), __float_as_uint(ps), false, false); ps = __uint_as_float(rr[0]) + __uint_as_float(rr[1]); }
    l_reg = l_reg * alpha + ps;
    const unsigned keep = (use_rowsel && !rowsel) ? 0u : 0xffffffffu;
#define PK4(P, B_, OUT) do { unsigned a0 = cvtpk(P[B_+0], P[B_+1]), a1 = cvtpk(P[B_+2], P[B_+3]); unsigned b0 = cvtpk(P[B_+4], P[B_+5]), b1 = cvtpk(P[B_+6], P[B_+7]); \
        if (use_rowsel) { a0 &= keep; a1 &= keep; b0 &= keep; b1 &= keep; } \
        auto r0 = __builtin_amdgcn_permlane32_swap(a0, b0, false, false); auto r1 = __builtin_amdgcn_permlane32_swap(a1, b1, false, false); \
        v4u w = {r0[0], r1[0], r0[1], r1[1]}; OUT = __builtin_bit_cast(bf16x8, w); } while (0)
    PK4(p0, 0, pa0); PK4(p0, 8, pa1); PK4(p1, 0, pa2); PK4(p1, 8, pa3);
#undef PK4
    return alpha;
}
template <int MODE>
__device__ __forceinline__ void at_mask(f32x16& p0, f32x16& p1, int kb, int hi, int tq, int lim, bool rowsel) {
    const float NEG = -__builtin_inff();
#pragma unroll
    for (int r = 0; r < 16; ++r) { const int k0 = kb + (r & 3) + 8 * (r >> 2) + 4 * hi, k1 = k0 + 32;
        bool v0, v1;
        if (MODE == 0) { v0 = k0 <= lim; v1 = k1 <= lim; }
        else if (MODE == 1) { v0 = rowsel && k0 <= tq; v1 = rowsel && k1 <= tq; }
        else { v0 = (unsigned)(tq - k0) < (unsigned)WIN; v1 = (unsigned)(tq - k1) < (unsigned)WIN; }
        if (!v0) p0[r] = NEG; if (!v1) p1[r] = NEG; }
}
template <int MODE>
__device__ __forceinline__ void at_branch(LAS unsigned char* lds, const bf16x8 (&qr)[8], const bf16* Kb, const bf16* Vb, int ld, int jlo, int NT, int tq, int lim, const LAS unsigned* bmrow,
                                          bf16* Obase, float& m_out, float& l_out, int tid_in) {
    int tid = tid_in; asm volatile("" : "+v"(tid));
    const int lane = tid & 63, wave = __builtin_amdgcn_readfirstlane(tid >> 6), l32 = lane & 31, hi = lane >> 5;
    LAS unsigned char* K_lds = lds + AT_K; LAS unsigned char* V_lds = lds + AT_V;
    LAS float* wsl = (LAS float*)(lds + AT_WS) + wave * 64;
    const int vb0 = (int)(unsigned)(size_t)V_lds + v_rd_base(lane);
    const int ksr = tid >> 4, kslc = (tid & 15) ^ (ksr & 7);
    const int vkk = (tid >> 7) * 8 + ((tid & 31) >> 2), vk = (vkk & ~0xC) | ((vkk & 4) << 1) | ((vkk & 8) >> 1), vc = ((tid >> 5) & 3) * 32 + (tid & 3) * 8;
    const char* ksrc = (const char*)(Kb + (size_t)ksr * ld + 8 * kslc); const char* vsrc = (const char*)(Vb + (size_t)vk * ld + vc);
    const size_t half_b = (size_t)32 * ld * 2, tile_b = (size_t)64 * ld * 2; const unsigned ldsw = (unsigned)wave * 1024u;
#define AT_ISSUE(j, stg) do { const size_t jo_ = (size_t)(j) * tile_b; \
        __builtin_amdgcn_global_load_lds((const GAS unsigned*)(ksrc + jo_), (LAS unsigned*)(K_lds + (stg) * 16384 + ldsw), 16, 0, 0); \
        __builtin_amdgcn_global_load_lds((const GAS unsigned*)(ksrc + jo_ + half_b), (LAS unsigned*)(K_lds + (stg) * 16384 + 8192 + ldsw), 16, 0, 0); \
        __builtin_amdgcn_global_load_lds((const GAS unsigned*)(vsrc + jo_), (LAS unsigned*)(V_lds + (stg) * 16384 + ldsw), 16, 0, 0); \
        __builtin_amdgcn_global_load_lds((const GAS unsigned*)(vsrc + jo_ + half_b), (LAS unsigned*)(V_lds + (stg) * 16384 + 8192 + ldsw), 16, 0, 0); } while (0)
    float m_reg = -1e4f, l_reg = 0.f; f32x16 o[4] = {};
    f32x16 negm;
#pragma unroll
    for (int r = 0; r < 16; ++r) negm[r] = 1e4f;
    const int tq_min = __builtin_amdgcn_readfirstlane(tq), lim_min = (tq_min - 31) >> 4;
    asm volatile("s_waitcnt vmcnt(0) lgkmcnt(0)" ::: "memory"); __builtin_amdgcn_s_barrier(); asm volatile("" ::: "memory");
    AT_ISSUE(jlo, 0); if (NT > 1) AT_ISSUE(jlo + 1, 1);
    int stg = 0;
    for (int t = 0; t < NT; ++t) {
        const int j = jlo + t; const int buf = stg;
        if (t + 1 < NT) asm volatile("s_waitcnt vmcnt(4)" ::: "memory"); else asm volatile("s_waitcnt vmcnt(0)" ::: "memory");
        __builtin_amdgcn_s_barrier(); asm volatile("" ::: "memory");
        if (t + 2 < NT) { const int s2 = stg == 0 ? 2 : stg - 1; AT_ISSUE(j + 2, s2); }
        bool rowsel = true;
        if (MODE == 1) rowsel = ((bmrow[j >> 5] >> (j & 31)) & 1u) != 0u;
        if (MODE != 1 || __any(rowsel)) {
        f32x16 p0, p1;
        at_qkt(p0, p1, K_lds + buf * 16384, l32, hi, qr, negm);
        const bool need_mask = MODE == 0 ? (64 * j + 63 > lim_min) : (MODE == 1 ? (64 * j + 63 > tq_min) : (64 * j + 63 > tq_min || 64 * j <= tq_min + 7 - WIN));
        if (need_mask) at_mask<MODE>(p0, p1, 64 * j, hi, tq, lim, true);
        bf16x8 pa0, pa1, pa2, pa3;
        const float alpha = at_softmax(p0, p1, m_reg, negm, l_reg, pa0, pa1, pa2, pa3, rowsel, MODE == 1);
        if (__any(alpha < 1.f)) { if (hi == 0) wsl[l32] = alpha; asm volatile("s_waitcnt lgkmcnt(0)" ::: "memory");
#pragma unroll
            for (int d = 0; d < 4; ++d)
#pragma unroll
                for (int r = 0; r < 16; ++r) o[d][r] *= wsl[crow(r, hi)]; }
        at_pv(o, vb0 + buf * 16384, pa0, pa1, pa2, pa3);
        }
        stg = stg == 2 ? 0 : stg + 1;
    }
    asm volatile("s_waitcnt lgkmcnt(0)" ::: "memory");
    if (hi == 0) wsl[32 + l32] = l_reg > 0.f ? 1.f / l_reg : 0.f;
    asm volatile("s_waitcnt lgkmcnt(0)" ::: "memory");
#pragma unroll
    for (int r = 0; r < 16; ++r) { const int q = crow(r, hi); const float rli = wsl[32 + q]; bf16* op = Obase + (size_t)(8 * wave + (q >> 2)) * 2048 + (q & 3) * 128 + l32;
#pragma unroll
        for (int d0 = 0; d0 < 4; ++d0) op[d0 * 32] = (bf16)f2bf(o[d0][r] * rli); }
    m_out = m_reg; l_out = l_reg;
#undef AT_ISSUE
}
__device__ __forceinline__ void at_importance(LAS unsigned char* lds, const bf16x8 (&qr)[8], const bf16* Kb, int nct, int lim, float m_reg, float l_reg, int tid_in) {
    int tid = tid_in; asm volatile("" : "+v"(tid));
    const int lane = tid & 63, wave = __builtin_amdgcn_readfirstlane(tid >> 6), l32 = lane & 31, hi = lane >> 5;
    LAS unsigned char* K_lds = lds + AT_K;
    LAS float* S4L = (LAS float*)(lds + AT_V); LAS float* LASTL = (LAS float*)(lds + AT_V + 16384);
    LAS float* imp = (LAS float*)(lds + AT_IMP); LAS float* carry = (LAS float*)(lds + AT_CARRY);
    const int sr = tid >> 4, sc = (tid & 15) * 8, kws = KSWZ(sr, sc * 2);
    const int head = l32 & 3, tok = 8 * wave + (l32 >> 2);
    const float linv = l_reg > 0.f ? 1.f / l_reg : 0.f; const f32x16 zero16 = {};
    bf16x8 st_k0, st_k1;
    __syncthreads();
    if (tid < 256) carry[tid] = 0.f;
    { const bf16* kp_ = Kb + (size_t)sr * 128 + sc; st_k0 = *(const GAS bf16x8*)kp_; st_k1 = *(const GAS bf16x8*)(kp_ + 32 * 128); }
    *(LAS bf16x8*)(K_lds + kws) = st_k0; *(LAS bf16x8*)(K_lds + kws + 32 * 256) = st_k1;
    __syncthreads();
    for (int t = 0; t < nct; ++t) {
        const int buf = t & 1;
        if (t + 1 < nct) { const bf16* kp_ = Kb + (size_t)(64 * (t + 1) + sr) * 128 + sc; st_k0 = *(const GAS bf16x8*)kp_; st_k1 = *(const GAS bf16x8*)(kp_ + 32 * 128); }
        f32x16 p0, p1;
        at_qkt(p0, p1, K_lds + buf * 16384, l32, hi, qr, zero16);
        at_mask<0>(p0, p1, 64 * t, hi, 0, lim, true);
#pragma unroll
        for (int r = 0; r < 16; ++r) { p0[r] = __builtin_amdgcn_exp2f(p0[r] - m_reg) * linv; p1[r] = __builtin_amdgcn_exp2f(p1[r] - m_reg) * linv; }
        LAS float* sp = S4L + (head * 64 + tok) * 16 + hi; LAS float* lp = LASTL + (head * 64 + tok) * 16 + hi;
#pragma unroll
        for (int q = 0; q < 4; ++q) { sp[2 * q] = (p0[4 * q] + p0[4 * q + 1]) + (p0[4 * q + 2] + p0[4 * q + 3]); lp[2 * q] = p0[4 * q + 3];
                                      sp[8 + 2 * q] = (p1[4 * q] + p1[4 * q + 1]) + (p1[4 * q + 2] + p1[4 * q + 3]); lp[8 + 2 * q] = p1[4 * q + 3]; }
        if (t + 1 < nct) { *(LAS bf16x8*)(K_lds + (buf ^ 1) * 16384 + kws) = st_k0; *(LAS bf16x8*)(K_lds + (buf ^ 1) * 16384 + kws + 32 * 256) = st_k1; }
        __syncthreads();
#pragma unroll
        for (int i = 0; i < 2; ++i) { const int item = tid + 512 * i, tk = item >> 4, gq = item & 15; float a = 0.f;
#pragma unroll
            for (int h = 0; h < 4; ++h) a += S4L[(h * 64 + tk) * 16 + gq] + (gq > 0 ? LASTL[(h * 64 + tk) * 16 + gq - 1] : carry[(t & 1) * 256 + h * 64 + tk]);
            imp[tk * AT_IMPLD + 16 * t + gq] = a; }
        if (tid < 256) carry[((t + 1) & 1) * 256 + tid] = LASTL[tid * 16 + 15];
        __syncthreads();
    }
}
__device__ __forceinline__ void at_topk(LAS unsigned char* lds, int tb, int tid_in) {
    int tid = tid_in; asm volatile("" : "+v"(tid));
    const int lane = tid & 63, wave = __builtin_amdgcn_readfirstlane(tid >> 6);
    const LAS float* imp = (const LAS float*)(lds + AT_IMP); LAS unsigned* bm = (LAS unsigned*)(lds + AT_BM);
    const int nforced = tb >= 2 ? 3 : tb + 1, nfree = SELTOP - nforced, ncand = tb - 2 > 0 ? tb - 2 : 0;
    const int j0 = lane, j1 = lane + 64;
    const bool c0 = j0 >= 1 && j0 <= tb - 2, c1 = j1 <= tb - 2;
    const bool f0 = (j0 == 0) || (j0 == tb) || (j0 == tb - 1), f1 = (j1 == tb) || (j1 == tb - 1);
    for (int i = 0; i < 8; ++i) { const int tk = wave * 8 + i;
        const unsigned k0 = c0 ? __float_as_uint(imp[tk * AT_IMPLD + j0]) + 1u : 0u, k1 = c1 ? __float_as_uint(imp[tk * AT_IMPLD + j1]) + 1u : 0u;
        bool s0, s1;
        if (ncand <= nfree) { s0 = c0; s1 = c1; }
        else {
            unsigned T = 0u;
            for (int b = 31; b >= 0; --b) { const unsigned cnd = T | (1u << b); const int cnt = __popcll(__ballot(k0 >= cnd)) + __popcll(__ballot(k1 >= cnd)); if (cnt >= nfree) T = cnd; }
            const bool g0 = k0 > T, g1 = k1 > T; const int ngt = __popcll(__ballot(g0)) + __popcll(__ballot(g1)); const int need = nfree - ngt;
            const unsigned long long e0 = __ballot(k0 == T), e1 = __ballot(k1 == T); const unsigned long long below = (1ull << lane) - 1ull;
            const int rk0 = __popcll(e0 & below), rk1 = __popcll(e0) + __popcll(e1 & below);
            s0 = g0 || (k0 == T && rk0 < need); s1 = g1 || (k1 == T && rk1 < need);
        }
        const unsigned long long m0 = __ballot(s0 || f0), m1 = __ballot(s1 || f1);
        if (lane == 0) { bm[tk * 4 + 0] = (unsigned)m0; bm[tk * 4 + 1] = (unsigned)(m0 >> 32); bm[tk * 4 + 2] = (unsigned)m1; bm[tk * 4 + 3] = (unsigned)(m1 >> 32); }
    }
}
__device__ __forceinline__ void attn_unit(LAS unsigned char* lds, int g, int tb, const bf16* PROJ, const bf16* KC, const bf16* VC, bf16* AO, int tid) {
    const int lane = tid & 63, wave = __builtin_amdgcn_readfirstlane(tid >> 6), l32 = lane & 31, hi = lane >> 5;
    const int tokl = 8 * wave + (l32 >> 2), head = 4 * g + (l32 & 3), T0 = 64 * tb, tq = T0 + tokl;
    bf16x8 qr[8];
#pragma unroll
    for (int d0 = 0; d0 < 8; ++d0) qr[d0] = *(const GAS bf16x8*)(PROJ + (size_t)tq * NPROJ + OFF_Q + head * 128 + d0 * 16 + hi * 8);
    bf16* Orow0 = AO + (size_t)T0 * 2048 + 4 * g * 128;
    const int nct = tb / 16 + 1; const int lim = (tq - 31) >> 4;
    float m_c, l_c, m_d, l_d;
    at_branch<0>(lds, qr, KC + (size_t)g * 512 * 128, VC + (size_t)g * 512 * 128, 128, 0, nct, tq, lim, nullptr, Orow0, m_c, l_c, tid);
    at_importance(lds, qr, KC + (size_t)g * 512 * 128, nct, lim, m_c, l_c, tid);
    __syncthreads();
    at_topk(lds, tb, tid);
    __syncthreads();
    const LAS unsigned* bmrow = (const LAS unsigned*)(lds + AT_BM) + tokl * 4;
    at_branch<1>(lds, qr, PROJ + OFF_KS + g * 128, PROJ + OFF_VS + g * 128, NPROJ, 0, tb + 1, tq, 0, bmrow, Orow0 + (size_t)S * 2048, m_d, l_d, tid);
    const int jlo = tb - 8 > 0 ? tb - 8 : 0;
    at_branch<2>(lds, qr, PROJ + OFF_KW + g * 128, PROJ + OFF_VW + g * 128, NPROJ, jlo, tb - jlo + 1, tq, 0, nullptr, Orow0 + (size_t)2 * S * 2048, m_d, l_d, tid);
    __syncthreads();
}


constexpr int CM_RED = 0, CM_H = 16384, CM_HLD = 136;
constexpr int CM_STG = 8192 + 32768, CM_NSTG = 3;
static_assert(CM_NSTG * CM_STG <= 131072, "compression ring");
__device__ __forceinline__ void cmp_unit(LAS unsigned char* lds, int kv, int g, int ib, const bf16* PROJ, const bf16* W1T, const bf16* W2T, const float* B1P, bf16* OUT, int tid_in) {
    int tid = tid_in; asm volatile("" : "+v"(tid));
    const int lane = tid & 63, wave = __builtin_amdgcn_readfirstlane(tid >> 6), l32 = lane & 31, hi = lane >> 5, nt = wave & 3, kh = wave >> 2;
    LAS float* red = (LAS float*)(lds + CM_RED); LAS bf16* Hs = (LAS bf16*)(lds + CM_H);
    const int coff = (kv == 0 ? OFF_KC : OFF_VC) + g * 128;
    const int sr = tid >> 4, spc = tid & 15, slc = spc ^ (sr & 7);
    const int ia = 32 * ib + sr, iac = ia < 510 ? ia : 510;
    const char* asrc = (const char*)(PROJ + (size_t)(16 * iac) * NPROJ + coff + 8 * slc);
    const char* bsrc = (const char*)(W1T + (size_t)sr * 4096 + 8 * slc);
    const unsigned ldsw = (unsigned)wave * 1024u;
#define CM_ISSUE(l_, stg_) do { LAS unsigned char* sb_ = lds + (stg_) * CM_STG; \
        __builtin_amdgcn_global_load_lds((const unsigned*)(asrc + (size_t)(l_) * (NPROJ * 2)), (LAS unsigned*)(sb_ + ldsw), 16, 0, 0); \
        _Pragma("unroll") for (int q_ = 0; q_ < 4; ++q_) \
            __builtin_amdgcn_global_load_lds((const unsigned*)(bsrc + (size_t)q_ * (32 * 4096 * 2) + (size_t)(l_) * 256), (LAS unsigned*)(sb_ + 8192 + q_ * 8192 + ldsw), 16, 0, 0); } while (0)
    f32x16 acc = {};
    asm volatile("s_waitcnt vmcnt(0) lgkmcnt(0)" ::: "memory"); __builtin_amdgcn_s_barrier();
    CM_ISSUE(0, 0); CM_ISSUE(1, 1);
    const int sw = l32 & 7;
    for (int l = 0; l < 32; ++l) { const int stg = l % CM_NSTG;
        if (l + 1 < 32) asm volatile("s_waitcnt vmcnt(5)" ::: "memory"); else asm volatile("s_waitcnt vmcnt(0)" ::: "memory");
        __builtin_amdgcn_s_barrier(); asm volatile("" ::: "memory");
        if (l + 2 < 32) CM_ISSUE(l + 2, (l + 2) % CM_NSTG);
        const LAS unsigned char* ap = lds + stg * CM_STG + l32 * 256; const LAS unsigned char* bp = lds + stg * CM_STG + 8192 + (32 * nt + l32) * 256;
#pragma unroll
        for (int kk = 0; kk < 4; ++kk) { const int c = (2 * (4 * kh + kk) + hi) ^ sw;
            const bf16x8 a = *(const LAS bf16x8*)(ap + 16 * c), b = *(const LAS bf16x8*)(bp + 16 * c); acc = __builtin_amdgcn_mfma_f32_32x32x16_bf16(a, b, acc, 0, 0, 0); }
    }
#undef CM_ISSUE
    asm volatile("s_waitcnt lgkmcnt(0)" ::: "memory"); __builtin_amdgcn_s_barrier(); asm volatile("" ::: "memory");
    if (kh == 1) {
#pragma unroll
        for (int r = 0; r < 16; ++r) red[(nt * 16 + r) * 64 + lane] = acc[r]; }
    __syncthreads();
    if (kh == 0) { const int n = 32 * nt + l32; float b1 = 0.f;
#pragma unroll
        for (int kc = 0; kc < 16; ++kc) b1 += B1P[kc * 128 + n];
#pragma unroll
        for (int r = 0; r < 16; ++r) { float v = acc[r] + red[(nt * 16 + r) * 64 + lane] + b1; v = v / (1.f + __expf(-v)); Hs[crow(r, hi) * CM_HLD + n] = (bf16)f2bf(v); } }
    __syncthreads();
    if (wave < 4) { f32x16 a2 = {};
#pragma unroll
        for (int kk = 0; kk < 8; ++kk) { const bf16x8 a = *(const LAS bf16x8*)(Hs + l32 * CM_HLD + 16 * kk + 8 * hi), b = *(const GAS bf16x8*)(W2T + (size_t)(32 * wave + l32) * 128 + 16 * kk + 8 * hi);
            a2 = __builtin_amdgcn_mfma_f32_32x32x16_bf16(a, b, a2, 0, 0, 0); }
#pragma unroll
        for (int r = 0; r < 16; ++r) { const int irow = 32 * ib + crow(r, hi); OUT[(size_t)irow * 128 + 32 * wave + l32] = irow < NCMP ? (bf16)f2bf(a2[r]) : (bf16)0; } }
    __syncthreads();
}

struct Args { const float* in[18]; float* out; unsigned char* ws; };


__global__ void __launch_bounds__(NWAVES * 64, 2) hybrid_fwd(Args args) {
    extern __shared__ __attribute__((aligned(16))) unsigned char lds[];
    Frame F;
    F.lds = (LAS unsigned char*)lds;
    F.MISC = (volatile LAS unsigned*)(F.lds + MISC_OFF);
    F.tid = threadIdx.x; F.lane = F.tid & 63; F.wave = __builtin_amdgcn_readfirstlane(F.tid >> 6);
    F.G = gridDim.x; { const int bx = blockIdx.x; F.vcu = (F.G % 8 == 0) ? (bx % 8) * (F.G / 8) + bx / 8 : bx; }
    unsigned char* ws = args.ws;
    F.ctl = (gu32*)(ws + WS_CTL);
    for (int u = F.tid; u < (LDS_BYTES - LDSCTL_OFF) / 4; u += NWAVES * 64) ((LAS unsigned*)(F.lds + LDSCTL_OFF))[u] = 0u;
    __syncthreads();
    (void)xcd_barrier_post((unsigned*)(F.ctl + CW_BAR), F.MISC + 8);
#define GRID_BAR() do { unsigned long long wz_ = 0; asm volatile("" : "+s"(wz_)); unsigned char* wsb_ = args.ws + wz_;     XcdBarrier b_; b_.bar = (unsigned*)((gu32*)(wsb_ + WS_CTL) + CW_BAR); b_.x = xb_xcc_id(); b_.st = (volatile LAS unsigned*)(F.lds + MISC_OFF) + 8; xcd_barrier(b_); } while (0)
#define PHASE_IDS() int tid_l_ = threadIdx.x; asm volatile("" : "+v"(tid_l_)); const int tid = tid_l_, lane = tid & 63, wave = __builtin_amdgcn_readfirstlane(tid >> 6); \
    const int gw = F.vcu * NWAVES + wave, NGW = F.G * NWAVES, gt = F.vcu * (NWAVES * 64) + tid, NGT = F.G * NWAVES * 64; (void)gw; (void)NGW; (void)gt; (void)NGT; (void)lane

    const float* x_in = args.in[0];
    bf16* XN = (bf16*)(ws + WS_XN); float* COS = (float*)(ws + WS_COS); float* SIN = (float*)(ws + WS_SIN);
    {
        PHASE_IDS();
        LAS float* scr = (LAS float*)(F.lds + RING_OFF + wave * 16384);
        constexpr int I_IN = (DM / 64) * (NPROJ / 32), I_O = (DM / 64) * (DM / 32), I_UP = (DM / 64) * (FF / 32), I_DN = (FF / 64) * (DM / 32);
        constexpr int I_L = I_IN + I_O + I_UP + I_DN;
        for (int rep = 0; rep < REP_PRO; ++rep)
        for (int it = gw; it < DEPTH * I_L; it += NGW) {
            const int l = it / I_L; int r = it % I_L;
            if (r < I_IN) { if (l >= PROJ_F8_FROM) p0_transpose_item_f8<true, 1>(args.in[2] + (size_t)l * DM * NSRC, DM, NSRC, NPROJ / 32, (unsigned char*)(ws + WS_WIN + l * SZ_WIN), WUP8_SCALE, args.in[1] + l * DM, args.in[1] + l * DM, DM, scr, r, lane);
                else p0_transpose_item<1, true>(args.in[2] + (size_t)l * DM * NSRC, DM, NSRC, NPROJ / 32, (bf16*)(ws + WS_WIN + l * SZ_WIN), args.in[1] + l * DM, args.in[1] + l * DM, DM, scr, r, lane); continue; } r -= I_IN;
            if (r < I_O) { if (l >= WO_F8_FROM) p0_transpose_item_f8<true>(args.in[13] + (size_t)l * DM * DM, DM, DM, DM / 32, (unsigned char*)(ws + WS_WO + l * SZ_WO), 64.f, args.in[6] + l * 2048, args.in[12] + l * 2048, 2048, scr, r, lane);
                else p0_transpose_item<0, true>(args.in[13] + (size_t)l * DM * DM, DM, DM, DM / 32, (bf16*)(ws + WS_WO + l * SZ_WO), args.in[6] + l * 2048, args.in[12] + l * 2048, 2048, scr, r, lane); continue; } r -= I_O;
            if (r < I_UP) { p0_transpose_item_f8<true>(args.in[15] + (size_t)l * DM * FF, DM, FF, FF / 32, (unsigned char*)(ws + WS_WUP + l * SZ_WUP), WUP8_SCALE, args.in[14] + l * DM, args.in[14] + l * DM, DM, scr, r, lane); continue; } r -= I_UP;
            p0_transpose_item_f8<false>(args.in[16] + (size_t)l * FF * DM, FF, DM, DM / 32, (unsigned char*)(ws + WS_WDN + l * SZ_WDN), 128.f, args.in[16], args.in[16], 0, scr, r, lane);
        }
        for (int it = gw; it < DEPTH * 2 * (256 + 8); it += NGW) { const int lk = it / 264, r = it % 264, kvv = lk & 1;
            const float* w1 = args.in[4] + (size_t)lk * 4096 * 128; const float* w2 = args.in[5] + (size_t)lk * 128 * 128;
            bf16* w1t = (bf16*)(ws + WS_W1T) + (size_t)lk * 128 * 4096; bf16* w2t = (bf16*)(ws + WS_W2T) + (size_t)lk * 128 * 128;
            if (r < 256) { if (kvv == 0) p0_transpose_item<0, false, true>(w1, 4096, 128, 4, w1t, w1, w1, 0, scr, r, lane); else p0_transpose_item<0, false, false>(w1, 4096, 128, 4, w1t, w1, w1, 0, scr, r, lane); }
            else { if (kvv == 0) p0_transpose_item<2, false, false>(w2, 128, 128, 4, w2t, w2, w2, 0, scr, r - 256, lane); else p0_transpose_item<0, false, false>(w2, 128, 128, 4, w2t, w2, w2, 0, scr, r - 256, lane); } }
        for (int e = gt; e < DEPTH * 2 * 16 * 128; e += NGT) { const int n = e & 127, kc = (e >> 7) & 15, lk = e >> 11;
            const float* w1 = args.in[4] + ((size_t)lk * 4096 + kc * 256) * 128 + n; const float* ps = args.in[3] + (size_t)lk * 4096 + kc * 256; float a = 0.f;
#pragma unroll 32
            for (int k = 0; k < 256; ++k) a += ps[k] * w1[(size_t)k * 128];
            ((float*)(ws + WS_B1P))[e] = a; }
        for (int e = gt; e < S * 64; e += NGT) { const int t = e >> 6, i = e & 63;
            const float inv = 1.0f / powf(10000.0f, (float)i * (1.0f / 64.0f)); const float ang = (float)t * inv;
            COS[e] = cosf(ang); SIN[e] = sinf(ang); }
        for (int m = gw; m < S; m += NGW) rms_row_to_bf16(x_in + (size_t)m * DM, XN + (size_t)m * DM, lane);
    }
    GRID_BAR();

    for (int L = 0; L < DEPTH; ++L) {
        { unsigned long long wz = 0; asm volatile("" : "+s"(wz)); ws = args.ws + wz; }
        bf16* Hres = (bf16*)(ws + WS_H);     static_assert(DEPTH == 2 && WO_F8_FROM == 1 && PROJ_F8_FROM == 1, "the phase instantiations below are written for this precision plan");
        bf16* XN = (bf16*)(ws + WS_XN); bf16* PROJ = (bf16*)(ws + WS_PROJ); bf16* ACT = (bf16*)(ws + WS_ACT); unsigned char* CAT = (unsigned char*)(ws + WS_CAT);     const bool wo_f8 = L >= WO_F8_FROM;
        float* ATT = (float*)(ws + WS_ATT); bf16* XBC = (bf16*)(ws + WS_XBC); bf16* Y = (bf16*)(ws + WS_Y);
        bf16* KC = (bf16*)(ws + WS_KC); bf16* VC = (bf16*)(ws + WS_VC); float* DT = (float*)(ws + WS_DT); float* ADT = (float*)(ws + WS_ADT);
        float* COS = (float*)(ws + WS_COS); float* SIN = (float*)(ws + WS_SIN); unsigned* BMP = (unsigned*)(ws + WS_BMP);
        bf16* AO = (bf16*)(ws + WS_ACT);     float* STT = (float*)(ws + WS_ST); bf16* PREVB = (bf16*)(ws + WS_PREV);     float* ACSG = (float*)(ws + WS_ACSG); float* DEC = (float*)(ws + WS_DEC);

        {
            const bool split = (L < PROJ_F8_FROM) && (F.G == 256);
            if (L >= PROJ_F8_FROM) { pg8::StaticOrder So; So.init(S, NPROJ, F.G, (int)blockIdx.x); pg8::Gemm g{XN, (const bf16*)(ws + WS_WIN + L * SZ_WIN), S, NPROJ, DM / 2};
                pg8::EpiProj E{PROJ, NPROJ, COS, SIN, QSCALE, 1.f / (XN8_SCALE * WUP8_SCALE), 0};
                pg8::gemm_phase<pg8::EpiProj, pg8::StaticOrder, true, true, true>(F.lds + RING_OFF, g, So, E); }
            else {
#pragma unroll 1
                for (int part = 0; part < (split ? 2 : 1); ++part) { const int c0p = part ? P1_SPLIT : 0, ncp = split ? (part ? NPROJ - P1_SPLIT : P1_SPLIT) : NPROJ;
                    pg8::StaticOrder So; So.init(S, ncp, F.G, (int)blockIdx.x); pg8::Gemm g{XN, (const bf16*)(ws + WS_WIN + L * SZ_WIN) + (size_t)c0p * DM, S, ncp, DM};
                    pg8::EpiProj E{PROJ, NPROJ, COS, SIN, QSCALE, 1.f, c0p / 256};
                    pg8::gemm_phase<pg8::EpiProj, pg8::StaticOrder, true, true>(F.lds + RING_OFF, g, So, E);
                    if (split && part == 0) GRID_BAR(); } }
        }
        {
            const bool split = (L < PROJ_F8_FROM) && (F.G == 256); const int bxp = bx_l(); const bool early = split && bxp >= (NPROJ - P1_SPLIT) / 256 * 32;
            const int ew = ((F.vcu >> 5) * 12 + ((F.vcu & 31) - 20));
#pragma unroll 1
            for (int pass = 0; pass < 2; ++pass) {
                const bool run = pass == 0 ? early : !split;
                if (run) {
                    PHASE_IDS();
#pragma unroll 1
                    for (int pv = (pass == 0 ? ew : F.vcu); pv < (pass == 0 ? 256 : F.vcu + 1); pv += 96) {
                        asm volatile("s_waitcnt vmcnt(0) lgkmcnt(0)" ::: "memory"); __syncthreads();
            for (int rep = 0; rep < REP_CMP; ++rep)
            for (int u = pv; u < 2 * NKV * 16; u += F.G) { const int kvv = u >> 6, g = (u >> 4) & 3, ib = u & 15; const int lk = L * 2 + kvv;
                cmp_unit(F.lds + RING_OFF, kvv, g, ib, PROJ, (const bf16*)(ws + WS_W1T) + (size_t)lk * 128 * 4096, (const bf16*)(ws + WS_W2T) + (size_t)lk * 128 * 128,
                         (const float*)(ws + WS_B1P) + (size_t)lk * 16 * 128, (kvv == 0 ? KC : VC) + (size_t)g * 512 * 128, tid); }
            { const float* cvw = args.in[7] + (size_t)L * 4 * CONVD; const float* cvb = args.in[8] + (size_t)L * CONVD; const int c0 = 8 * tid;
              float wv[4][8], bv[8];
#pragma unroll
              for (int j = 0; j < 8; ++j) bv[j] = cvb[c0 + j];
#pragma unroll
              for (int k = 0; k < 4; ++k)
#pragma unroll
                  for (int j = 0; j < 8; ++j) wv[k][j] = cvw[k * CONVD + c0 + j];
              const bool cv_w = (F.G == 256); const int nblk = cv_w ? (pv < 128 ? 1 : 7) : 1, blk0 = cv_w ? (pv < 128 ? pv : 128 + 7 * (pv - 128)) : pv, bstep = cv_w ? 1 : F.G, bend = cv_w ? blk0 + nblk : S / 8;
              for (int rep = 0; rep < REP_CONV; ++rep)
              for (int blk = blk0; blk < bend; blk += bstep) { const int t0 = 8 * blk;
                v4u rw[11];
#pragma unroll
                for (int i = 0; i < 11; ++i) { const int tt = t0 - 3 + i; rw[i] = tt >= 0 ? *(const GAS v4u*)(PROJ + (size_t)tt * NPROJ + OFF_XBC + c0) : (v4u){0u, 0u, 0u, 0u}; }
#pragma unroll
                for (int o8 = 0; o8 < 8; ++o8) { float a[8];
#pragma unroll
                    for (int j = 0; j < 8; ++j) a[j] = bv[j];
#pragma unroll
                    for (int k = 0; k < 4; ++k) { const v4u w = rw[o8 + k];
                        const float f[8] = {bflo(w.x), bfhi(w.x), bflo(w.y), bfhi(w.y), bflo(w.z), bfhi(w.z), bflo(w.w), bfhi(w.w)};
#pragma unroll
                        for (int j = 0; j < 8; ++j) a[j] += f[j] * wv[k][j]; }
#pragma unroll
                    for (int j = 0; j < 8; ++j) a[j] = a[j] / (1.f + __expf(-a[j]));
                    v4u o; o.x = pk2(a[0], a[1]); o.y = pk2(a[2], a[3]); o.z = pk2(a[4], a[5]); o.w = pk2(a[6], a[7]);
                    *(GAS v4u*)(XBC + (size_t)(t0 + o8) * CONVD + c0) = o; } } }
                    }
                }
                if (pass == 0) { GRID_BAR(); for (int rb = 0; rb < REP_BAR; ++rb) GRID_BAR(); }
            }
        }
        if (!((L < PROJ_F8_FROM) && (F.G == 256))) GRID_BAR();
        {
            PHASE_IDS();
            for (int rep = 0; rep < REP_ATTN; ++rep)
            for (int u = F.vcu; u < 256; u += F.G) { const int g = u & 3, tbp = u >> 2;
#pragma unroll 1
                for (int uu = 0; uu < 2; ++uu) attn_unit(F.lds + RING_OFF, g, uu ? tbp : 127 - tbp, PROJ, KC, VC, AO, tid); }
        }
        __syncthreads();
        {
            PHASE_IDS();
            for (int rep = 0; rep < REP_SSD; ++rep)
            for (int u = F.vcu; u < NCHUNK * SSM_G; u += F.G) ssd1_unit(F.lds + RING_OFF, u >> 3, u & 7, XBC, PROJ, args.in[9] + L * 32, args.in[10] + L * 32, Y, STT, DEC, ACSG, tid);
        }
        GRID_BAR();
        {
            PHASE_IDS();
            for (int rep = 0; rep < REP_AN; ++rep)
            for (int t = gw; t < S; t += NGW) {
                f32x4 v[8]; float s = 0.f;
#pragma unroll
                for (int j = 0; j < 8; ++j) { const int hd = 2 * j + (lane >> 5); const bf16* gp = PROJ + (size_t)t * NPROJ + OFF_G + hd;
                    const float g0 = 1.f / (1.f + __expf(-bf2f(gp[0]))), g1 = 1.f / (1.f + __expf(-bf2f(gp[16]))), g2 = 1.f / (1.f + __expf(-bf2f(gp[32])));
                    const size_t off = (size_t)t * 2048 + 256 * j + 4 * lane;
                    const unsigned long long u0 = *(const GAS unsigned long long*)(AO + off), u1 = *(const GAS unsigned long long*)(AO + (size_t)S * 2048 + off), u2 = *(const GAS unsigned long long*)(AO + (size_t)2 * S * 2048 + off);
                    const f32x4 a0 = {bflo((unsigned)u0), bfhi((unsigned)u0), bflo((unsigned)(u0 >> 32)), bfhi((unsigned)(u0 >> 32))}, a1 = {bflo((unsigned)u1), bfhi((unsigned)u1), bflo((unsigned)(u1 >> 32)), bfhi((unsigned)(u1 >> 32))},
                                a2 = {bflo((unsigned)u2), bfhi((unsigned)u2), bflo((unsigned)(u2 >> 32)), bfhi((unsigned)(u2 >> 32))};
                    v[j] = a0 * g0 + a1 * g1 + a2 * g2; s += (v[j].x * v[j].x + v[j].y * v[j].y) + (v[j].z * v[j].z + v[j].w * v[j].w); }
                const float rstd = 1.f / sqrtf(wave_sum(s) * (1.f / 2048.f) + EPS);
                if (wo_f8) { GAS unsigned* o4 = (GAS unsigned*)(CAT + (size_t)t * DM) + lane;
#pragma unroll
                    for (int j = 0; j < 8; ++j) o4[64 * j] = pg8::pk4_fp8(v[j].x * rstd, v[j].y * rstd, v[j].z * rstd, v[j].w * rstd); }
                else { GAS unsigned long long* o8 = (GAS unsigned long long*)((bf16*)CAT + (size_t)t * DM) + lane;
#pragma unroll
                    for (int j = 0; j < 8; ++j) o8[64 * j] = (unsigned long long)pk2(v[j].x * rstd, v[j].y * rstd) | ((unsigned long long)pk2(v[j].z * rstd, v[j].w * rstd) << 32); }
            }
            for (int rep = 0; rep < REP_SCAN; ++rep)
            for (int e = gt; e < SSM_H * SSM_P * SSM_N; e += NGT) { const int h = e >> 13; float st = 0.f; float sv[NCHUNK], dv[NCHUNK];
#pragma unroll
                for (int c = 0; c < NCHUNK; ++c) { sv[c] = STT[(size_t)c * (SSM_H * SSM_P * SSM_N) + e]; dv[c] = DEC[c * 32 + h]; }
#pragma unroll
                for (int c = 0; c < NCHUNK; ++c) { PREVB[(size_t)c * (SSM_H * SSM_P * SSM_N) + e] = (bf16)f2bf(st); st = dv[c] * st + sv[c]; } }
        }
        GRID_BAR();
        {
            PHASE_IDS();
            const float* dsk = args.in[11] + L * 32;
            for (int rep = 0; rep < REP_SSD3; ++rep)
            for (int u = F.vcu; u < NCHUNK * SSM_G; u += F.G) ssd3_unit(F.lds + RING_OFF, u >> 3, u & 7, XBC, PROJ, Y, (bf16*)ATT, PREVB, ACSG, dsk, CAT, wo_f8, tid);
        }
        GRID_BAR();
        {
            pg8::StaticOrder So; So.init(S, DM, F.G, (int)blockIdx.x);
            if (wo_f8) { pg8::Gemm g{(const bf16*)CAT, (const bf16*)(ws + WS_WO + L * SZ_WO), S, DM, DM / 2};
                pg8::EpiResidH<false> E{Hres, (pg8::bf16_t*)Hres, DM, 1.f / 64.f};
                pg8::gemm_phase<pg8::EpiResidH<false>, pg8::StaticOrder, true, true, true>(F.lds + RING_OFF, g, So, E); }
            else { pg8::Gemm g{(const bf16*)CAT, (const bf16*)(ws + WS_WO + L * SZ_WO), S, DM, DM};
                pg8::EpiResidH<true> E{x_in, (pg8::bf16_t*)Hres, DM, 1.f};
                pg8::gemm_phase<pg8::EpiResidH<true>, pg8::StaticOrder, true, true>(F.lds + RING_OFF, g, So, E); }
        }
        GRID_BAR();
        { PHASE_IDS(); for (int rep = 0; rep < REP_RMS; ++rep) for (int m = gw; m < S; m += NGW) rms_rowh_to_fp8(Hres + (size_t)m * DM, (unsigned char*)XN + (size_t)m * DM, lane); }
        GRID_BAR();
        {
            pg8::Gemm g{XN, (const bf16*)(ws + WS_WUP + L * SZ_WUP), S, FF, DM / 2}; pg8::StaticOrder So; So.init(S, FF, F.G, (int)blockIdx.x);
            pg8::EpiRelu2F8 E{(unsigned char*)ACT, FF, 1.f / (XN8_SCALE * WUP8_SCALE)};
            for (int rep = 0; rep < REP_UP; ++rep)
            pg8::gemm_phase<pg8::EpiRelu2F8, pg8::StaticOrder, true, true, true>(F.lds + RING_OFF, g, So, E);
        }
        GRID_BAR();
        {
            pg8::Gemm g{ACT, (const bf16*)(ws + WS_WDN + L * SZ_WDN), S, DM, FF / 2}; pg8::StaticOrder So; So.init(S, DM, F.G, (int)blockIdx.x);
            pg8::EpiResidH<false> E{Hres, (pg8::bf16_t*)Hres, DM, 1.f / 128.f};
            pg8::gemm_phase<pg8::EpiResidH<false>, pg8::StaticOrder, true, true, true>(F.lds + RING_OFF, g, So, E);
        }
        GRID_BAR();
        if (L + 1 < DEPTH) { PHASE_IDS(); for (int m = gw; m < S; m += NGW) rms_rowh_to_fp8(Hres + (size_t)m * DM, (unsigned char*)XN + (size_t)m * DM, lane); GRID_BAR(); }
        else {
            PHASE_IDS();
            const float* nf = args.in[17];
            for (int rep = 0; rep < REP_FIN; ++rep)
            for (int m = gw; m < S; m += NGW) {
                const GAS v4u* xr = (const GAS v4u*)(Hres + (size_t)m * DM) + lane; v4u v[8]; float s = 0.f;
#pragma unroll
                for (int j = 0; j < 8; ++j) { v[j] = xr[64 * j]; const float a0 = bflo(v[j].x), a1 = bfhi(v[j].x), a2 = bflo(v[j].y), a3 = bfhi(v[j].y), a4 = bflo(v[j].z), a5 = bfhi(v[j].z), a6 = bflo(v[j].w), a7 = bfhi(v[j].w);
                    s += ((a0 * a0 + a1 * a1) + (a2 * a2 + a3 * a3)) + ((a4 * a4 + a5 * a5) + (a6 * a6 + a7 * a7)); }
                const float rstd = 1.f / sqrtf(wave_sum(s) * (1.f / DM) + EPS);
                GAS f32x4* o4 = (GAS f32x4*)(args.out + (size_t)m * DM) + 2 * lane; const GAS f32x4* w4 = (const GAS f32x4*)nf + 2 * lane;
#pragma unroll
                for (int j = 0; j < 8; ++j) { const f32x4 g0 = w4[128 * j], g1 = w4[128 * j + 1];
                    o4[128 * j] = (f32x4){bflo(v[j].x), bfhi(v[j].x), bflo(v[j].y), bfhi(v[j].y)} * rstd * g0; o4[128 * j + 1] = (f32x4){bflo(v[j].z), bfhi(v[j].z), bflo(v[j].w), bfhi(v[j].w)} * rstd * g1; }
            }
        }
    }
}

extern "C" void kernel_launch(void* const* d_in, const int* in_sizes, int n_in, void* d_out, int out_size, void* d_ws, size_t ws_size, hipStream_t stream) {
    static int grid = 0;
    if (grid == 0) {
        if (n_in != 18 || in_sizes[0] != S * DM || out_size != S * DM || ws_size < WS_END) { fprintf(stderr, "kernel_launch: shape/workspace mismatch: n_in %d in0 %d out %d ws %zu (need %zu)\n", n_in, n_in > 0 ? in_sizes[0] : -1, out_size, ws_size, (size_t)WS_END); grid = -1; return; }
        int dev = 0, cus = 0, per_cu = 0;
        if (hipGetDevice(&dev) != hipSuccess || hipDeviceGetAttribute(&cus, hipDeviceAttributeMultiprocessorCount, dev) != hipSuccess) { grid = -1; return; }
        if (hipFuncSetAttribute((const void*)hybrid_fwd, hipFuncAttributeMaxDynamicSharedMemorySize, LDS_BYTES) != hipSuccess) { fprintf(stderr, "kernel_launch: hipFuncSetAttribute failed\n"); grid = -1; return; }
        if (hipOccupancyMaxActiveBlocksPerMultiprocessor(&per_cu, (const void*)hybrid_fwd, NWAVES * 64, LDS_BYTES) != hipSuccess || per_cu < 1) fprintf(stderr, "kernel_launch: occupancy query reports %d\n", per_cu);
        (void)hipGetLastError();
        grid = cus;
    }
    if (grid < 0) return;
    if (hipMemsetAsync((char*)d_ws + WS_CTL, 0, CTL_ZERO_BYTES, stream) != hipSuccess) return;
    Args a{};
    for (int i = 0; i < 18; ++i) a.in[i] = (const float*)d_in[i];
    a.out = (float*)d_out; a.ws = (unsigned char*)d_ws;
    hipLaunchKernelGGL(hybrid_fwd, dim3(grid), dim3(NWAVES * 64), LDS_BYTES, stream, a);
}
```

```cpp
#include <hip/hip_runtime.h>
#include <cstdio>
#include <cstdint>
#include <cmath>
#ifndef REP_ATTN
#define REP_ATTN 1
#endif
#ifndef REP_UP
#define REP_UP 1
#endif
#ifndef REP_CMP
#define REP_CMP 1
#endif
#ifndef REP_PRO
#define REP_PRO 1
#endif
#ifndef REP_SSD
#define REP_SSD 1
#endif
#ifndef REP_LIGHT
#define REP_LIGHT 1
#endif
#ifndef REP_RMS
#define REP_RMS 1
#endif
#ifndef REP_CONV
#define REP_CONV 1
#endif
#ifndef REP_AN
#define REP_AN 1
#endif
#ifndef REP_SCAN
#define REP_SCAN 1
#endif
#ifndef REP_PROJ
#define REP_PROJ 1
#endif
#ifndef REP_BAR
#define REP_BAR 0
#endif
#ifndef REP_FIN
#define REP_FIN 1
#endif
#ifndef REP_SSD3
#define REP_SSD3 1
#endif
namespace pg8 {
#define PG8_LAS __attribute__((address_space(3)))
typedef unsigned short bf16_t;
typedef short bf16x8 __attribute__((ext_vector_type(8)));
typedef float f32x4 __attribute__((ext_vector_type(4)));
typedef unsigned u32x4 __attribute__((ext_vector_type(4)));
typedef int i32x4 __attribute__((ext_vector_type(4)));
typedef int i32x8 __attribute__((ext_vector_type(8)));
constexpr int BM = 256, BK = 64, HALF = 128, HTB = HALF * BK * 2  , STAGE_BYTES = 8 * HTB, NXCD = 8, WGM = 8;

__host__ __device__ __forceinline__ int lds_byte(int r, int c) { const int st = (r >> 4) * 2 + (c >> 5), rr = r & 15, cc = c & 31, ob = rr * 64 + cc * 2; return st * 1024 + (ob ^ (((ob >> 9) & 1) << 5)); }
__host__ __device__ __forceinline__ void stage_rc(int b, int& R, int& C) { const int st = b / 1024, sb = b % 1024, swz = sb ^ (((sb >> 9) & 1) << 5); R = (st >> 1) * 16 + swz / 64; C = (st & 1) * 32 + (swz % 64) / 2; }
__host__ __device__ __forceinline__ int perm32(int rho) { const int n = rho >> 4, i = rho & 15; return 8 * (i >> 2) + 4 * n + (i & 3); }

struct Unit { int pm, pn; };
struct Gemm { const bf16_t* A; const bf16_t* Bt; int M, N, K; };

struct StaticOrder {
    int nM, nN, nwg, G, c;
    __host__ __device__ void init(int M, int N, int G_, int c_) { nM = M / BM; nN = N / BM; nwg = nM * nN; G = G_; c = c_; }
    __host__ __device__ bool next(int i, Unit& u) const {
        const long L = (long)i * G + c; if (L >= nwg) return false;
        int wgid = (int)L; { const int q = nwg / NXCD, r = nwg % NXCD, xcd = wgid % NXCD, off = wgid / NXCD; wgid = (xcd < r ? xcd * (q + 1) : r * (q + 1) + (xcd - r) * q) + off; }
        const int nig = WGM * nN, gid = wgid / nig, fm = gid * WGM, gsz = (nM - fm) < WGM ? (nM - fm) : WGM;
        u.pm = fm + ((wgid % nig) % gsz); u.pn = (wgid % nig) / gsz; return true;
    }
    __device__ __forceinline__ void a_ready(const Unit&) const {}
    __device__ __forceinline__ void done(const Unit&) const {}
};

__device__ __forceinline__ unsigned cvt_pk_bf16(float lo, float hi) { unsigned r; asm volatile("v_cvt_pk_bf16_f32 %0, %1, %2" : "=v"(r) : "v"(lo), "v"(hi)); return r; }
typedef float f32x2 __attribute__((ext_vector_type(2)));
struct EpiProj {
    static constexpr bool PERM = true, AFTER_DRAIN = false;
    bf16_t* O; int ldc; const float* cosT; const float* sinT; float qscale; float osc; int pn0;
    template <bool ROPE>
    __device__ __forceinline__ void body(const f32x4 (&acc)[2][2][4][2], int row0, int colt, int cw, float sc) const {
        f32x4 ca[8], sa[8];
#define EPIPROJ_LD(g) do { const int row_ = row0 + ((g) >> 2) * HALF + ((g) & 3) * 16; ca[g] = *(const f32x4*)(cosT + (size_t)row_ * 64 + (cw >> 1)); sa[g] = *(const f32x4*)(sinT + (size_t)row_ * 64 + (cw >> 1)); } while (0)
        if (ROPE) { EPIPROJ_LD(0); EPIPROJ_LD(1); EPIPROJ_LD(2); EPIPROJ_LD(3); asm volatile("" ::: "memory"); }
#pragma unroll
        for (int g = 0; g < 8; ++g) { const int ai = g >> 2, m = g & 3; const int row = row0 + ai * HALF + m * 16;
            if (ROPE && g == 2) { asm volatile("" ::: "memory"); EPIPROJ_LD(4); EPIPROJ_LD(5); EPIPROJ_LD(6); EPIPROJ_LD(7); asm volatile("" ::: "memory"); }
#pragma unroll
            for (int bj = 0; bj < 2; ++bj) {
                f32x4 v0 = acc[ai][bj][m][0], v1 = acc[ai][bj][m][1];
                if (ROPE) { const f32x4 cc = ca[g], ss = sa[g]; f32x4 r0, r1;
                    r0[0] = v0[0] * cc[0] - v0[1] * ss[0]; r0[1] = v0[1] * cc[0] + v0[0] * ss[0];
                    r0[2] = v0[2] * cc[1] - v0[3] * ss[1]; r0[3] = v0[3] * cc[1] + v0[2] * ss[1];
                    r1[0] = v1[0] * cc[2] - v1[1] * ss[2]; r1[1] = v1[1] * cc[2] + v1[0] * ss[2];
                    r1[2] = v1[2] * cc[3] - v1[3] * ss[3]; r1[3] = v1[3] * cc[3] + v1[2] * ss[3];
                    v0 = r0; v1 = r1; }
                v0 = v0 * sc; v1 = v1 * sc;
                u32x4 w; w.x = cvt_pk_bf16(v0[0], v0[1]); w.y = cvt_pk_bf16(v0[2], v0[3]); w.z = cvt_pk_bf16(v1[0], v1[1]); w.w = cvt_pk_bf16(v1[2], v1[3]);
                *(u32x4*)(O + (size_t)row * ldc + colt + bj * HALF + cw) = w; } }
#undef EPIPROJ_LD
    }
    __device__ __forceinline__ void operator()(const f32x4 (&acc)[2][2][4][2], const Unit& u, int wr, int wc, int fr, int fq) const {
        const int row0 = u.pm * BM + wr * 64 + fr; const int colt = (u.pn + pn0) * BM; const int cw = wc * 32 + 8 * fq;
        const int blk0 = 2 * (u.pn + pn0);
        const bool rope = blk0 < 16 || (blk0 < 40 && ((((blk0 - 16) >> 2) & 1) == 0)); const float sc = (blk0 < 16 ? qscale : 1.f) * osc;
        if (rope) body<true>(acc, row0, colt, cw, sc); else body<false>(acc, row0, colt, cw, sc);
    }
};
struct EpiResid {
    static constexpr bool PERM = false, AFTER_DRAIN = false;
    const float* base; float* out; int ldc; float scale;
    __device__ __forceinline__ void operator()(const f32x4 (&acc)[2][2][4][2], const Unit& u, int wr, int wc, int fr, int fq) const {
        const int row0 = u.pm * BM + wr * 64 + fr, col0 = u.pn * BM + wc * 32 + 4 * fq;
        f32x4 cur[2][2], nxt[2][2];
        { const size_t off = (size_t)row0 * ldc + col0;
#pragma unroll
          for (int bj = 0; bj < 2; ++bj)
#pragma unroll
              for (int n = 0; n < 2; ++n) cur[bj][n] = *(const f32x4*)(base + off + bj * HALF + n * 16); }
#pragma unroll
        for (int gi = 0; gi < 8; ++gi) { const int ai = gi >> 2, m = gi & 3; const size_t off = (size_t)(row0 + ai * HALF + m * 16) * ldc + col0;
            if (gi < 7) { const int ai2 = (gi + 1) >> 2, m2 = (gi + 1) & 3; const size_t off2 = (size_t)(row0 + ai2 * HALF + m2 * 16) * ldc + col0;
#pragma unroll
                for (int bj = 0; bj < 2; ++bj)
#pragma unroll
                    for (int n = 0; n < 2; ++n) nxt[bj][n] = *(const f32x4*)(base + off2 + bj * HALF + n * 16); }
            asm volatile("" ::: "memory");
#pragma unroll
            for (int bj = 0; bj < 2; ++bj)
#pragma unroll
                for (int n = 0; n < 2; ++n) *(f32x4*)(out + off + bj * HALF + n * 16) = cur[bj][n] + acc[ai][bj][m][n] * scale;
            asm volatile("" ::: "memory");
#pragma unroll
            for (int bj = 0; bj < 2; ++bj)
#pragma unroll
                for (int n = 0; n < 2; ++n) cur[bj][n] = nxt[bj][n]; }
    }
};

template <bool BASE_F32>
struct EpiResidH {
    static constexpr bool PERM = true, AFTER_DRAIN = false;
    const void* base; bf16_t* out; int ldc; float scale;
    __device__ __forceinline__ void ld(f32x4 (&d)[2][2], size_t off) const {
#pragma unroll
        for (int bj = 0; bj < 2; ++bj) {
            if (BASE_F32) { const float* b = (const float*)base + off + bj * HALF; d[bj][0] = *(const f32x4*)b; d[bj][1] = *(const f32x4*)(b + 4); }
            else { const u32x4 w = *(const u32x4*)((const bf16_t*)base + off + bj * HALF);
                d[bj][0] = (f32x4){__uint_as_float(w.x << 16), __uint_as_float(w.x & 0xffff0000u), __uint_as_float(w.y << 16), __uint_as_float(w.y & 0xffff0000u)};
                d[bj][1] = (f32x4){__uint_as_float(w.z << 16), __uint_as_float(w.z & 0xffff0000u), __uint_as_float(w.w << 16), __uint_as_float(w.w & 0xffff0000u)}; } }
    }
    __device__ __forceinline__ void operator()(const f32x4 (&acc)[2][2][4][2], const Unit& u, int wr, int wc, int fr, int fq) const {
        const int row0 = u.pm * BM + wr * 64 + fr, col0 = u.pn * BM + wc * 32 + 8 * fq;
        f32x4 cur[2][2], nxt[2][2];
        ld(cur, (size_t)row0 * ldc + col0);
#pragma unroll
        for (int gi = 0; gi < 8; ++gi) { const int ai = gi >> 2, m = gi & 3; const size_t off = (size_t)(row0 + ai * HALF + m * 16) * ldc + col0;
            if (gi < 7) { const int ai2 = (gi + 1) >> 2, m2 = (gi + 1) & 3; ld(nxt, (size_t)(row0 + ai2 * HALF + m2 * 16) * ldc + col0); }
            asm volatile("" ::: "memory");
#pragma unroll
            for (int bj = 0; bj < 2; ++bj) { const f32x4 v0 = cur[bj][0] + acc[ai][bj][m][0] * scale, v1 = cur[bj][1] + acc[ai][bj][m][1] * scale;
                u32x4 w; w.x = cvt_pk_bf16(v0[0], v0[1]); w.y = cvt_pk_bf16(v0[2], v0[3]); w.z = cvt_pk_bf16(v1[0], v1[1]); w.w = cvt_pk_bf16(v1[2], v1[3]);
                *(u32x4*)(out + off + bj * HALF) = w; }
            asm volatile("" ::: "memory");
#pragma unroll
            for (int bj = 0; bj < 2; ++bj) { cur[bj][0] = nxt[bj][0]; cur[bj][1] = nxt[bj][1]; } }
    }
};
struct EpiRelu2 {
    static constexpr bool PERM = true, AFTER_DRAIN = false;
    bf16_t* O; int ldc;
    __device__ __forceinline__ void operator()(const f32x4 (&acc)[2][2][4][2], const Unit& u, int wr, int wc, int fr, int fq) const {
        const int row0 = u.pm * BM + wr * 64 + fr; const int col0 = u.pn * BM + wc * 32 + 8 * fq;
#pragma unroll
        for (int ai = 0; ai < 2; ++ai)
#pragma unroll
            for (int m = 0; m < 4; ++m) { bf16_t* rowp = O + (size_t)(row0 + ai * HALF + m * 16) * ldc + col0;
#pragma unroll
                for (int bj = 0; bj < 2; ++bj) { f32x4 v0 = acc[ai][bj][m][0], v1 = acc[ai][bj][m][1];
#pragma unroll
                    for (int e = 0; e < 4; ++e) { const float a = fmaxf(v0[e], 0.f), b = fmaxf(v1[e], 0.f); v0[e] = a * a; v1[e] = b * b; }
                    u32x4 w; w.x = cvt_pk_bf16(v0[0], v0[1]); w.y = cvt_pk_bf16(v0[2], v0[3]); w.z = cvt_pk_bf16(v1[0], v1[1]); w.w = cvt_pk_bf16(v1[2], v1[3]);
                    *(u32x4*)(rowp + bj * HALF) = w; } }
    }
};

__device__ __forceinline__ unsigned pk4_fp8(float a, float b, float c, float d) {
    a = fminf(fmaxf(a, -448.f), 448.f); b = fminf(fmaxf(b, -448.f), 448.f); c = fminf(fmaxf(c, -448.f), 448.f); d = fminf(fmaxf(d, -448.f), 448.f);
    int w = __builtin_amdgcn_cvt_pk_fp8_f32(a, b, 0, false); w = __builtin_amdgcn_cvt_pk_fp8_f32(c, d, w, true); return (unsigned)w; }
struct EpiRelu2F8 {
    static constexpr bool PERM = true, AFTER_DRAIN = false;
    unsigned char* O; int ldc; float sc;
    __device__ __forceinline__ void operator()(const f32x4 (&acc)[2][2][4][2], const Unit& u, int wr, int wc, int fr, int fq) const {
        const int row0 = u.pm * BM + wr * 64 + fr; const int col0 = u.pn * BM + wc * 32 + 8 * fq;
        const int odd = fq & 1;
#pragma unroll
        for (int ai = 0; ai < 2; ++ai)
#pragma unroll
            for (int bj = 0; bj < 2; ++bj) { unsigned lo[4], hi[4];
#pragma unroll
                for (int m = 0; m < 4; ++m) { f32x4 v0 = acc[ai][bj][m][0], v1 = acc[ai][bj][m][1];
#pragma unroll
                    for (int e = 0; e < 4; ++e) { const float a = fmaxf(v0[e] * sc, 0.f), b = fmaxf(v1[e] * sc, 0.f); v0[e] = a * a; v1[e] = b * b; }
                    lo[m] = pk4_fp8(v0[0], v0[1], v0[2], v0[3]); hi[m] = pk4_fp8(v1[0], v1[1], v1[2], v1[3]); }
#pragma unroll
                for (int mp = 0; mp < 4; mp += 2) {
                    auto rl = __builtin_amdgcn_permlane16_swap(lo[mp], lo[mp + 1], false, false); auto rh = __builtin_amdgcn_permlane16_swap(hi[mp], hi[mp + 1], false, false);
                    u32x4 w; w.x = rl[0]; w.y = rh[0]; w.z = rl[1]; w.w = rh[1];
                    *(u32x4*)(O + (size_t)(row0 + ai * HALF + (mp + odd) * 16) * ldc + col0 + bj * HALF - 8 * odd) = w; } }
    }
};
template <class Epi, class Sched, bool ALIGN_EPI = false, bool SP2 = false, bool F8 = false>
__device__ __forceinline__ void gemm_phase(PG8_LAS unsigned char* lds, const Gemm g, const Sched& S, const Epi& E) {
    int tid_o = threadIdx.x; asm volatile("" : "+v"(tid_o));
    const int tid = tid_o, wid = __builtin_amdgcn_readfirstlane(tid >> 6), lane = tid & 63, wr = wid >> 2, wc = wid & 3, fr = lane & 15, fq = lane >> 4;
    const int K = g.K, nt = K / BK;
    unsigned voffA[2], voffB[2];
#pragma unroll
    for (int i = 0; i < 2; ++i) { int R, C; stage_rc(tid * 16 + i * 8192, R, C); const int Rb = Epi::PERM ? ((R & ~31) + perm32(R & 31)) : R;
        voffA[i] = (unsigned)(R * K + C) * 2u; voffB[i] = (unsigned)(Rb * K + C) * 2u; }
    const size_t kstep = (size_t)(BK * 2);
    const size_t hstep = (size_t)HALF * K * 2;
    const size_t tstep = 2 * hstep;
    const unsigned ldsw = (unsigned)wid * 1024u;
    const int aoff = lds_byte(wr * 64 + fr, fq * 8), boff = lds_byte(wc * 32 + fr, fq * 8);
#define PG8_SA(b, h) (((b) * 2 + (h)) * HTB)
#define PG8_SB(b, h) ((4 + (b) * 2 + (h)) * HTB)
#define PG8_STAGE(bufoff, gbase, voff) do { _Pragma("unroll") for (int _i = 0; _i < 2; ++_i) \
        __builtin_amdgcn_global_load_lds((const unsigned*)((const char*)(gbase) + (voff)[_i]), (PG8_LAS unsigned*)(lds + (bufoff) + ldsw + _i * 8192), 16, 0, 0); } while (0)
#define PG8_LDA(dst, b, h) do { if constexpr (F8) { _Pragma("unroll") for (int m = 0; m < 4; ++m) { const i32x4 x0_ = *(const PG8_LAS i32x4*)(lds + PG8_SA(b, h) + aoff + m * 2048), x1_ = *(const PG8_LAS i32x4*)(lds + PG8_SA(b, h) + aoff + m * 2048 + 1024); \
        dst##8[m] = __builtin_shufflevector(x0_, x1_, 0, 1, 2, 3, 4, 5, 6, 7); } } else { _Pragma("unroll") for (int m = 0; m < 4; ++m) _Pragma("unroll") for (int k = 0; k < 2; ++k) dst[m][k] = *(const PG8_LAS bf16x8*)(lds + PG8_SA(b, h) + aoff + m * 2048 + k * 1024); } } while (0)
#define PG8_LDB(dst, b, h) do { if constexpr (F8) { _Pragma("unroll") for (int n = 0; n < 2; ++n) { const i32x4 x0_ = *(const PG8_LAS i32x4*)(lds + PG8_SB(b, h) + boff + n * 2048), x1_ = *(const PG8_LAS i32x4*)(lds + PG8_SB(b, h) + boff + n * 2048 + 1024); \
        dst##8[n] = __builtin_shufflevector(x0_, x1_, 0, 1, 2, 3, 4, 5, 6, 7); } } else { _Pragma("unroll") for (int n = 0; n < 2; ++n) _Pragma("unroll") for (int k = 0; k < 2; ++k) dst[n][k] = *(const PG8_LAS bf16x8*)(lds + PG8_SB(b, h) + boff + n * 2048 + k * 1024); } } while (0)
#define PG8_CAT(x0, x1) __builtin_shufflevector(__builtin_bit_cast(i32x4, x0), __builtin_bit_cast(i32x4, x1), 0, 1, 2, 3, 4, 5, 6, 7)
#define PG8_MMA(ai, bj, At, Bt) do { __builtin_amdgcn_s_setprio(1); if constexpr (F8) { _Pragma("unroll") for (int m = 0; m < 4; ++m) _Pragma("unroll") for (int n = 0; n < 2; ++n) \
        asm volatile("v_mfma_scale_f32_16x16x128_f8f6f4 %0, %1, %2, %0, %3, %3 op_sel_hi:[0,0,0]" : "+v"(acc[ai][bj][m][n]) : "v"(Bt##8[n]), "v"(At##8[m]), "v"(f8scale)); } else { \
        _Pragma("unroll") for (int m = 0; m < 4; ++m) _Pragma("unroll") for (int n = 0; n < 2; ++n) _Pragma("unroll") for (int k = 0; k < 2; ++k) \
        acc[ai][bj][m][n] = __builtin_amdgcn_mfma_f32_16x16x32_bf16(Bt[n][k], At[m][k], acc[ai][bj][m][n], 0, 0, 0); } __builtin_amdgcn_s_setprio(0); } while (0)
#define PG8_WAIT_V(n) asm volatile("s_waitcnt vmcnt(" #n ")" ::: "memory")
#define PG8_WAIT_L(n) asm volatile("s_waitcnt lgkmcnt(" #n ")" ::: "memory")
#define PG8_BAR __builtin_amdgcn_s_barrier()
#define PG8_SCHED __builtin_amdgcn_sched_barrier(0)
    Unit cur, nxt; int ui = 0;
    if (!S.next(0, cur)) return;
    f32x4 acc[2][2][4][2];
#pragma unroll
    for (int a = 0; a < 2; ++a)
#pragma unroll
        for (int b = 0; b < 2; ++b)
#pragma unroll
            for (int m = 0; m < 4; ++m)
#pragma unroll
                for (int n = 0; n < 2; ++n) acc[a][b][m][n] = (f32x4){0.f, 0.f, 0.f, 0.f};
    int f8scale = 0x7F7F7F7F; asm volatile("" : "+v"(f8scale));
    bf16x8 At[4][2], B0[2][2], B1[2][2]; i32x8 At8[4], B08[2], B18[2];
    const char* cA = (const char*)g.A + (size_t)cur.pm * tstep; const char* cB = (const char*)g.Bt + (size_t)cur.pn * tstep;
    S.a_ready(cur);
    if constexpr (SP2) {
        PG8_STAGE(PG8_SB(0, 0), cB, voffB); PG8_STAGE(PG8_SB(0, 1), cB + hstep, voffB); PG8_STAGE(PG8_SA(0, 0), cA, voffA); PG8_STAGE(PG8_SA(0, 1), cA + hstep, voffA);
        if (wr == 1) PG8_BAR;
        PG8_WAIT_V(2); PG8_BAR;
        PG8_STAGE(PG8_SB(1, 0), cB + kstep, voffB); PG8_STAGE(PG8_SA(1, 0), cA + kstep, voffA); PG8_STAGE(PG8_SB(1, 1), cB + hstep + kstep, voffB);
        PG8_WAIT_V(6); PG8_BAR;
    } else {
        PG8_STAGE(PG8_SB(0, 0), cB, voffB); PG8_STAGE(PG8_SA(0, 0), cA, voffA); PG8_STAGE(PG8_SB(0, 1), cB + hstep, voffB); PG8_STAGE(PG8_SA(0, 1), cA + hstep, voffA);
        if (wr == 1) PG8_BAR;
        PG8_WAIT_V(4); PG8_BAR;
        PG8_STAGE(PG8_SB(1, 0), cB + kstep, voffB); PG8_STAGE(PG8_SA(1, 0), cA + kstep, voffA); PG8_STAGE(PG8_SB(1, 1), cB + hstep + kstep, voffB);
        PG8_WAIT_V(6); PG8_BAR;
    }
    for (;;) {
        const bool has_next = S.next(ui + 1, nxt);
        const char* nA = has_next ? (const char*)g.A + (size_t)nxt.pm * tstep : cA; const char* nB = has_next ? (const char*)g.Bt + (size_t)nxt.pn * tstep : cB;
        for (int t = 0; t < nt; t += 2) {
            const bool last = (t == nt - 2);
            const char* a1 = cA + (size_t)(t + 1) * kstep;
            const char* a2 = last ? nA : cA + (size_t)(t + 2) * kstep; const char* b2 = last ? nB : cB + (size_t)(t + 2) * kstep;
            const char* a3 = a2 + kstep; const char* b3 = b2 + kstep;
            if (last && has_next) S.a_ready(nxt);
            if constexpr (SP2) {
            PG8_LDB(B0, 0, 0); PG8_LDB(B1, 0, 1); PG8_SCHED; PG8_LDA(At, 0, 0); PG8_STAGE(PG8_SA(1, 1), a1 + hstep, voffA);
            PG8_WAIT_V(8); PG8_WAIT_L(0); PG8_BAR; PG8_MMA(0, 0, At, B0); PG8_MMA(0, 1, At, B1); PG8_BAR; PG8_SCHED;
            PG8_LDA(At, 0, 1); PG8_STAGE(PG8_SB(0, 0), b2, voffB); PG8_STAGE(PG8_SB(0, 1), b2 + hstep, voffB); PG8_STAGE(PG8_SA(0, 0), a2, voffA);
            PG8_WAIT_V(8); PG8_WAIT_L(0); PG8_BAR; PG8_MMA(1, 0, At, B0); PG8_MMA(1, 1, At, B1); PG8_BAR; PG8_SCHED;
            PG8_LDB(B0, 1, 0); PG8_LDB(B1, 1, 1); PG8_SCHED; PG8_LDA(At, 1, 0); PG8_STAGE(PG8_SA(0, 1), a2 + hstep, voffA);
            PG8_WAIT_V(8); PG8_WAIT_L(0); PG8_BAR; PG8_MMA(0, 0, At, B0); PG8_MMA(0, 1, At, B1); PG8_BAR; PG8_SCHED;
            PG8_LDA(At, 1, 1); PG8_STAGE(PG8_SB(1, 0), b3, voffB); PG8_STAGE(PG8_SB(1, 1), b3 + hstep, voffB); PG8_STAGE(PG8_SA(1, 0), a3, voffA);
            PG8_WAIT_V(8); PG8_WAIT_L(0); PG8_BAR; PG8_MMA(1, 0, At, B0); PG8_MMA(1, 1, At, B1); PG8_BAR; PG8_SCHED;
            } else {
            PG8_LDB(B0, 0, 0); PG8_SCHED; PG8_LDA(At, 0, 0); PG8_STAGE(PG8_SA(1, 1), a1 + hstep, voffA);
            PG8_WAIT_L(8); PG8_BAR; PG8_WAIT_L(0); PG8_MMA(0, 0, At, B0); PG8_BAR; PG8_SCHED;
            PG8_LDB(B1, 0, 1); PG8_STAGE(PG8_SB(0, 0), b2, voffB);
            PG8_BAR; PG8_WAIT_L(0); PG8_MMA(0, 1, At, B1); PG8_BAR;
            PG8_LDA(At, 0, 1); PG8_STAGE(PG8_SA(0, 0), a2, voffA);
            PG8_BAR; PG8_WAIT_L(0); PG8_MMA(1, 0, At, B0); PG8_BAR; PG8_SCHED;
            PG8_STAGE(PG8_SB(0, 1), b2 + hstep, voffB);
            PG8_WAIT_V(6); PG8_BAR; PG8_MMA(1, 1, At, B1); PG8_BAR;
            PG8_LDB(B0, 1, 0); PG8_SCHED; PG8_LDA(At, 1, 0); PG8_STAGE(PG8_SA(0, 1), a2 + hstep, voffA);
            PG8_WAIT_L(8); PG8_BAR; PG8_WAIT_L(0); PG8_MMA(0, 0, At, B0); PG8_BAR; PG8_SCHED;
            PG8_LDB(B1, 1, 1); PG8_STAGE(PG8_SB(1, 0), b3, voffB);
            PG8_BAR; PG8_WAIT_L(0); PG8_MMA(0, 1, At, B1); PG8_BAR;
            PG8_LDA(At, 1, 1); PG8_STAGE(PG8_SA(1, 0), a3, voffA);
            PG8_BAR; PG8_WAIT_L(0); PG8_MMA(1, 0, At, B0); PG8_BAR; PG8_SCHED;
            PG8_STAGE(PG8_SB(1, 1), b3 + hstep, voffB);
            PG8_WAIT_V(6); PG8_BAR; PG8_MMA(1, 1, At, B1); PG8_BAR;
            }
        }
        if constexpr (ALIGN_EPI) { if (wr == 0) PG8_BAR; }
        if constexpr (F8) asm volatile("s_nop 15\n\ts_nop 15" ::: "memory");
        if constexpr (!Epi::AFTER_DRAIN) { E(acc, cur, wr, wc, fr, fq); S.done(cur); }
        if (!has_next) break;
#pragma unroll
        for (int a = 0; a < 2; ++a)
#pragma unroll
            for (int b = 0; b < 2; ++b)
#pragma unroll
                for (int m = 0; m < 4; ++m)
#pragma unroll
                    for (int n = 0; n < 2; ++n) acc[a][b][m][n] = (f32x4){0.f, 0.f, 0.f, 0.f};
        cur = nxt; cA = nA; cB = nB; ++ui;
        if constexpr (ALIGN_EPI) { if (wr == 1) PG8_BAR; }
    }
    PG8_WAIT_V(0);
    if constexpr (!ALIGN_EPI) { if (wr == 0) PG8_BAR; }
    PG8_BAR;
    if constexpr (Epi::AFTER_DRAIN) { E.fused(acc, cur, wr, wc, fr, fq, lds, wid, lane); S.done(cur); }
#undef PG8_SA
#undef PG8_SB
#undef PG8_STAGE
#undef PG8_LDA
#undef PG8_LDB
#undef PG8_MMA
#undef PG8_CAT
#undef PG8_WAIT_V
#undef PG8_WAIT_L
#undef PG8_BAR
#undef PG8_SCHED
}
}

constexpr int NWAVES = 8;
constexpr int S = 8192, DM = 4096, FF = 16384, DEPTH = 2;
constexpr int NSRC = 11344, NPROJ = 11520;
constexpr int OFF_Q = 0, OFF_KC = 2048, OFF_VC = 2560, OFF_KS = 3072, OFF_VS = 3584, OFF_KW = 4096, OFF_VW = 4608, OFF_XBC = 5120, OFF_Z = 9216, OFF_G = 11264, OFF_DT = 11312;
constexpr int NH = 16, NKV = 4, HD = 128, NCMP = 511, NSEL = 128, SELTOP = 16, WIN = 512;
constexpr int SSM_W = 2048, SSM_H = 32, SSM_P = 64, SSM_G = 8, SSM_N = 128, CONVD = 4096, CHUNK = 256, NCHUNK = S / CHUNK;
constexpr float EPS = 1e-5f;
constexpr float QSCALE = 0.08838834764831845f * 1.4426950408889634f;

constexpr size_t MiB = 1u << 20;
constexpr size_t WS_CTL = 0, CTL_ZERO_BYTES = 1 * MiB;
constexpr size_t SZ_WIN = (size_t)NPROJ * DM * 2, SZ_WO = (size_t)DM * DM * 2, SZ_WUP = (size_t)FF * DM * 2, SZ_WDN = (size_t)DM * FF * 2;
constexpr size_t WS_WIN = 2 * MiB;
constexpr size_t WS_WO = WS_WIN + DEPTH * SZ_WIN;
constexpr size_t WS_WUP = WS_WO + DEPTH * SZ_WO;
constexpr size_t WS_WDN = WS_WUP + DEPTH * SZ_WUP;
constexpr size_t WS_H = WS_WDN + DEPTH * SZ_WDN;
constexpr size_t WS_XN = WS_H + (size_t)S * DM * 4;
constexpr size_t WS_PROJ = WS_XN + (size_t)S * DM * 2;
constexpr size_t WS_ACT = WS_PROJ + (size_t)S * NPROJ * 2;
constexpr size_t WS_CAT = WS_ACT + (size_t)S * FF * 2;
constexpr size_t WS_ATT = WS_CAT + (size_t)S * DM * 2;
constexpr size_t WS_XBC = WS_ATT + (size_t)S * 2048 * 4;
constexpr size_t WS_Y = WS_XBC + (size_t)S * CONVD * 2;
constexpr size_t WS_ST = WS_Y + (size_t)S * 2048 * 4;
constexpr size_t WS_PREV = WS_ST + (size_t)NCHUNK * SSM_H * SSM_P * SSM_N * 4;
constexpr size_t WS_KC = WS_PREV + (size_t)NCHUNK * SSM_H * SSM_P * SSM_N * 4;
constexpr size_t WS_VC = WS_KC + (size_t)NKV * 512 * HD * 2;
constexpr size_t WS_DT = WS_VC + (size_t)NKV * 512 * HD * 2;
constexpr size_t WS_ADT = WS_DT + (size_t)S * 32 * 4;
constexpr size_t WS_COS = WS_ADT + (size_t)S * 32 * 4;
constexpr size_t WS_SIN = WS_COS + (size_t)S * 64 * 4;
constexpr size_t WS_BMP = WS_SIN + (size_t)S * 64 * 4;
constexpr size_t WS_ACSG = WS_BMP + (size_t)S * 16 * 4;
constexpr size_t WS_DEC = WS_ACSG + (size_t)S * 32 * 4;
constexpr size_t WS_W1T = WS_DEC + 4096;
constexpr size_t WS_W2T = WS_W1T + (size_t)DEPTH * 2 * 128 * 4096 * 2;
constexpr size_t WS_B1P = WS_W2T + (size_t)DEPTH * 2 * 128 * 128 * 2;
constexpr size_t WS_END = WS_B1P + (size_t)DEPTH * 2 * 16 * 128 * 4;
constexpr int CW_BAR = 4096, CW_P1 = 8192;
constexpr int P1_SPLIT = 10240;

constexpr int RING_OFF = 0, RING_BYTES = 131072;
constexpr int LDSCTL_OFF = 143360, MISC_OFF = LDSCTL_OFF + 320;
constexpr int LDS_BYTES = 147456;

#define GAS __attribute__((address_space(1)))
#define LAS __attribute__((address_space(3)))
typedef unsigned short bf16;
typedef unsigned v4u __attribute__((ext_vector_type(4)));
typedef float f32x4 __attribute__((ext_vector_type(4)));
typedef short bf16x8 __attribute__((ext_vector_type(8)));
typedef GAS unsigned gu32;
typedef GAS unsigned long long gu64;
#define RLX_AGENT __ATOMIC_RELAXED, __HIP_MEMORY_SCOPE_AGENT
#define LDS_WAIT() asm volatile("s_waitcnt lgkmcnt(0)" ::: "memory")
#define VM_WAIT() asm volatile("s_waitcnt vmcnt(0)" ::: "memory")
__device__ __forceinline__ unsigned long long rt() { return __builtin_amdgcn_s_memrealtime(); }
__device__ __forceinline__ unsigned f2bf(float f) { unsigned u = __builtin_bit_cast(unsigned, f); return (u + 0x7fffu + ((u >> 16) & 1u)) >> 16; }
__device__ __forceinline__ unsigned pk2(float lo, float hi) { return f2bf(lo) | (f2bf(hi) << 16); }

#define XB_TMO      128
#define XB_XCNT(j)  (256  + 64 * (j))
#define XB_XSUB(j)  (1280 + 64 * (j))
#define XB_XGEN(j)  (2304 + 64 * (j))
#define XB_TOP      3328
#define XB_TOPGEN   3392
#define XCD_BAR_WORDS 3456
#define XB_SPIN_CAP (1u << 18)

__device__ __forceinline__ unsigned xb_ld(unsigned* p)              { return __hip_atomic_load(p, __ATOMIC_RELAXED, __HIP_MEMORY_SCOPE_AGENT); }
__device__ __forceinline__ unsigned xb_add(unsigned* p, unsigned v) { return __hip_atomic_fetch_add(p, v, __ATOMIC_RELAXED, __HIP_MEMORY_SCOPE_AGENT); }
__device__ __forceinline__ unsigned xb_xcc_id() { return (unsigned)__builtin_amdgcn_s_getreg((3 << 11) | 20) & 0xFu; }
#define XB_SPIN(cond, bar) do { unsigned _sp = 0; while (cond) { __builtin_amdgcn_s_sleep(1); \
    if ((++_sp & 255u) == 0u) { if (xb_ld(&(bar)[XB_TMO])) break; if (_sp > XB_SPIN_CAP) { atomicAdd(&(bar)[XB_TMO], 1u); break; } } } } while (0)

__device__ __forceinline__ int bx_l() { int b = (int)blockIdx.x; asm volatile("" : "+s"(b)); return b; }
struct XcdBarrier {
    unsigned* bar; unsigned x;
    volatile LAS unsigned* st;
};

__device__ __forceinline__ XcdBarrier xcd_barrier_post(unsigned* bar, volatile LAS unsigned* st) {
    XcdBarrier b; b.bar = bar; b.x = xb_xcc_id(); b.st = st;
    if (threadIdx.x == 0) (void)xb_add(&bar[XB_XCNT(b.x)], 1u);
    return b;
}
__device__ __forceinline__ void xcd_barrier_complete(unsigned* bar, unsigned x, unsigned& nloc, unsigned& nx) {
    const unsigned G = gridDim.x * gridDim.y * gridDim.z;
    unsigned sum, cnt, mine, sp = 0u;
    for (;;) {
        sum = 0u; cnt = 0u; mine = 0u;
#pragma unroll
        for (unsigned j = 0; j < 16; ++j) { const unsigned c = xb_ld(&bar[XB_XCNT(j)]); sum += c; cnt += (c > 0u) ? 1u : 0u; mine = (j == x) ? c : mine; }
        if (sum == G) break;
        __builtin_amdgcn_s_sleep(1);
        if ((++sp & 255u) == 0u) { if (xb_ld(&bar[XB_TMO])) break; if (sp > XB_SPIN_CAP) { atomicAdd(&bar[XB_TMO], 1u); break; } }
    }
    nloc = mine > 0u ? mine : 1u; nx = cnt > 0u ? cnt : 1u;
}

__device__ __forceinline__ void xcd_barrier(const XcdBarrier& b) {
    asm volatile("s_waitcnt vmcnt(0)" ::: "memory");
    __syncthreads();
    if (threadIdx.x == 0) {
        unsigned* bar = b.bar;
        __builtin_amdgcn_s_waitcnt(0);
        unsigned nloc = b.st[0], nx = b.st[1];
        if (nloc == 0u) { xcd_barrier_complete(bar, b.x, nloc, nx); b.st[0] = nloc; b.st[1] = nx; }
        const unsigned old = xb_add(&bar[XB_XSUB(b.x)], 1u);
        const unsigned gen = old / nloc;
        if (old + 1u == (gen + 1u) * nloc) {
            __builtin_amdgcn_fence(__ATOMIC_RELEASE, "agent");
            asm volatile("s_waitcnt vmcnt(0)" ::: "memory");
            const unsigned og = xb_add(&bar[XB_TOP], 1u);
            const unsigned tg = og / nx;
            if (og + 1u == (tg + 1u) * nx) xb_add(&bar[XB_TOPGEN], 1u);
            else XB_SPIN(xb_ld(&bar[XB_TOPGEN]) == tg, bar);
            __builtin_amdgcn_fence(__ATOMIC_ACQUIRE, "agent");
            xb_add(&bar[XB_XGEN(b.x)], 1u);
            asm volatile("s_waitcnt vmcnt(0)" ::: "memory");
        } else {
            XB_SPIN(xb_ld(&bar[XB_XGEN(b.x)]) == gen, bar);
            __builtin_amdgcn_fence(__ATOMIC_ACQUIRE, "agent");
            asm volatile("s_waitcnt vmcnt(0)" ::: "memory");
        }
    }
    __syncthreads();
}


__device__ __forceinline__ float bf2f(unsigned short b) { return __builtin_bit_cast(float, (unsigned)b << 16); }
__device__ __forceinline__ float bflo(unsigned w) { return __builtin_bit_cast(float, w << 16); }
__device__ __forceinline__ float bfhi(unsigned w) { return __builtin_bit_cast(float, w & 0xffff0000u); }
__device__ __forceinline__ float wave_sum(float v) {
#pragma unroll
    for (int o = 1; o < 64; o <<= 1) v += __shfl_xor(v, o);
    return v;
}
__device__ __forceinline__ float wave_max(float v) {
#pragma unroll
    for (int o = 1; o < 64; o <<= 1) v = fmaxf(v, __shfl_xor(v, o));
    return v;
}

struct Frame {
    LAS unsigned char* lds;
    volatile LAS unsigned* MISC;
    gu32* ctl;
    int tid, lane, wave;
    int vcu, G;
};

__device__ __forceinline__ int src_col_in(int c) {
    if (c < 5120) { const int blk = c >> 7, p = c & 127; const bool rope = blk < 16 || ((((blk - 16) >> 2) & 1) == 0); const int d = rope ? (p >> 1) + 64 * (p & 1) : p; return blk * 128 + d; }
    if (c < OFF_Z) return c + 2096;
    if (c < OFF_G) return c - 4048;
    if (c < OFF_DT) return 5120 + (c - OFF_G);
    if (c < NSRC) return c;
    return -1;
}
__device__ __forceinline__ int nat_dim(int p) { return (p >> 1) + 64 * (p & 1); }
template <int MAP, bool KS, bool KPERM = false>
__device__ __forceinline__ void p0_transpose_item(const float* W, int K, int Nsrc, int nblk, bf16* WT, const float* ksA, const float* ksB, int ksplit, LAS float* scr, int item, int lane) {
    const int kb = item / nblk, nb = item % nblk, k0 = 64 * kb, n0 = 32 * nb;
    const int nr = n0 + (lane & 31); const int sc = MAP == 1 ? src_col_in(nr) : (MAP == 2 ? nat_dim(nr) : nr);
    float v[32];
#pragma unroll
    for (int i = 0; i < 32; ++i) { const int k = k0 + 2 * i + (lane >> 5); const int ksrc = KPERM ? ((k & ~127) + nat_dim(k & 127)) : k;
        v[i] = sc >= 0 ? W[(size_t)ksrc * Nsrc + sc] : 0.f; }
#pragma unroll
    for (int i = 0; i < 32; ++i) { const int kk = 2 * i + (lane >> 5); const int k = k0 + kk;
        if (KS) v[i] *= (k < ksplit ? ksA[k] : ksB[k - ksplit]);
        scr[kk * 33 + (lane & 31)] = v[i]; }
    LDS_WAIT(); asm volatile("" ::: "memory");
    const int c = lane & 7;
#pragma unroll
    for (int j = 0; j < 4; ++j) { const int n = (lane >> 3) + 8 * j; const LAS float* s = scr + (8 * c) * 33 + n;
        v4u o; o.x = pk2(s[0 * 33], s[1 * 33]); o.y = pk2(s[2 * 33], s[3 * 33]); o.z = pk2(s[4 * 33], s[5 * 33]); o.w = pk2(s[6 * 33], s[7 * 33]);
        *(GAS v4u*)(WT + (size_t)(n0 + n) * K + k0 + 8 * c) = o; }
    LDS_WAIT(); asm volatile("" ::: "memory");
}

template <bool KS, int MAP = 0>
__device__ __forceinline__ void p0_transpose_item_f8(const float* W, int K, int Nsrc, int nblk, unsigned char* WT, float wscale, const float* ksA, const float* ksB, int ksplit, LAS float* scr, int item, int lane) {
    const int pr = item >> 1, kb = 2 * (pr / nblk) + (item & 1), nb = pr % nblk, k0 = 64 * kb, n0 = 32 * nb;
    const int nr = n0 + (lane & 31); const int sc = MAP == 1 ? src_col_in(nr) : nr;
    float v[32];
#pragma unroll
    for (int i = 0; i < 32; ++i) v[i] = sc >= 0 ? W[(size_t)(k0 + 2 * i + (lane >> 5)) * Nsrc + sc] : 0.f;
#pragma unroll
    for (int i = 0; i < 32; ++i) { const int k = k0 + 2 * i + (lane >> 5); float x = v[i] * wscale; if (KS) x *= (k < ksplit ? ksA[k] : ksB[k - ksplit]); scr[(2 * i + (lane >> 5)) * 33 + (lane & 31)] = x; }
    LDS_WAIT(); asm volatile("" ::: "memory");
    const int c = lane & 7;
#pragma unroll
    for (int j = 0; j < 4; ++j) { const int n = (lane >> 3) + 8 * j; const LAS float* s = scr + (8 * c) * 33 + n;
        const unsigned long long o = (unsigned long long)pg8::pk4_fp8(s[0 * 33], s[1 * 33], s[2 * 33], s[3 * 33]) | ((unsigned long long)pg8::pk4_fp8(s[4 * 33], s[5 * 33], s[6 * 33], s[7 * 33]) << 32);
        *(GAS unsigned long long*)(WT + (size_t)(n0 + n) * K + k0 + 8 * c) = o; }
    LDS_WAIT(); asm volatile("" ::: "memory");
}
__device__ __forceinline__ void rms_row_to_bf16(const float* xrow, bf16* orow, int lane) {
    const GAS f32x4* xr = (const GAS f32x4*)xrow + lane;
    f32x4 v[16]; float s = 0.f;
#pragma unroll
    for (int j = 0; j < 16; ++j) { v[j] = xr[64 * j]; s += (v[j].x * v[j].x + v[j].y * v[j].y) + (v[j].z * v[j].z + v[j].w * v[j].w); }
    const float rstd = 1.f / sqrtf(wave_sum(s) * (1.f / DM) + EPS);
    GAS unsigned long long* o8 = (GAS unsigned long long*)orow + lane;
#pragma unroll
    for (int j = 0; j < 16; ++j) o8[64 * j] = (unsigned long long)pk2(v[j].x * rstd, v[j].y * rstd) | ((unsigned long long)pk2(v[j].z * rstd, v[j].w * rstd) << 32);
}
constexpr float XN8_SCALE = 4.f, WUP8_SCALE = 64.f;
__device__ __forceinline__ void rms_rowh_to_fp8(const bf16* xrow, unsigned char* orow, int lane) {
    const GAS v4u* xr = (const GAS v4u*)xrow + lane;
    v4u v[8]; float s = 0.f;
#pragma unroll
    for (int j = 0; j < 8; ++j) { v[j] = xr[64 * j]; const float a0 = bflo(v[j].x), a1 = bfhi(v[j].x), a2 = bflo(v[j].y), a3 = bfhi(v[j].y), a4 = bflo(v[j].z), a5 = bfhi(v[j].z), a6 = bflo(v[j].w), a7 = bfhi(v[j].w);
        s += ((a0 * a0 + a1 * a1) + (a2 * a2 + a3 * a3)) + ((a4 * a4 + a5 * a5) + (a6 * a6 + a7 * a7)); }
    const float rstd = XN8_SCALE / sqrtf(wave_sum(s) * (1.f / DM) + EPS);
    GAS unsigned long long* o8 = (GAS unsigned long long*)orow + lane;
#pragma unroll
    for (int j = 0; j < 8; ++j) o8[64 * j] = (unsigned long long)pg8::pk4_fp8(bflo(v[j].x) * rstd, bfhi(v[j].x) * rstd, bflo(v[j].y) * rstd, bfhi(v[j].y) * rstd) | ((unsigned long long)pg8::pk4_fp8(bflo(v[j].z) * rstd, bfhi(v[j].z) * rstd, bflo(v[j].w) * rstd, bfhi(v[j].w) * rstd) << 32);
}
__device__ __forceinline__ void rms4h_to_fp8(const bf16* H, unsigned char* X, int m0, int mstep, int lane) {
    v4u v[4][8];
#pragma unroll
    for (int i = 0; i < 4; ++i) { const GAS v4u* xr = (const GAS v4u*)(H + (size_t)(m0 + i * mstep) * DM) + lane;
#pragma unroll
        for (int j = 0; j < 8; ++j) v[i][j] = xr[64 * j]; }
    asm volatile("" ::: "memory");
#pragma unroll
    for (int i = 0; i < 4; ++i) { float s = 0.f;
#pragma unroll
        for (int j = 0; j < 8; ++j) { const float a0 = bflo(v[i][j].x), a1 = bfhi(v[i][j].x), a2 = bflo(v[i][j].y), a3 = bfhi(v[i][j].y), a4 = bflo(v[i][j].z), a5 = bfhi(v[i][j].z), a6 = bflo(v[i][j].w), a7 = bfhi(v[i][j].w);
            s += ((a0 * a0 + a1 * a1) + (a2 * a2 + a3 * a3)) + ((a4 * a4 + a5 * a5) + (a6 * a6 + a7 * a7)); }
        const float rstd = XN8_SCALE / sqrtf(wave_sum(s) * (1.f / DM) + EPS);
        GAS unsigned long long* o8 = (GAS unsigned long long*)(X + (size_t)(m0 + i * mstep) * DM) + lane;
#pragma unroll
        for (int j = 0; j < 8; ++j) o8[64 * j] = (unsigned long long)pg8::pk4_fp8(bflo(v[i][j].x) * rstd, bfhi(v[i][j].x) * rstd, bflo(v[i][j].y) * rstd, bfhi(v[i][j].y) * rstd) | ((unsigned long long)pg8::pk4_fp8(bflo(v[i][j].z) * rstd, bfhi(v[i][j].z) * rstd, bflo(v[i][j].w) * rstd, bfhi(v[i][j].w) * rstd) << 32); }
}
constexpr int PROJ_F8_FROM = 1;
constexpr int WO_F8_FROM = 1;
__device__ __forceinline__ void rms_row_to_fp8(const float* xrow, unsigned char* orow, int lane) {
    const GAS f32x4* xr = (const GAS f32x4*)xrow + lane;
    f32x4 v[16]; float s = 0.f;
#pragma unroll
    for (int j = 0; j < 16; ++j) { v[j] = xr[64 * j]; s += (v[j].x * v[j].x + v[j].y * v[j].y) + (v[j].z * v[j].z + v[j].w * v[j].w); }
    const float rstd = XN8_SCALE / sqrtf(wave_sum(s) * (1.f / DM) + EPS);
    GAS unsigned* o4 = (GAS unsigned*)orow + lane;
#pragma unroll
    for (int j = 0; j < 16; ++j) o4[64 * j] = pg8::pk4_fp8(v[j].x * rstd, v[j].y * rstd, v[j].z * rstd, v[j].w * rstd);
}

typedef float f32x16 __attribute__((ext_vector_type(16)));
typedef short s16x4 __attribute__((ext_vector_type(4)));
__device__ __forceinline__ int crow(int r, int hi) { return (r & 3) + 8 * (r >> 2) + 4 * hi; }
__device__ __forceinline__ unsigned cvtpk(float lo, float hi) { unsigned r; asm volatile("v_cvt_pk_bf16_f32 %0, %1, %2" : "=v"(r) : "v"(lo), "v"(hi)); return r; }
__device__ __forceinline__ void stage4_tr(LAS bf16* dst  , int ld, v4u w0, v4u w1, v4u w2, v4u w3, float d0, float d1, float d2, float d3) {
    const unsigned a0[4] = {w0.x, w0.y, w0.z, w0.w}, a1[4] = {w1.x, w1.y, w1.z, w1.w}, a2[4] = {w2.x, w2.y, w2.z, w2.w}, a3[4] = {w3.x, w3.y, w3.z, w3.w};
#pragma unroll
    for (int jj = 0; jj < 4; ++jj) {
        const unsigned long long lo = (unsigned long long)cvtpk(bflo(a0[jj]) * d0, bflo(a1[jj]) * d1) | ((unsigned long long)cvtpk(bflo(a2[jj]) * d2, bflo(a3[jj]) * d3) << 32);
        const unsigned long long hi = (unsigned long long)cvtpk(bfhi(a0[jj]) * d0, bfhi(a1[jj]) * d1) | ((unsigned long long)cvtpk(bfhi(a2[jj]) * d2, bfhi(a3[jj]) * d3) << 32);
        *(LAS unsigned long long*)(dst + (2 * jj) * ld) = lo; *(LAS unsigned long long*)(dst + (2 * jj + 1) * ld) = hi; }
}
constexpr int SSD_LD = 264;
constexpr int SSD_XT2 = 0, SSD_BN = 2 * 64 * SSD_LD * 2, SSD_ACS = SSD_BN + 256 * 256, SSD_DTL = SSD_ACS + 4096, SSD_LDS_END = SSD_DTL + 4096;
constexpr int SSD_BT = 0, SSD_XT = 128 * SSD_LD * 2;
static_assert(SSD_LDS_END <= LDSCTL_OFF && SSD_XT + 64 * SSD_LD * 2 <= SSD_ACS, "ssd lds");
__device__ __forceinline__ void ssd1_unit(LAS unsigned char* lds, int c, int g, const bf16* XBC, const bf16* PROJ, const float* dtb, const float* alog, bf16* Y, float* ST, float* DEC, float* ACSG, int tid_in) {
    int tid = tid_in; asm volatile("" : "+v"(tid));
    const int lane = tid & 63, wave = __builtin_amdgcn_readfirstlane(tid >> 6), l32 = lane & 31, hi = lane >> 5;
    LAS bf16* XT2 = (LAS bf16*)(lds + SSD_XT2); LAS unsigned char* BN = lds + SSD_BN; LAS float* acs = (LAS float*)(lds + SSD_ACS); LAS float* dtl = (LAS float*)(lds + SSD_DTL);
    const int t0 = c * CHUNK;
    __syncthreads();
    if (wave < 4) { const int h = 4 * g + wave; float a[4], run = 0.f; const float nA = -expf(alog[h]), db = dtb[h];
#pragma unroll
        for (int i = 0; i < 4; ++i) { const float xr = bf2f(PROJ[(size_t)(t0 + 4 * lane + i) * NPROJ + OFF_DT + h]) + db; const float sp = xr > 20.f ? xr : log1pf(expf(xr));
            a[i] = sp * nA; run += a[i]; a[i] = run; dtl[wave * 256 + 4 * lane + i] = sp; }
        float inc = run;
#pragma unroll
        for (int d = 1; d < 64; d <<= 1) { const float v = __shfl_up(inc, d); if (lane >= d) inc += v; }
        const float excl = inc - run;
#pragma unroll
        for (int i = 0; i < 4; ++i) { const float v = a[i] + excl; acs[wave * 256 + 4 * lane + i] = v; ACSG[(size_t)(t0 + 4 * lane + i) * 32 + h] = v; }
        if (lane == 63) DEC[c * 32 + h] = expf(inc);
    }
#pragma unroll
    for (int i = 0; i < 8; ++i) { const int idx = tid + 512 * i, s = idx >> 4, ch = idx & 15;
        const v4u w = *(const GAS v4u*)(XBC + (size_t)(t0 + s) * CONVD + 2048 + g * 128 + 8 * ch);
        *(LAS v4u*)(BN + s * 256 + ((ch ^ (s & 7)) << 4)) = w; }
    __syncthreads();
#pragma unroll 1
    for (int rd = 0; rd < 2; ++rd) {
        { const int s0 = 4 * lane;
#pragma unroll
          for (int cq = 0; cq < 2; ++cq) { const int cb = 8 * (2 * wave + cq), hq = cb >> 6, pb = cb & 63;
            const bf16* xp = XBC + (size_t)(t0 + s0) * CONVD + (4 * g + 2 * rd) * 64 + cb;
            const v4u w0 = *(const GAS v4u*)xp, w1 = *(const GAS v4u*)(xp + CONVD), w2 = *(const GAS v4u*)(xp + 2 * CONVD), w3 = *(const GAS v4u*)(xp + 3 * CONVD);
            const f32x4 dv = *(const LAS f32x4*)(dtl + (2 * rd + hq) * 256 + s0);
            stage4_tr(XT2 + (hq * 64 + pb) * SSD_LD + s0, SSD_LD, w0, w1, w2, w3, dv[0], dv[1], dv[2], dv[3]); } }
        __syncthreads();
        { const int hq = wave >> 2, hh = 2 * rd + hq, h = 4 * g + hh;
#pragma unroll 1
          for (int task = 0; task < 2; ++task) {
            const int lt = task ? 7 - (wave & 3) : (wave & 3); const int lloc = 32 * lt + l32, lrow = t0 + lloc;
            bf16x8 cf[8];
#pragma unroll
            for (int kk = 0; kk < 8; ++kk) cf[kk] = *(const GAS bf16x8*)(XBC + (size_t)lrow * CONVD + 3072 + g * 128 + 16 * kk + 8 * hi);
            const float acl = acs[hh * 256 + lloc];
            f32x16 ya0 = {}, ya1 = {};
            for (int j = 0; j <= lt; ++j) {
                f32x16 gt = {};
                { const int s = 32 * j + l32; const LAS unsigned char* brow = BN + s * 256; const int sw = s & 7;
#pragma unroll
                  for (int kk = 0; kk < 8; ++kk) { const bf16x8 a = *(const LAS bf16x8*)(brow + (((2 * kk + hi) ^ sw) << 4)); gt = __builtin_amdgcn_mfma_f32_32x32x16_bf16(a, cf[kk], gt, 0, 0, 0); } }
                float e[16];
#pragma unroll
                for (int q = 0; q < 4; ++q) { const f32x4 av = *(const LAS f32x4*)(acs + hh * 256 + 32 * j + 8 * q + 4 * hi);
#pragma unroll
                    for (int i = 0; i < 4; ++i) { const int r = 4 * q + i, s = 32 * j + crow(r, hi); const float ev = __expf(fminf(acl - av[i], 0.f)); e[r] = (s <= lloc) ? gt[r] * ev : 0.f; } }
                v4u w0 = {cvtpk(e[0], e[1]), cvtpk(e[2], e[3]), cvtpk(e[4], e[5]), cvtpk(e[6], e[7])}, w1 = {cvtpk(e[8], e[9]), cvtpk(e[10], e[11]), cvtpk(e[12], e[13]), cvtpk(e[14], e[15])};
                const bf16x8 pk0 = __builtin_bit_cast(bf16x8, w0), pk1 = __builtin_bit_cast(bf16x8, w1);
#pragma unroll
                for (int pt = 0; pt < 2; ++pt) {
                    const LAS bf16* xr = XT2 + (hq * 64 + 32 * pt + l32) * SSD_LD + 32 * j + 4 * hi;
                    const s16x4 a0 = *(const LAS s16x4*)(xr), a1 = *(const LAS s16x4*)(xr + 8), a2 = *(const LAS s16x4*)(xr + 16), a3 = *(const LAS s16x4*)(xr + 24);
                    const bf16x8 af0 = {a0[0], a0[1], a0[2], a0[3], a1[0], a1[1], a1[2], a1[3]}, af1 = {a2[0], a2[1], a2[2], a2[3], a3[0], a3[1], a3[2], a3[3]};
                    if (pt == 0) { ya0 = __builtin_amdgcn_mfma_f32_32x32x16_bf16(af0, pk0, ya0, 0, 0, 0); ya0 = __builtin_amdgcn_mfma_f32_32x32x16_bf16(af1, pk1, ya0, 0, 0, 0); }
                    else { ya1 = __builtin_amdgcn_mfma_f32_32x32x16_bf16(af0, pk0, ya1, 0, 0, 0); ya1 = __builtin_amdgcn_mfma_f32_32x32x16_bf16(af1, pk1, ya1, 0, 0, 0); }
                }
            }
            bf16* yrow = Y + (size_t)lrow * 2048 + h * 64 + 4 * hi;
#pragma unroll
            for (int q = 0; q < 4; ++q) { *(GAS unsigned long long*)(yrow + 8 * q) = (unsigned long long)cvtpk(ya0[4 * q], ya0[4 * q + 1]) | ((unsigned long long)cvtpk(ya0[4 * q + 2], ya0[4 * q + 3]) << 32);
                                          *(GAS unsigned long long*)(yrow + 32 + 8 * q) = (unsigned long long)cvtpk(ya1[4 * q], ya1[4 * q + 1]) | ((unsigned long long)cvtpk(ya1[4 * q + 2], ya1[4 * q + 3]) << 32); }
          } }
        __syncthreads();
    }
    LAS bf16* BT = (LAS bf16*)(lds + SSD_BT); LAS bf16* XT = (LAS bf16*)(lds + SSD_XT);
    { const int s0 = 4 * lane;
#pragma unroll
      for (int cq = 0; cq < 2; ++cq) { const int nb = 8 * (2 * wave + cq);
        const bf16* bp = XBC + (size_t)(t0 + s0) * CONVD + 2048 + g * 128 + nb;
        const v4u w0 = *(const GAS v4u*)bp, w1 = *(const GAS v4u*)(bp + CONVD), w2 = *(const GAS v4u*)(bp + 2 * CONVD), w3 = *(const GAS v4u*)(bp + 3 * CONVD);
        stage4_tr(BT + nb * SSD_LD + s0, SSD_LD, w0, w1, w2, w3, 1.f, 1.f, 1.f, 1.f); } }
    for (int hh = 0; hh < 4; ++hh) {
        const int h = 4 * g + hh;
        { const float aend = acs[hh * 256 + 255]; const int s0 = 4 * lane, pb = 8 * wave;
          const bf16* xp = XBC + (size_t)(t0 + s0) * CONVD + h * 64 + pb;
          const v4u w0 = *(const GAS v4u*)xp, w1 = *(const GAS v4u*)(xp + CONVD), w2 = *(const GAS v4u*)(xp + 2 * CONVD), w3 = *(const GAS v4u*)(xp + 3 * CONVD);
          const f32x4 dv = *(const LAS f32x4*)(dtl + hh * 256 + s0), av = *(const LAS f32x4*)(acs + hh * 256 + s0);
          stage4_tr(XT + pb * SSD_LD + s0, SSD_LD, w0, w1, w2, w3, dv[0] * __expf(aend - av[0]), dv[1] * __expf(aend - av[1]), dv[2] * __expf(aend - av[2]), dv[3] * __expf(aend - av[3])); }
        __syncthreads();
        { const int pt = wave >> 2, nt = wave & 3; f32x16 acc = {};
          const LAS bf16* ar = XT + (32 * pt + l32) * SSD_LD + 8 * hi; const LAS bf16* br = BT + (32 * nt + l32) * SSD_LD + 8 * hi;
#pragma unroll
          for (int kk = 0; kk < 16; ++kk) { const bf16x8 a = *(const LAS bf16x8*)(ar + 16 * kk), b = *(const LAS bf16x8*)(br + 16 * kk); acc = __builtin_amdgcn_mfma_f32_32x32x16_bf16(a, b, acc, 0, 0, 0); }
          float* sp = ST + ((size_t)(c * 32 + h) * 64 + 32 * pt) * 128 + 32 * nt + l32;
#pragma unroll
          for (int r = 0; r < 16; ++r) sp[(size_t)crow(r, hi) * 128] = acc[r]; }
        __syncthreads();
    }
}
constexpr int S3_LD = 68;
__device__ __forceinline__ void ssd3_unit(LAS unsigned char* lds, int c, int g, const bf16* XBC, const bf16* PROJ, const bf16* Y, bf16* Y2, const bf16* PREV, const float* ACSG, const float* dsk, unsigned char* CAT, bool cat_f8, int tid_in) {
    int tid = tid_in; asm volatile("" : "+v"(tid));
    const int lane = tid & 63, wave = __builtin_amdgcn_readfirstlane(tid >> 6), l32 = lane & 31, hi = lane >> 5;
    LAS float* T = (LAS float*)(lds + 65536) + wave * (32 * S3_LD);
    const int t0 = c * CHUNK; const int lrow = t0 + 32 * wave + l32;
    asm volatile("s_waitcnt vmcnt(0) lgkmcnt(0)" ::: "memory"); __builtin_amdgcn_s_barrier();
    { const int sr = tid >> 4, spc = tid & 15, slc = spc ^ (sr & 7);
      const char* psrc = (const char*)(PREV + ((size_t)(c * 32 + 4 * g) * 64 + sr) * 128 + 8 * slc);
#pragma unroll
      for (int q = 0; q < 8; ++q)
          __builtin_amdgcn_global_load_lds((const unsigned*)(psrc + (size_t)q * (32 * 128 * 2)), (LAS unsigned*)(lds + q * 8192 + wave * 1024), 16, 0, 0); }
    const int q8 = (lane & 7) * 8, tl0 = lane >> 3;
    bf16x8 cf[8];
#pragma unroll
    for (int kk = 0; kk < 8; ++kk) cf[kk] = *(const GAS bf16x8*)(XBC + (size_t)lrow * CONVD + 3072 + g * 128 + 16 * kk + 8 * hi);
    float ss[4] = {0.f, 0.f, 0.f, 0.f};
    asm volatile("s_waitcnt vmcnt(0)" ::: "memory"); __builtin_amdgcn_s_barrier(); asm volatile("" ::: "memory");
    const int sw = l32 & 7;
#pragma unroll
    for (int hh = 0; hh < 4; ++hh) { const int h = 4 * g + hh; const float dk = dsk[h];
        f32x16 acc0 = {}, acc1 = {};
        const LAS unsigned char* pr = lds + hh * 16384 + l32 * 256;
#pragma unroll
        for (int kk = 0; kk < 8; ++kk) { const int cx = ((2 * kk + hi) ^ sw) << 4; const bf16x8 w0 = *(const LAS bf16x8*)(pr + cx), w1 = *(const LAS bf16x8*)(pr + 8192 + cx);
            acc0 = __builtin_amdgcn_mfma_f32_32x32x16_bf16(cf[kk], w0, acc0, 0, 0, 0);
            acc1 = __builtin_amdgcn_mfma_f32_32x32x16_bf16(cf[kk], w1, acc1, 0, 0, 0); }
        asm volatile("" ::: "memory");
#pragma unroll
        for (int r = 0; r < 16; ++r) { T[crow(r, hi) * S3_LD + l32] = acc0[r]; T[crow(r, hi) * S3_LD + 32 + l32] = acc1[r]; }
        asm volatile("s_waitcnt lgkmcnt(0)" ::: "memory");
#pragma unroll
        for (int ip = 0; ip < 2; ++ip) {
            v4u yw[2]; v4u xw[2], zw[2]; float ea[2];
#pragma unroll
            for (int ii = 0; ii < 2; ++ii) { const int i = 2 * ip + ii; const int t = t0 + 32 * wave + tl0 + 8 * i; const int ch = h * 64 + q8;
                yw[ii] = *(const GAS v4u*)(Y + (size_t)t * 2048 + ch);
                xw[ii] = *(const GAS v4u*)(XBC + (size_t)t * CONVD + ch); zw[ii] = *(const GAS v4u*)(PROJ + (size_t)t * NPROJ + OFF_Z + ch); ea[ii] = __expf(ACSG[(size_t)t * 32 + h]); }
#pragma unroll
            for (int ii = 0; ii < 2; ++ii) { const int i = 2 * ip + ii; const LAS f32x4* tp = (const LAS f32x4*)(T + (tl0 + 8 * i) * S3_LD + q8); const f32x4 a0 = tp[0], a1 = tp[1];
                const float xv[8] = {bflo(xw[ii].x), bfhi(xw[ii].x), bflo(xw[ii].y), bfhi(xw[ii].y), bflo(xw[ii].z), bfhi(xw[ii].z), bflo(xw[ii].w), bfhi(xw[ii].w)};
                const float zv[8] = {bflo(zw[ii].x), bfhi(zw[ii].x), bflo(zw[ii].y), bfhi(zw[ii].y), bflo(zw[ii].z), bfhi(zw[ii].z), bflo(zw[ii].w), bfhi(zw[ii].w)};
                const float ydv[8] = {bflo(yw[ii].x), bfhi(yw[ii].x), bflo(yw[ii].y), bfhi(yw[ii].y), bflo(yw[ii].z), bfhi(yw[ii].z), bflo(yw[ii].w), bfhi(yw[ii].w)};
                float y[8];
#pragma unroll
                for (int j = 0; j < 8; ++j) { const float a = j < 4 ? a0[j & 3] : a1[j & 3], yd = ydv[j];
                    float v = a * ea[ii] + yd + dk * xv[j]; v *= zv[j] / (1.f + __expf(-zv[j])); y[j] = v; ss[i] += v * v; }
                *(GAS v4u*)(Y2 + (size_t)(t0 + 32 * wave + tl0 + 8 * i) * 2048 + h * 64 + q8) = (v4u){cvtpk(y[0], y[1]), cvtpk(y[2], y[3]), cvtpk(y[4], y[5]), cvtpk(y[6], y[7])}; }
            asm volatile("" ::: "memory");
        }
        asm volatile("s_waitcnt lgkmcnt(0)" ::: "memory");
    }
    asm volatile("s_waitcnt vmcnt(0)" ::: "memory");
    float rs[4];
#pragma unroll
    for (int i = 0; i < 4; ++i) { float s = ss[i]; s += __shfl_xor(s, 1); s += __shfl_xor(s, 2); s += __shfl_xor(s, 4); rs[i] = 1.f / sqrtf(s * (1.f / 256.f) + EPS); }
#pragma unroll
    for (int hh = 0; hh < 4; ++hh)
#pragma unroll
        for (int i = 0; i < 4; ++i) { const int t = t0 + 32 * wave + tl0 + 8 * i; const float r = rs[i];
            const unsigned long long* yp = (const unsigned long long*)(Y2 + (size_t)t * 2048 + (4 * g + hh) * 64 + q8);
            const unsigned long long u0 = __hip_atomic_load(yp, __ATOMIC_RELAXED, __HIP_MEMORY_SCOPE_AGENT), u1 = __hip_atomic_load(yp + 1, __ATOMIC_RELAXED, __HIP_MEMORY_SCOPE_AGENT);
            const v4u w = {(unsigned)u0, (unsigned)(u0 >> 32), (unsigned)u1, (unsigned)(u1 >> 32)};
            if (cat_f8) {
            const unsigned long long o = (unsigned long long)pg8::pk4_fp8(bflo(w.x) * r, bfhi(w.x) * r, bflo(w.y) * r, bfhi(w.y) * r) | ((unsigned long long)pg8::pk4_fp8(bflo(w.z) * r, bfhi(w.z) * r, bflo(w.w) * r, bfhi(w.w) * r) << 32);
            *(GAS unsigned long long*)(CAT + (size_t)t * DM + 2048 + (4 * g + hh) * 64 + q8) = o; }
            else *(GAS v4u*)((bf16*)CAT + (size_t)t * DM + 2048 + (4 * g + hh) * 64 + q8) = (v4u){cvtpk(bflo(w.x) * r, bfhi(w.x) * r), cvtpk(bflo(w.y) * r, bfhi(w.y) * r), cvtpk(bflo(w.z) * r, bfhi(w.z) * r), cvtpk(bflo(w.w) * r, bfhi(w.w) * r)}; }
}

#define KSWZ(row, colB) ((row) * 256 + ((colB) ^ (((row) & 7) << 4)))
#define SBAR() __builtin_amdgcn_sched_barrier(0)
__device__ __forceinline__ int v_st(int k, int c) { const int kk = (k & ~0xC) | ((k & 4) << 1) | ((k & 8) >> 1); return ((kk >> 3) * 4 + (c >> 5)) * 512 + ((kk & 7) * 32 + (c & 31)) * 2; }
__device__ __forceinline__ int v_rd_base(int lane) { return ((lane & 3) << 3) | (((lane >> 2) & 3) << 6) | (((lane >> 4) & 1) << 5) | (((lane >> 5) & 1) << 8); }
constexpr int v_rd_off(int d0, int ks, int half) { return d0 * 512 + ks * 4096 + half * 2048; }
constexpr int AT_K = 0, AT_V = 49152, AT_WS = 98304, AT_IMP = AT_WS + 2048, AT_IMPLD = 129, AT_CARRY = AT_IMP + 64 * AT_IMPLD * 4, AT_BM = AT_CARRY + 2048, AT_END = AT_BM + 1024;
static_assert(AT_END <= LDSCTL_OFF, "attention lds");
constexpr float AT_THR = 11.5f;

__device__ __forceinline__ void at_qkt(f32x16& p0, f32x16& p1, const LAS unsigned char* Kt, int l32, int hi, const bf16x8 (&qr)[8], const f32x16& cinit) {
    const LAS unsigned char* kb[4];
#pragma unroll
    for (int dd = 0; dd < 4; ++dd) kb[dd] = Kt + KSWZ(l32, (dd * 16 + hi * 8) * 2);
#pragma unroll
    for (int d0 = 0; d0 < 8; ++d0) { const LAS unsigned char* a = kb[d0 & 3] + (d0 >> 2) * 128;
        const bf16x8 b0 = *(const LAS bf16x8*)a, b1 = *(const LAS bf16x8*)(a + 32 * 256);
        if (d0 == 0) { p0 = __builtin_amdgcn_mfma_f32_32x32x16_bf16(b0, qr[0], cinit, 0, 0, 0); p1 = __builtin_amdgcn_mfma_f32_32x32x16_bf16(b1, qr[0], cinit, 0, 0, 0); }
        else { p0 = __builtin_amdgcn_mfma_f32_32x32x16_bf16(b0, qr[d0], p0, 0, 0, 0); p1 = __builtin_amdgcn_mfma_f32_32x32x16_bf16(b1, qr[d0], p1, 0, 0, 0); } }
}
__device__ __forceinline__ void at_pv(f32x16 (&o)[4], int vb, bf16x8 pa0, bf16x8 pa1, bf16x8 pa2, bf16x8 pa3) {
#define TRRD(dst, off) asm volatile("ds_read_b64_tr_b16 %0, %1 offset:%2" : "=&v"(dst) : "v"(vb), "i"(off) : "memory")
#define PV_D0(d0) do { s16x4 l0, l1, l2, l3, h0, h1, h2, h3; constexpr int b_ = v_rd_off(d0, 0, 0); \
        TRRD(l0, b_); TRRD(h0, b_ + 2048); TRRD(l1, b_ + 4096); TRRD(h1, b_ + 6144); TRRD(l2, b_ + 8192); TRRD(h2, b_ + 10240); TRRD(l3, b_ + 12288); TRRD(h3, b_ + 14336); \
        asm volatile("s_waitcnt lgkmcnt(0)" ::: "memory"); SBAR(); \
        o[d0] = __builtin_amdgcn_mfma_f32_32x32x16_bf16(pa0, (bf16x8){l0[0], l0[1], l0[2], l0[3], h0[0], h0[1], h0[2], h0[3]}, o[d0], 0, 0, 0); \
        o[d0] = __builtin_amdgcn_mfma_f32_32x32x16_bf16(pa1, (bf16x8){l1[0], l1[1], l1[2], l1[3], h1[0], h1[1], h1[2], h1[3]}, o[d0], 0, 0, 0); \
        o[d0] = __builtin_amdgcn_mfma_f32_32x32x16_bf16(pa2, (bf16x8){l2[0], l2[1], l2[2], l2[3], h2[0], h2[1], h2[2], h2[3]}, o[d0], 0, 0, 0); \
        o[d0] = __builtin_amdgcn_mfma_f32_32x32x16_bf16(pa3, (bf16x8){l3[0], l3[1], l3[2], l3[3], h3[0], h3[1], h3[2], h3[3]}, o[d0], 0, 0, 0); } while (0)
    PV_D0(0); PV_D0(1); PV_D0(2); PV_D0(3);
#undef PV_D0
#undef TRRD
}
__device__ __forceinline__ float max3f(float a, float b, float c) { float r; asm("v_max3_f32 %0, %1, %2, %3" : "=v"(r) : "v"(a), "v"(b), "v"(c)); return r; }
__device__ __forceinline__ float at_softmax(f32x16& p0, f32x16& p1, float& m_reg, f32x16& negm, float& l_reg, bf16x8& pa0, bf16x8& pa1, bf16x8& pa2, bf16x8& pa3, bool rowsel, bool use_rowsel) {
    float ma = max3f(p0[0], p0[1], p0[2]), mb = max3f(p0[3], p0[4], p0[5]), mc = max3f(p0[6], p0[7], p0[8]), md = max3f(p0[9], p0[10], p0[11]);
    ma = max3f(ma, p0[12], p0[13]); mb = max3f(mb, p0[14], p0[15]); mc = max3f(mc, p1[0], p1[1]); md = max3f(md, p1[2], p1[3]);
    ma = max3f(ma, p1[4], p1[5]); mb = max3f(mb, p1[6], p1[7]); mc = max3f(mc, p1[8], p1[9]); md = max3f(md, p1[10], p1[11]);
    ma = max3f(ma, p1[12], p1[13]); mb = max3f(mb, p1[14], p1[15]);
    float pmax = fmaxf(max3f(ma, mb, mc), md);
    if (use_rowsel && !rowsel) pmax = -__builtin_inff();
    { auto rr = __builtin_amdgcn_permlane32_swap(__float_as_uint(pmax), __float_as_uint(pmax), false, false); pmax = fmaxf(__uint_as_float(rr[0]), __uint_as_float(rr[1])); }
    float alpha = 1.f;
    if (!__all(pmax <= AT_THR)) {
        const float d = fmaxf(pmax, 0.f); alpha = __builtin_amdgcn_exp2f(-d); m_reg += d;
#pragma unroll
        for (int r = 0; r < 16; ++r) { p0[r] -= d; p1[r] -= d; negm[r] = -m_reg; }
    }
    float s0 = 0.f, s1 = 0.f, s2 = 0.f, s3 = 0.f;
#pragma unroll
    for (int r = 0; r < 16; r += 4) { p0[r] = __builtin_amdgcn_exp2f(p0[r]); p0[r + 1] = __builtin_amdgcn_exp2f(p0[r + 1]); p0[r + 2] = __builtin_amdgcn_exp2f(p0[r + 2]); p0[r + 3] = __builtin_amdgcn_exp2f(p0[r + 3]);
        s0 += p0[r]; s1 += p0[r + 1]; s2 += p0[r + 2]; s3 += p0[r + 3]; }
#pragma unroll
    for (int r = 0; r < 16; r += 4) { p1[r] = __builtin_amdgcn_exp2f(p1[r]); p1[r + 1] = __builtin_amdgcn_exp2f(p1[r + 1]); p1[r + 2] = __builtin_amdgcn_exp2f(p1[r + 2]); p1[r + 3] = __builtin_amdgcn_exp2f(p1[r + 3]);
        s0 += p1[r]; s1 += p1[r + 1]; s2 += p1[r + 2]; s3 += p1[r + 3]; }
    float ps = (s0 + s1) + (s2 + s3);
    if (use_rowsel && !rowsel) ps = 0.f;
    { auto rr = __builtin_amdgcn_permlane32_swap(__float_as_uint(ps), __float_as_uint(ps), false, false); ps = __uint_as_float(rr[0]) + __uint_as_float(rr[1]); }
    l_reg = l_reg * alpha + ps;
    const unsigned keep = (use_rowsel && !rowsel) ? 0u : 0xffffffffu;
#define PK4(P, B_, OUT) do { unsigned a0 = cvtpk(P[B_+0], P[B_+1]), a1 = cvtpk(P[B_+2], P[B_+3]); unsigned b0 = cvtpk(P[B_+4], P[B_+5]), b1 = cvtpk(P[B_+6], P[B_+7]); \
        if (use_rowsel) { a0 &= keep; a1 &= keep; b0 &= keep; b1 &= keep; } \
        auto r0 = __builtin_amdgcn_permlane32_swap(a0, b0, false, false); auto r1 = __builtin_amdgcn_permlane32_swap(a1, b1, false, false); \
        v4u w = {r0[0], r1[0], r0[1], r1[1]}; OUT = __builtin_bit_cast(bf16x8, w); } while (0)
    PK4(p0, 0, pa0); PK4(p0, 8, pa1); PK4(p1, 0, pa2); PK4(p1, 8, pa3);
#undef PK4
    return alpha;
}
template <int MODE>
__device__ __forceinline__ void at_mask(f32x16& p0, f32x16& p1, int kb, int hi, int tq, int lim, bool rowsel) {
    const float NEG = -__builtin_inff();
#pragma unroll
    for (int r = 0; r < 16; ++r) { const int k0 = kb + (r & 3) + 8 * (r >> 2) + 4 * hi, k1 = k0 + 32;
        bool v0, v1;
        if (MODE == 0) { v0 = k0 <= lim; v1 = k1 <= lim; }
        else if (MODE == 1) { v0 = rowsel && k0 <= tq; v1 = rowsel && k1 <= tq; }
        else { v0 = (unsigned)(tq - k0) < (unsigned)WIN; v1 = (unsigned)(tq - k1) < (unsigned)WIN; }
        if (!v0) p0[r] = NEG; if (!v1) p1[r] = NEG; }
}
template <int MODE>
__device__ __forceinline__ void at_branch(LAS unsigned char* lds, const bf16x8 (&qr)[8], const bf16* Kb, const bf16* Vb, int ld, int jlo, int NT, int tq, int lim, const LAS unsigned* bmrow,
                                          bf16* Obase, float& m_out, float& l_out, int tid_in) {
    int tid = tid_in; asm volatile("" : "+v"(tid));
    const int lane = tid & 63, wave = __builtin_amdgcn_readfirstlane(tid >> 6), l32 = lane & 31, hi = lane >> 5;
    LAS unsigned char* K_lds = lds + AT_K; LAS unsigned char* V_lds = lds + AT_V;
    LAS float* wsl = (LAS float*)(lds + AT_WS) + wave * 64;
    const int vb0 = (int)(unsigned)(size_t)V_lds + v_rd_base(lane);
    const int ksr = tid >> 4, kslc = (tid & 15) ^ (ksr & 7);
    const int vkk = (tid >> 7) * 8 + ((tid & 31) >> 2), vk = (vkk & ~0xC) | ((vkk & 4) << 1) | ((vkk & 8) >> 1), vc = ((tid >> 5) & 3) * 32 + (tid & 3) * 8;
    const char* ksrc = (const char*)(Kb + (size_t)ksr * ld + 8 * kslc); const char* vsrc = (const char*)(Vb + (size_t)vk * ld + vc);
    const size_t half_b = (size_t)32 * ld * 2, tile_b = (size_t)64 * ld * 2; const unsigned ldsw = (unsigned)wave * 1024u;
#define AT_ISSUE(j, stg) do { const size_t jo_ = (size_t)(j) * tile_b; \
        __builtin_amdgcn_global_load_lds((const GAS unsigned*)(ksrc + jo_), (LAS unsigned*)(K_lds + (stg) * 16384 + ldsw), 16, 0, 0); \
        __builtin_amdgcn_global_load_lds((const GAS unsigned*)(ksrc + jo_ + half_b), (LAS unsigned*)(K_lds + (stg) * 16384 + 8192 + ldsw), 16, 0, 0); \
        __builtin_amdgcn_global_load_lds((const GAS unsigned*)(vsrc + jo_), (LAS unsigned*)(V_lds + (stg) * 16384 + ldsw), 16, 0, 0); \
        __builtin_amdgcn_global_load_lds((const GAS unsigned*)(vsrc + jo_ + half_b), (LAS unsigned*)(V_lds + (stg) * 16384 + 8192 + ldsw), 16, 0, 0); } while (0)
    float m_reg = -1e4f, l_reg = 0.f; f32x16 o[4] = {};
    f32x16 negm;
#pragma unroll
    for (int r = 0; r < 16; ++r) negm[r] = 1e4f;
    const int tq_min = __builtin_amdgcn_readfirstlane(tq), lim_min = (tq_min - 31) >> 4;
    asm volatile("s_waitcnt vmcnt(0) lgkmcnt(0)" ::: "memory"); __builtin_amdgcn_s_barrier(); asm volatile("" ::: "memory");
    AT_ISSUE(jlo, 0); if (NT > 1) AT_ISSUE(jlo + 1, 1);
    int stg = 0;
    for (int t = 0; t < NT; ++t) {
        const int j = jlo + t; const int buf = stg;
        if (t + 1 < NT) asm volatile("s_waitcnt vmcnt(4)" ::: "memory"); else asm volatile("s_waitcnt vmcnt(0)" ::: "memory");
        __builtin_amdgcn_s_barrier(); asm volatile("" ::: "memory");
        if (t + 2 < NT) { const int s2 = stg == 0 ? 2 : stg - 1; AT_ISSUE(j + 2, s2); }
        bool rowsel = true;
        if (MODE == 1) rowsel = ((bmrow[j >> 5] >> (j & 31)) & 1u) != 0u;
        if (MODE != 1 || __any(rowsel)) {
        f32x16 p0, p1;
        at_qkt(p0, p1, K_lds + buf * 16384, l32, hi, qr, negm);
        const bool need_mask = MODE == 0 ? (64 * j + 63 > lim_min) : (MODE == 1 ? (64 * j + 63 > tq_min) : (64 * j + 63 > tq_min || 64 * j <= tq_min + 7 - WIN));
        if (need_mask) at_mask<MODE>(p0, p1, 64 * j, hi, tq, lim, true);
        bf16x8 pa0, pa1, pa2, pa3;
        const float alpha = at_softmax(p0, p1, m_reg, negm, l_reg, pa0, pa1, pa2, pa3, rowsel, MODE == 1);
        if (__any(alpha < 1.f)) { if (hi == 0) wsl[l32] = alpha; asm volatile("s_waitcnt lgkmcnt(0)" ::: "memory");
#pragma unroll
            for (int d = 0; d < 4; ++d)
#pragma unroll
                for (int r = 0; r < 16; ++r) o[d][r] *= wsl[crow(r, hi)]; }
        at_pv(o, vb0 + buf * 16384, pa0, pa1, pa2, pa3);
        }
        stg = stg == 2 ? 0 : stg + 1;
    }
    asm volatile("s_waitcnt lgkmcnt(0)" ::: "memory");
    if (hi == 0) wsl[32 + l32] = l_reg > 0.f ? 1.f / l_reg : 0.f;
    asm volatile("s_waitcnt lgkmcnt(0)" ::: "memory");
#pragma unroll
    for (int r = 0; r < 16; ++r) { const int q = crow(r, hi); const float rli = wsl[32 + q]; bf16* op = Obase + (size_t)(8 * wave + (q >> 2)) * 2048 + (q & 3) * 128 + l32;
#pragma unroll
        for (int d0 = 0; d0 < 4; ++d0) op[d0 * 32] = (bf16)f2bf(o[d0][r] * rli); }
    m_out = m_reg; l_out = l_reg;
#undef AT_ISSUE
}
__device__ __forceinline__ void at_importance(LAS unsigned char* lds, const bf16x8 (&qr)[8], const bf16* Kb, int nct, int lim, float m_reg, float l_reg, int tid_in) {
    int tid = tid_in; asm volatile("" : "+v"(tid));
    const int lane = tid & 63, wave = __builtin_amdgcn_readfirstlane(tid >> 6), l32 = lane & 31, hi = lane >> 5;
    LAS unsigned char* K_lds = lds + AT_K;
    LAS float* S4L = (LAS float*)(lds + AT_V); LAS float* LASTL = (LAS float*)(lds + AT_V + 16384);
    LAS float* imp = (LAS float*)(lds + AT_IMP); LAS float* carry = (LAS float*)(lds + AT_CARRY);
    const int sr = tid >> 4, sc = (tid & 15) * 8, kws = KSWZ(sr, sc * 2);
    const int head = l32 & 3, tok = 8 * wave + (l32 >> 2);
    const float linv = l_reg > 0.f ? 1.f / l_reg : 0.f; const f32x16 zero16 = {};
    bf16x8 st_k0, st_k1;
    __syncthreads();
    if (tid < 256) carry[tid] = 0.f;
    { const bf16* kp_ = Kb + (size_t)sr * 128 + sc; st_k0 = *(const GAS bf16x8*)kp_; st_k1 = *(const GAS bf16x8*)(kp_ + 32 * 128); }
    *(LAS bf16x8*)(K_lds + kws) = st_k0; *(LAS bf16x8*)(K_lds + kws + 32 * 256) = st_k1;
    __syncthreads();
    for (int t = 0; t < nct; ++t) {
        const int buf = t & 1;
        if (t + 1 < nct) { const bf16* kp_ = Kb + (size_t)(64 * (t + 1) + sr) * 128 + sc; st_k0 = *(const GAS bf16x8*)kp_; st_k1 = *(const GAS bf16x8*)(kp_ + 32 * 128); }
        f32x16 p0, p1;
        at_qkt(p0, p1, K_lds + buf * 16384, l32, hi, qr, zero16);
        at_mask<0>(p0, p1, 64 * t, hi, 0, lim, true);
#pragma unroll
        for (int r = 0; r < 16; ++r) { p0[r] = __builtin_amdgcn_exp2f(p0[r] - m_reg) * linv; p1[r] = __builtin_amdgcn_exp2f(p1[r] - m_reg) * linv; }
        LAS float* sp = S4L + (head * 64 + tok) * 16 + hi; LAS float* lp = LASTL + (head * 64 + tok) * 16 + hi;
#pragma unroll
        for (int q = 0; q < 4; ++q) { sp[2 * q] = (p0[4 * q] + p0[4 * q + 1]) + (p0[4 * q + 2] + p0[4 * q + 3]); lp[2 * q] = p0[4 * q + 3];
                                      sp[8 + 2 * q] = (p1[4 * q] + p1[4 * q + 1]) + (p1[4 * q + 2] + p1[4 * q + 3]); lp[8 + 2 * q] = p1[4 * q + 3]; }
        if (t + 1 < nct) { *(LAS bf16x8*)(K_lds + (buf ^ 1) * 16384 + kws) = st_k0; *(LAS bf16x8*)(K_lds + (buf ^ 1) * 16384 + kws + 32 * 256) = st_k1; }
        __syncthreads();
#pragma unroll
        for (int i = 0; i < 2; ++i) { const int item = tid + 512 * i, tk = item >> 4, gq = item & 15; float a = 0.f;
#pragma unroll
            for (int h = 0; h < 4; ++h) a += S4L[(h * 64 + tk) * 16 + gq] + (gq > 0 ? LASTL[(h * 64 + tk) * 16 + gq - 1] : carry[(t & 1) * 256 + h * 64 + tk]);
            imp[tk * AT_IMPLD + 16 * t + gq] = a; }
        if (tid < 256) carry[((t + 1) & 1) * 256 + tid] = LASTL[tid * 16 + 15];
        __syncthreads();
    }
}
__device__ __forceinline__ void at_topk(LAS unsigned char* lds, int tb, int tid_in) {
    int tid = tid_in; asm volatile("" : "+v"(tid));
    const int lane = tid & 63, wave = __builtin_amdgcn_readfirstlane(tid >> 6);
    const LAS float* imp = (const LAS float*)(lds + AT_IMP); LAS unsigned* bm = (LAS unsigned*)(lds + AT_BM);
    const int nforced = tb >= 2 ? 3 : tb + 1, nfree = SELTOP - nforced, ncand = tb - 2 > 0 ? tb - 2 : 0;
    const int j0 = lane, j1 = lane + 64;
    const bool c0 = j0 >= 1 && j0 <= tb - 2, c1 = j1 <= tb - 2;
    const bool f0 = (j0 == 0) || (j0 == tb) || (j0 == tb - 1), f1 = (j1 == tb) || (j1 == tb - 1);
    for (int i = 0; i < 8; ++i) { const int tk = wave * 8 + i;
        const unsigned k0 = c0 ? __float_as_uint(imp[tk * AT_IMPLD + j0]) + 1u : 0u, k1 = c1 ? __float_as_uint(imp[tk * AT_IMPLD + j1]) + 1u : 0u;
        bool s0, s1;
        if (ncand <= nfree) { s0 = c0; s1 = c1; }
        else {
            unsigned T = 0u;
            for (int b = 31; b >= 0; --b) { const unsigned cnd = T | (1u << b); const int cnt = __popcll(__ballot(k0 >= cnd)) + __popcll(__ballot(k1 >= cnd)); if (cnt >= nfree) T = cnd; }
            const bool g0 = k0 > T, g1 = k1 > T; const int ngt = __popcll(__ballot(g0)) + __popcll(__ballot(g1)); const int need = nfree - ngt;
            const unsigned long long e0 = __ballot(k0 == T), e1 = __ballot(k1 == T); const unsigned long long below = (1ull << lane) - 1ull;
            const int rk0 = __popcll(e0 & below), rk1 = __popcll(e0) + __popcll(e1 & below);
            s0 = g0 || (k0 == T && rk0 < need); s1 = g1 || (k1 == T && rk1 < need);
        }
        const unsigned long long m0 = __ballot(s0 || f0), m1 = __ballot(s1 || f1);
        if (lane == 0) { bm[tk * 4 + 0] = (unsigned)m0; bm[tk * 4 + 1] = (unsigned)(m0 >> 32); bm[tk * 4 + 2] = (unsigned)m1; bm[tk * 4 + 3] = (unsigned)(m1 >> 32); }
    }
}
__device__ __forceinline__ void attn_unit(LAS unsigned char* lds, int g, int tb, const bf16* PROJ, const bf16* KC, const bf16* VC, bf16* AO, int tid) {
    const int lane = tid & 63, wave = __builtin_amdgcn_readfirstlane(tid >> 6), l32 = lane & 31, hi = lane >> 5;
    const int tokl = 8 * wave + (l32 >> 2), head = 4 * g + (l32 & 3), T0 = 64 * tb, tq = T0 + tokl;
    bf16x8 qr[8];
#pragma unroll
    for (int d0 = 0; d0 < 8; ++d0) qr[d0] = *(const GAS bf16x8*)(PROJ + (size_t)tq * NPROJ + OFF_Q + head * 128 + d0 * 16 + hi * 8);
    bf16* Orow0 = AO + (size_t)T0 * 2048 + 4 * g * 128;
    const int nct = tb / 16 + 1; const int lim = (tq - 31) >> 4;
    float m_c, l_c, m_d, l_d;
    at_branch<0>(lds, qr, KC + (size_t)g * 512 * 128, VC + (size_t)g * 512 * 128, 128, 0, nct, tq, lim, nullptr, Orow0, m_c, l_c, tid);
    at_importance(lds, qr, KC + (size_t)g * 512 * 128, nct, lim, m_c, l_c, tid);
    __syncthreads();
    at_topk(lds, tb, tid);
    __syncthreads();
    const LAS unsigned* bmrow = (const LAS unsigned*)(lds + AT_BM) + tokl * 4;
    at_branch<1>(lds, qr, PROJ + OFF_KS + g * 128, PROJ + OFF_VS + g * 128, NPROJ, 0, tb + 1, tq, 0, bmrow, Orow0 + (size_t)S * 2048, m_d, l_d, tid);
    const int jlo = tb - 8 > 0 ? tb - 8 : 0;
    at_branch<2>(lds, qr, PROJ + OFF_KW + g * 128, PROJ + OFF_VW + g * 128, NPROJ, jlo, tb - jlo + 1, tq, 0, nullptr, Orow0 + (size_t)2 * S * 2048, m_d, l_d, tid);
    __syncthreads();
}


constexpr int CM_RED = 0, CM_H = 16384, CM_HLD = 136;
constexpr int CM_STG = 8192 + 32768, CM_NSTG = 3;
static_assert(CM_NSTG * CM_STG <= 131072, "compression ring");
__device__ __forceinline__ void cmp_unit(LAS unsigned char* lds, int kv, int g, int ib, const bf16* PROJ, const bf16* W1T, const bf16* W2T, const float* B1P, bf16* OUT, int tid_in) {
    int tid = tid_in; asm volatile("" : "+v"(tid));
    const int lane = tid & 63, wave = __builtin_amdgcn_readfirstlane(tid >> 6), l32 = lane & 31, hi = lane >> 5, nt = wave & 3, kh = wave >> 2;
    LAS float* red = (LAS float*)(lds + CM_RED); LAS bf16* Hs = (LAS bf16*)(lds + CM_H);
    const int coff = (kv == 0 ? OFF_KC : OFF_VC) + g * 128;
    const int sr = tid >> 4, spc = tid & 15, slc = spc ^ (sr & 7);
    const int ia = 32 * ib + sr, iac = ia < 510 ? ia : 510;
    const char* asrc = (const char*)(PROJ + (size_t)(16 * iac) * NPROJ + coff + 8 * slc);
    const char* bsrc = (const char*)(W1T + (size_t)sr * 4096 + 8 * slc);
    const unsigned ldsw = (unsigned)wave * 1024u;
#define CM_ISSUE(l_, stg_) do { LAS unsigned char* sb_ = lds + (stg_) * CM_STG; \
        __builtin_amdgcn_global_load_lds((const unsigned*)(asrc + (size_t)(l_) * (NPROJ * 2)), (LAS unsigned*)(sb_ + ldsw), 16, 0, 0); \
        _Pragma("unroll") for (int q_ = 0; q_ < 4; ++q_) \
            __builtin_amdgcn_global_load_lds((const unsigned*)(bsrc + (size_t)q_ * (32 * 4096 * 2) + (size_t)(l_) * 256), (LAS unsigned*)(sb_ + 8192 + q_ * 8192 + ldsw), 16, 0, 0); } while (0)
    f32x16 acc = {};
    asm volatile("s_waitcnt vmcnt(0) lgkmcnt(0)" ::: "memory"); __builtin_amdgcn_s_barrier();
    CM_ISSUE(0, 0); CM_ISSUE(1, 1);
    const int sw = l32 & 7;
    for (int l = 0; l < 32; ++l) { const int stg = l % CM_NSTG;
        if (l + 1 < 32) asm volatile("s_waitcnt vmcnt(5)" ::: "memory"); else asm volatile("s_waitcnt vmcnt(0)" ::: "memory");
        __builtin_amdgcn_s_barrier(); asm volatile("" ::: "memory");
        if (l + 2 < 32) CM_ISSUE(l + 2, (l + 2) % CM_NSTG);
        const LAS unsigned char* ap = lds + stg * CM_STG + l32 * 256; const LAS unsigned char* bp = lds + stg * CM_STG + 8192 + (32 * nt + l32) * 256;
#pragma unroll
        for (int kk = 0; kk < 4; ++kk) { const int c = (2 * (4 * kh + kk) + hi) ^ sw;
            const bf16x8 a = *(const LAS bf16x8*)(ap + 16 * c), b = *(const LAS bf16x8*)(bp + 16 * c); acc = __builtin_amdgcn_mfma_f32_32x32x16_bf16(a, b, acc, 0, 0, 0); }
    }
#undef CM_ISSUE
    asm volatile("s_waitcnt lgkmcnt(0)" ::: "memory"); __builtin_amdgcn_s_barrier(); asm volatile("" ::: "memory");
    if (kh == 1) {
#pragma unroll
        for (int r = 0; r < 16; ++r) red[(nt * 16 + r) * 64 + lane] = acc[r]; }
    __syncthreads();
    if (kh == 0) { const int n = 32 * nt + l32; float b1 = 0.f;
#pragma unroll
        for (int kc = 0; kc < 16; ++kc) b1 += B1P[kc * 128 + n];
#pragma unroll
        for (int r = 0; r < 16; ++r) { float v = acc[r] + red[(nt * 16 + r) * 64 + lane] + b1; v = v / (1.f + __expf(-v)); Hs[crow(r, hi) * CM_HLD + n] = (bf16)f2bf(v); } }
    __syncthreads();
    if (wave < 4) { f32x16 a2 = {};
#pragma unroll
        for (int kk = 0; kk < 8; ++kk) { const bf16x8 a = *(const LAS bf16x8*)(Hs + l32 * CM_HLD + 16 * kk + 8 * hi), b = *(const GAS bf16x8*)(W2T + (size_t)(32 * wave + l32) * 128 + 16 * kk + 8 * hi);
            a2 = __builtin_amdgcn_mfma_f32_32x32x16_bf16(a, b, a2, 0, 0, 0); }
#pragma unroll
        for (int r = 0; r < 16; ++r) { const int irow = 32 * ib + crow(r, hi); OUT[(size_t)irow * 128 + 32 * wave + l32] = irow < NCMP ? (bf16)f2bf(a2[r]) : (bf16)0; } }
    __syncthreads();
}

struct Args { const float* in[18]; float* out; unsigned char* ws; };


__global__ void __launch_bounds__(NWAVES * 64, 2) hybrid_fwd(Args args) {
    extern __shared__ __attribute__((aligned(16))) unsigned char lds[];
    Frame F;
    F.lds = (LAS unsigned char*)lds;
    F.MISC = (volatile LAS unsigned*)(F.lds + MISC_OFF);
    F.tid = threadIdx.x; F.lane = F.tid & 63; F.wave = __builtin_amdgcn_readfirstlane(F.tid >> 6);
    F.G = gridDim.x; { const int bx = blockIdx.x; F.vcu = (F.G % 8 == 0) ? (bx % 8) * (F.G / 8) + bx / 8 : bx; }
    unsigned char* ws = args.ws;
    F.ctl = (gu32*)(ws + WS_CTL);
    for (int u = F.tid; u < (LDS_BYTES - LDSCTL_OFF) / 4; u += NWAVES * 64) ((LAS unsigned*)(F.lds + LDSCTL_OFF))[u] = 0u;
    __syncthreads();
    (void)xcd_barrier_post((unsigned*)(F.ctl + CW_BAR), F.MISC + 8);
#define GRID_BAR() do { unsigned long long wz_ = 0; asm volatile("" : "+s"(wz_)); unsigned char* wsb_ = args.ws + wz_;     XcdBarrier b_; b_.bar = (unsigned*)((gu32*)(wsb_ + WS_CTL) + CW_BAR); b_.x = xb_xcc_id(); b_.st = (volatile LAS unsigned*)(F.lds + MISC_OFF) + 8; xcd_barrier(b_); } while (0)
#define PHASE_IDS() int tid_l_ = threadIdx.x; asm volatile("" : "+v"(tid_l_)); const int tid = tid_l_, lane = tid & 63, wave = __builtin_amdgcn_readfirstlane(tid >> 6); \
    const int gw = F.vcu * NWAVES + wave, NGW = F.G * NWAVES, gt = F.vcu * (NWAVES * 64) + tid, NGT = F.G * NWAVES * 64; (void)gw; (void)NGW; (void)gt; (void)NGT; (void)lane

    const float* x_in = args.in[0];
    bf16* XN = (bf16*)(ws + WS_XN); float* COS = (float*)(ws + WS_COS); float* SIN = (float*)(ws + WS_SIN);
    {
        PHASE_IDS();
        LAS float* scr = (LAS float*)(F.lds + RING_OFF + wave * 16384);
        constexpr int I_IN = (DM / 64) * (NPROJ / 32), I_O = (DM / 64) * (DM / 32), I_UP = (DM / 64) * (FF / 32), I_DN = (FF / 64) * (DM / 32);
        constexpr int I_L = I_IN + I_O + I_UP + I_DN;
        for (int rep = 0; rep < REP_PRO; ++rep)
        for (int it = gw; it < DEPTH * I_L; it += NGW) {
            const int l = it / I_L; int r = it % I_L;
            if (r < I_IN) { if (l >= PROJ_F8_FROM) p0_transpose_item_f8<true, 1>(args.in[2] + (size_t)l * DM * NSRC, DM, NSRC, NPROJ / 32, (unsigned char*)(ws + WS_WIN + l * SZ_WIN), WUP8_SCALE, args.in[1] + l * DM, args.in[1] + l * DM, DM, scr, r, lane);
                else p0_transpose_item<1, true>(args.in[2] + (size_t)l * DM * NSRC, DM, NSRC, NPROJ / 32, (bf16*)(ws + WS_WIN + l * SZ_WIN), args.in[1] + l * DM, args.in[1] + l * DM, DM, scr, r, lane); continue; } r -= I_IN;
            if (r < I_O) { if (l >= WO_F8_FROM) p0_transpose_item_f8<true>(args.in[13] + (size_t)l * DM * DM, DM, DM, DM / 32, (unsigned char*)(ws + WS_WO + l * SZ_WO), 64.f, args.in[6] + l * 2048, args.in[12] + l * 2048, 2048, scr, r, lane);
                else p0_transpose_item<0, true>(args.in[13] + (size_t)l * DM * DM, DM, DM, DM / 32, (bf16*)(ws + WS_WO + l * SZ_WO), args.in[6] + l * 2048, args.in[12] + l * 2048, 2048, scr, r, lane); continue; } r -= I_O;
            if (r < I_UP) { p0_transpose_item_f8<true>(args.in[15] + (size_t)l * DM * FF, DM, FF, FF / 32, (unsigned char*)(ws + WS_WUP + l * SZ_WUP), WUP8_SCALE, args.in[14] + l * DM, args.in[14] + l * DM, DM, scr, r, lane); continue; } r -= I_UP;
            p0_transpose_item_f8<false>(args.in[16] + (size_t)l * FF * DM, FF, DM, DM / 32, (unsigned char*)(ws + WS_WDN + l * SZ_WDN), 128.f, args.in[16], args.in[16], 0, scr, r, lane);
        }
        for (int it = gw; it < DEPTH * 2 * (256 + 8); it += NGW) { const int lk = it / 264, r = it % 264, kvv = lk & 1;
            const float* w1 = args.in[4] + (size_t)lk * 4096 * 128; const float* w2 = args.in[5] + (size_t)lk * 128 * 128;
            bf16* w1t = (bf16*)(ws + WS_W1T) + (size_t)lk * 128 * 4096; bf16* w2t = (bf16*)(ws + WS_W2T) + (size_t)lk * 128 * 128;
            if (r < 256) { if (kvv == 0) p0_transpose_item<0, false, true>(w1, 4096, 128, 4, w1t, w1, w1, 0, scr, r, lane); else p0_transpose_item<0, false, false>(w1, 4096, 128, 4, w1t, w1, w1, 0, scr, r, lane); }
            else { if (kvv == 0) p0_transpose_item<2, false, false>(w2, 128, 128, 4, w2t, w2, w2, 0, scr, r - 256, lane); else p0_transpose_item<0, false, false>(w2, 128, 128, 4, w2t, w2, w2, 0, scr, r - 256, lane); } }
        for (int e = gt; e < DEPTH * 2 * 16 * 128; e += NGT) { const int n = e & 127, kc = (e >> 7) & 15, lk = e >> 11;
            const float* w1 = args.in[4] + ((size_t)lk * 4096 + kc * 256) * 128 + n; const float* ps = args.in[3] + (size_t)lk * 4096 + kc * 256; float a = 0.f;
#pragma unroll 32
            for (int k = 0; k < 256; ++k) a += ps[k] * w1[(size_t)k * 128];
            ((float*)(ws + WS_B1P))[e] = a; }
        for (int e = gt; e < S * 64; e += NGT) { const int t = e >> 6, i = e & 63;
            const float inv = 1.0f / powf(10000.0f, (float)i * (1.0f / 64.0f)); const float ang = (float)t * inv;
            COS[e] = cosf(ang); SIN[e] = sinf(ang); }
        for (int m = gw; m < S; m += NGW) rms_row_to_bf16(x_in + (size_t)m * DM, XN + (size_t)m * DM, lane);
    }
    GRID_BAR();

    for (int L = 0; L < DEPTH; ++L) {
        { unsigned long long wz = 0; asm volatile("" : "+s"(wz)); ws = args.ws + wz; }
        bf16* Hres = (bf16*)(ws + WS_H);     static_assert(DEPTH == 2 && WO_F8_FROM == 1 && PROJ_F8_FROM == 1, "the phase instantiations below are written for this precision plan");
        bf16* XN = (bf16*)(ws + WS_XN); bf16* PROJ = (bf16*)(ws + WS_PROJ); bf16* ACT = (bf16*)(ws + WS_ACT); unsigned char* CAT = (unsigned char*)(ws + WS_CAT);     const bool wo_f8 = L >= WO_F8_FROM;
        float* ATT = (float*)(ws + WS_ATT); bf16* XBC = (bf16*)(ws + WS_XBC); bf16* Y = (bf16*)(ws + WS_Y);
        bf16* KC = (bf16*)(ws + WS_KC); bf16* VC = (bf16*)(ws + WS_VC); float* DT = (float*)(ws + WS_DT); float* ADT = (float*)(ws + WS_ADT);
        float* COS = (float*)(ws + WS_COS); float* SIN = (float*)(ws + WS_SIN); unsigned* BMP = (unsigned*)(ws + WS_BMP);
        bf16* AO = (bf16*)(ws + WS_ACT);     float* STT = (float*)(ws + WS_ST); bf16* PREVB = (bf16*)(ws + WS_PREV);     float* ACSG = (float*)(ws + WS_ACSG); float* DEC = (float*)(ws + WS_DEC);

        {
            const bool split = (L < PROJ_F8_FROM) && (F.G == 256);
            if (L >= PROJ_F8_FROM) { pg8::StaticOrder So; So.init(S, NPROJ, F.G, (int)blockIdx.x); pg8::Gemm g{XN, (const bf16*)(ws + WS_WIN + L * SZ_WIN), S, NPROJ, DM / 2};
                pg8::EpiProj E{PROJ, NPROJ, COS, SIN, QSCALE, 1.f / (XN8_SCALE * WUP8_SCALE), 0};
                pg8::gemm_phase<pg8::EpiProj, pg8::StaticOrder, true, true, true>(F.lds + RING_OFF, g, So, E); }
            else {
#pragma unroll 1
                for (int part = 0; part < (split ? 2 : 1); ++part) { const int c0p = part ? P1_SPLIT : 0, ncp = split ? (part ? NPROJ - P1_SPLIT : P1_SPLIT) : NPROJ;
                    pg8::StaticOrder So; So.init(S, ncp, F.G, (int)blockIdx.x); pg8::Gemm g{XN, (const bf16*)(ws + WS_WIN + L * SZ_WIN) + (size_t)c0p * DM, S, ncp, DM};
                    pg8::EpiProj E{PROJ, NPROJ, COS, SIN, QSCALE, 1.f, c0p / 256};
                    pg8::gemm_phase<pg8::EpiProj, pg8::StaticOrder, true, true>(F.lds + RING_OFF, g, So, E);
                    if (split && part == 0) GRID_BAR(); } }
        }
        {
            const bool split = (L < PROJ_F8_FROM) && (F.G == 256); const int bxp = bx_l(); const bool early = split && bxp >= (NPROJ - P1_SPLIT) / 256 * 32;
            const int ew = ((F.vcu >> 5) * 12 + ((F.vcu & 31) - 20));
#pragma unroll 1
            for (int pass = 0; pass < 2; ++pass) {
                const bool run = pass == 0 ? early : !split;
                if (run) {
                    PHASE_IDS();
#pragma unroll 1
                    for (int pv = (pass == 0 ? ew : F.vcu); pv < (pass == 0 ? 256 : F.vcu + 1); pv += 96) {
                        asm volatile("s_waitcnt vmcnt(0) lgkmcnt(0)" ::: "memory"); __syncthreads();
            for (int rep = 0; rep < REP_CMP; ++rep)
            for (int u = pv; u < 2 * NKV * 16; u += F.G) { const int kvv = u >> 6, g = (u >> 4) & 3, ib = u & 15; const int lk = L * 2 + kvv;
                cmp_unit(F.lds + RING_OFF, kvv, g, ib, PROJ, (const bf16*)(ws + WS_W1T) + (size_t)lk * 128 * 4096, (const bf16*)(ws + WS_W2T) + (size_t)lk * 128 * 128,
                         (const float*)(ws + WS_B1P) + (size_t)lk * 16 * 128, (kvv == 0 ? KC : VC) + (size_t)g * 512 * 128, tid); }
            { const float* cvw = args.in[7] + (size_t)L * 4 * CONVD; const float* cvb = args.in[8] + (size_t)L * CONVD; const int c0 = 8 * tid;
              float wv[4][8], bv[8];
#pragma unroll
              for (int j = 0; j < 8; ++j) bv[j] = cvb[c0 + j];
#pragma unroll
              for (int k = 0; k < 4; ++k)
#pragma unroll
                  for (int j = 0; j < 8; ++j) wv[k][j] = cvw[k * CONVD + c0 + j];
              const bool cv_w = (F.G == 256); const int nblk = cv_w ? (pv < 128 ? 1 : 7) : 1, blk0 = cv_w ? (pv < 128 ? pv : 128 + 7 * (pv - 128)) : pv, bstep = cv_w ? 1 : F.G, bend = cv_w ? blk0 + nblk : S / 8;
              for (int rep = 0; rep < REP_CONV; ++rep)
              for (int blk = blk0; blk < bend; blk += bstep) { const int t0 = 8 * blk;
                v4u rw[11];
#pragma unroll
                for (int i = 0; i < 11; ++i) { const int tt = t0 - 3 + i; rw[i] = tt >= 0 ? *(const GAS v4u*)(PROJ + (size_t)tt * NPROJ + OFF_XBC + c0) : (v4u){0u, 0u, 0u, 0u}; }
#pragma unroll
                for (int o8 = 0; o8 < 8; ++o8) { float a[8];
#pragma unroll
                    for (int j = 0; j < 8; ++j) a[j] = bv[j];
#pragma unroll
                    for (int k = 0; k < 4; ++k) { const v4u w = rw[o8 + k];
                        const float f[8] = {bflo(w.x), bfhi(w.x), bflo(w.y), bfhi(w.y), bflo(w.z), bfhi(w.z), bflo(w.w), bfhi(w.w)};
#pragma unroll
                        for (int j = 0; j < 8; ++j) a[j] += f[j] * wv[k][j]; }
#pragma unroll
                    for (int j = 0; j < 8; ++j) a[j] = a[j] / (1.f + __expf(-a[j]));
                    v4u o; o.x = pk2(a[0], a[1]); o.y = pk2(a[2], a[3]); o.z = pk2(a[4], a[5]); o.w = pk2(a[6], a[7]);
                    *(GAS v4u*)(XBC + (size_t)(t0 + o8) * CONVD + c0) = o; } } }
                    }
                }
                if (pass == 0) { GRID_BAR(); for (int rb = 0; rb < REP_BAR; ++rb) GRID_BAR(); }
            }
        }
        if (!((L < PROJ_F8_FROM) && (F.G == 256))) GRID_BAR();
        {
            PHASE_IDS();
            for (int rep = 0; rep < REP_ATTN; ++rep)
            for (int u = F.vcu; u < 256; u += F.G) { const int g = u & 3, tbp = u >> 2;
#pragma unroll 1
                for (int uu = 0; uu < 2; ++uu) attn_unit(F.lds + RING_OFF, g, uu ? tbp : 127 - tbp, PROJ, KC, VC, AO, tid); }
        }
        __syncthreads();
        {
            PHASE_IDS();
            for (int rep = 0; rep < REP_SSD; ++rep)
            for (int u = F.vcu; u < NCHUNK * SSM_G; u += F.G) ssd1_unit(F.lds + RING_OFF, u >> 3, u & 7, XBC, PROJ, args.in[9] + L * 32, args.in[10] + L * 32, Y, STT, DEC, ACSG, tid);
        }
        GRID_BAR();
        {
            PHASE_IDS();
            for (int rep = 0; rep < REP_AN; ++rep)
            for (int t = gw; t < S; t += NGW) {
                f32x4 v[8]; float s = 0.f;
#pragma unroll
                for (int j = 0; j < 8; ++j) { const int hd = 2 * j + (lane >> 5); const bf16* gp = PROJ + (size_t)t * NPROJ + OFF_G + hd;
                    const float g0 = 1.f / (1.f + __expf(-bf2f(gp[0]))), g1 = 1.f / (1.f + __expf(-bf2f(gp[16]))), g2 = 1.f / (1.f + __expf(-bf2f(gp[32])));
                    const size_t off = (size_t)t * 2048 + 256 * j + 4 * lane;
                    const unsigned long long u0 = *(const GAS unsigned long long*)(AO + off), u1 = *(const GAS unsigned long long*)(AO + (size_t)S * 2048 + off), u2 = *(const GAS unsigned long long*)(AO + (size_t)2 * S * 2048 + off);
                    const f32x4 a0 = {bflo((unsigned)u0), bfhi((unsigned)u0), bflo((unsigned)(u0 >> 32)), bfhi((unsigned)(u0 >> 32))}, a1 = {bflo((unsigned)u1), bfhi((unsigned)u1), bflo((unsigned)(u1 >> 32)), bfhi((unsigned)(u1 >> 32))},
                                a2 = {bflo((unsigned)u2), bfhi((unsigned)u2), bflo((unsigned)(u2 >> 32)), bfhi((unsigned)(u2 >> 32))};
                    v[j] = a0 * g0 + a1 * g1 + a2 * g2; s += (v[j].x * v[j].x + v[j].y * v[j].y) + (v[j].z * v[j].z + v[j].w * v[j].w); }
                const float rstd = 1.f / sqrtf(wave_sum(s) * (1.f / 2048.f) + EPS);
                if (wo_f8) { GAS unsigned* o4 = (GAS unsigned*)(CAT + (size_t)t * DM) + lane;
#pragma unroll
                    for (int j = 0; j < 8; ++j) o4[64 * j] = pg8::pk4_fp8(v[j].x * rstd, v[j].y * rstd, v[j].z * rstd, v[j].w * rstd); }
                else { GAS unsigned long long* o8 = (GAS unsigned long long*)((bf16*)CAT + (size_t)t * DM) + lane;
#pragma unroll
                    for (int j = 0; j < 8; ++j) o8[64 * j] = (unsigned long long)pk2(v[j].x * rstd, v[j].y * rstd) | ((unsigned long long)pk2(v[j].z * rstd, v[j].w * rstd) << 32); }
            }
            for (int rep = 0; rep < REP_SCAN; ++rep)
            for (int e = gt; e < SSM_H * SSM_P * SSM_N; e += NGT) { const int h = e >> 13; float st = 0.f; float sv[NCHUNK], dv[NCHUNK];
#pragma unroll
                for (int c = 0; c < NCHUNK; ++c) { sv[c] = STT[(size_t)c * (SSM_H * SSM_P * SSM_N) + e]; dv[c] = DEC[c * 32 + h]; }
#pragma unroll
                for (int c = 0; c < NCHUNK; ++c) { PREVB[(size_t)c * (SSM_H * SSM_P * SSM_N) + e] = (bf16)f2bf(st); st = dv[c] * st + sv[c]; } }
        }
        GRID_BAR();
        {
            PHASE_IDS();
            const float* dsk = args.in[11] + L * 32;
            for (int rep = 0; rep < REP_SSD3; ++rep)
            for (int u = F.vcu; u < NCHUNK * SSM_G; u += F.G) ssd3_unit(F.lds + RING_OFF, u >> 3, u & 7, XBC, PROJ, Y, (bf16*)ATT, PREVB, ACSG, dsk, CAT, wo_f8, tid);
        }
        GRID_BAR();
        {
            pg8::StaticOrder So; So.init(S, DM, F.G, (int)blockIdx.x);
            if (wo_f8) { pg8::Gemm g{(const bf16*)CAT, (const bf16*)(ws + WS_WO + L * SZ_WO), S, DM, DM / 2};
                pg8::EpiResidH<false> E{Hres, (pg8::bf16_t*)Hres, DM, 1.f / 64.f};
                pg8::gemm_phase<pg8::EpiResidH<false>, pg8::StaticOrder, true, true, true>(F.lds + RING_OFF, g, So, E); }
            else { pg8::Gemm g{(const bf16*)CAT, (const bf16*)(ws + WS_WO + L * SZ_WO), S, DM, DM};
                pg8::EpiResidH<true> E{x_in, (pg8::bf16_t*)Hres, DM, 1.f};
                pg8::gemm_phase<pg8::EpiResidH<true>, pg8::StaticOrder, true, true>(F.lds + RING_OFF, g, So, E); }
        }
        GRID_BAR();
        { PHASE_IDS(); if (F.G == 256) rms4h_to_fp8(Hres, (unsigned char*)XN, gw, NGW, lane); else for (int m = gw; m < S; m += NGW) rms_rowh_to_fp8(Hres + (size_t)m * DM, (unsigned char*)XN + (size_t)m * DM, lane); }
        GRID_BAR();
        {
            pg8::Gemm g{XN, (const bf16*)(ws + WS_WUP + L * SZ_WUP), S, FF, DM / 2}; pg8::StaticOrder So; So.init(S, FF, F.G, (int)blockIdx.x);
            pg8::EpiRelu2F8 E{(unsigned char*)ACT, FF, 1.f / (XN8_SCALE * WUP8_SCALE)};
            for (int rep = 0; rep < REP_UP; ++rep)
            pg8::gemm_phase<pg8::EpiRelu2F8, pg8::StaticOrder, true, true, true>(F.lds + RING_OFF, g, So, E);
        }
        GRID_BAR();
        {
            pg8::Gemm g{ACT, (const bf16*)(ws + WS_WDN + L * SZ_WDN), S, DM, FF / 2}; pg8::StaticOrder So; So.init(S, DM, F.G, (int)blockIdx.x);
            pg8::EpiResidH<false> E{Hres, (pg8::bf16_t*)Hres, DM, 1.f / 128.f};
            pg8::gemm_phase<pg8::EpiResidH<false>, pg8::StaticOrder, true, true, true>(F.lds + RING_OFF, g, So, E);
        }
        GRID_BAR();
        if (L + 1 < DEPTH) { PHASE_IDS(); if (F.G == 256) rms4h_to_fp8(Hres, (unsigned char*)XN, gw, NGW, lane); else for (int m = gw; m < S; m += NGW) rms_rowh_to_fp8(Hres + (size_t)m * DM, (unsigned char*)XN + (size_t)m * DM, lane); GRID_BAR(); }
        else {
            PHASE_IDS();
            const float* nf = args.in[17];
            for (int rep = 0; rep < REP_FIN; ++rep)
            for (int m = gw; m < S; m += NGW) {
                const GAS v4u* xr = (const GAS v4u*)(Hres + (size_t)m * DM) + lane; v4u v[8]; float s = 0.f;
#pragma unroll
                for (int j = 0; j < 8; ++j) { v[j] = xr[64 * j]; const float a0 = bflo(v[j].x), a1 = bfhi(v[j].x), a2 = bflo(v[j].y), a3 = bfhi(v[j].y), a4 = bflo(v[j].z), a5 = bfhi(v[j].z), a6 = bflo(v[j].w), a7 = bfhi(v[j].w);
                    s += ((a0 * a0 + a1 * a1) + (a2 * a2 + a3 * a3)) + ((a4 * a4 + a5 * a5) + (a6 * a6 + a7 * a7)); }
                const float rstd = 1.f / sqrtf(wave_sum(s) * (1.f / DM) + EPS);
                GAS f32x4* o4 = (GAS f32x4*)(args.out + (size_t)m * DM) + 2 * lane; const GAS f32x4* w4 = (const GAS f32x4*)nf + 2 * lane;
#pragma unroll
                for (int j = 0; j < 8; ++j) { const f32x4 g0 = w4[128 * j], g1 = w4[128 * j + 1];
                    o4[128 * j] = (f32x4){bflo(v[j].x), bfhi(v[j].x), bflo(v[j].y), bfhi(v[j].y)} * rstd * g0; o4[128 * j + 1] = (f32x4){bflo(v[j].z), bfhi(v[j].z), bflo(v[j].w), bfhi(v[j].w)} * rstd * g1; }
            }
        }
    }
}

extern "C" void kernel_launch(void* const* d_in, const int* in_sizes, int n_in, void* d_out, int out_size, void* d_ws, size_t ws_size, hipStream_t stream) {
    static int grid = 0;
    if (grid == 0) {
        if (n_in != 18 || in_sizes[0] != S * DM || out_size != S * DM || ws_size < WS_END) { fprintf(stderr, "kernel_launch: shape/workspace mismatch: n_in %d in0 %d out %d ws %zu (need %zu)\n", n_in, n_in > 0 ? in_sizes[0] : -1, out_size, ws_size, (size_t)WS_END); grid = -1; return; }
        int dev = 0, cus = 0, per_cu = 0;
        if (hipGetDevice(&dev) != hipSuccess || hipDeviceGetAttribute(&cus, hipDeviceAttributeMultiprocessorCount, dev) != hipSuccess) { grid = -1; return; }
        if (hipFuncSetAttribute((const void*)hybrid_fwd, hipFuncAttributeMaxDynamicSharedMemorySize, LDS_BYTES) != hipSuccess) { fprintf(stderr, "kernel_launch: hipFuncSetAttribute failed\n"); grid = -1; return; }
        if (hipOccupancyMaxActiveBlocksPerMultiprocessor(&per_cu, (const void*)hybrid_fwd, NWAVES * 64, LDS_BYTES) != hipSuccess || per_cu < 1) fprintf(stderr, "kernel_launch: occupancy query reports %d\n", per_cu);
        (void)hipGetLastError();
        grid = cus;
    }
    if (grid < 0) return;
    if (hipMemsetAsync((char*)d_ws + WS_CTL, 0, CTL_ZERO_BYTES, stream) != hipSuccess) return;
    Args a{};
    for (int i = 0; i < 18; ++i) a.in[i] = (const float*)d_in[i];
    a.out = (float*)d_out; a.ws = (unsigned char*)d_ws;
    hipLaunchKernelGGL(hybrid_fwd, dim3(grid), dim3(NWAVES * 64), LDS_BYTES, stream, a);
}
```

```cpp
#include <hip/hip_runtime.h>
#include <cstdio>
#include <cstdint>
#include <cmath>
#ifndef REP_ATTN
#define REP_ATTN 1
#endif
#ifndef REP_UP
#define REP_UP 1
#endif
#ifndef REP_CMP
#define REP_CMP 1
#endif
#ifndef REP_PRO
#define REP_PRO 1
#endif
#ifndef REP_SSD
#define REP_SSD 1
#endif
#ifndef REP_LIGHT
#define REP_LIGHT 1
#endif
#ifndef REP_RMS
#define REP_RMS 1
#endif
#ifndef REP_CONV
#define REP_CONV 1
#endif
#ifndef REP_AN
#define REP_AN 1
#endif
#ifndef REP_SCAN
#define REP_SCAN 1
#endif
#ifndef REP_PROJ
#define REP_PROJ 1
#endif
#ifndef REP_BAR
#define REP_BAR 0
#endif
#ifndef REP_FIN
#define REP_FIN 1
#endif
#ifndef REP_SSD3
#define REP_SSD3 1
#endif
namespace pg8 {
#define PG8_LAS __attribute__((address_space(3)))
typedef unsigned short bf16_t;
typedef short bf16x8 __attribute__((ext_vector_type(8)));
typedef float f32x4 __attribute__((ext_vector_type(4)));
typedef unsigned u32x4 __attribute__((ext_vector_type(4)));
typedef int i32x4 __attribute__((ext_vector_type(4)));
typedef int i32x8 __attribute__((ext_vector_type(8)));
constexpr int BM = 256, BK = 64, HALF = 128, HTB = HALF * BK * 2  , STAGE_BYTES = 8 * HTB, NXCD = 8, WGM = 8;

__host__ __device__ __forceinline__ int lds_byte(int r, int c) { const int st = (r >> 4) * 2 + (c >> 5), rr = r & 15, cc = c & 31, ob = rr * 64 + cc * 2; return st * 1024 + (ob ^ (((ob >> 9) & 1) << 5)); }
__host__ __device__ __forceinline__ void stage_rc(int b, int& R, int& C) { const int st = b / 1024, sb = b % 1024, swz = sb ^ (((sb >> 9) & 1) << 5); R = (st >> 1) * 16 + swz / 64; C = (st & 1) * 32 + (swz % 64) / 2; }
__host__ __device__ __forceinline__ int perm32(int rho) { const int n = rho >> 4, i = rho & 15; return 8 * (i >> 2) + 4 * n + (i & 3); }

struct Unit { int pm, pn; };
struct Gemm { const bf16_t* A; const bf16_t* Bt; int M, N, K; };

struct StaticOrder {
    int nM, nN, nwg, G, c;
    __host__ __device__ void init(int M, int N, int G_, int c_) { nM = M / BM; nN = N / BM; nwg = nM * nN; G = G_; c = c_; }
    __host__ __device__ bool next(int i, Unit& u) const {
        const long L = (long)i * G + c; if (L >= nwg) return false;
        int wgid = (int)L; { const int q = nwg / NXCD, r = nwg % NXCD, xcd = wgid % NXCD, off = wgid / NXCD; wgid = (xcd < r ? xcd * (q + 1) : r * (q + 1) + (xcd - r) * q) + off; }
        const int nig = WGM * nN, gid = wgid / nig, fm = gid * WGM, gsz = (nM - fm) < WGM ? (nM - fm) : WGM;
        u.pm = fm + ((wgid % nig) % gsz); u.pn = (wgid % nig) / gsz; return true;
    }
    __device__ __forceinline__ void a_ready(const Unit&) const {}
    __device__ __forceinline__ void done(const Unit&) const {}
};

__device__ __forceinline__ unsigned cvt_pk_bf16(float lo, float hi) { unsigned r; asm volatile("v_cvt_pk_bf16_f32 %0, %1, %2" : "=v"(r) : "v"(lo), "v"(hi)); return r; }
typedef float f32x2 __attribute__((ext_vector_type(2)));
struct EpiProj {
    static constexpr bool PERM = true, AFTER_DRAIN = false;
    bf16_t* O; int ldc; const float* cosT; const float* sinT; float qscale; float osc; int pn0;
    template <bool ROPE>
    __device__ __forceinline__ void body(const f32x4 (&acc)[2][2][4][2], int row0, int colt, int cw, float sc) const {
        f32x4 ca[8], sa[8];
#define EPIPROJ_LD(g) do { const int row_ = row0 + ((g) >> 2) * HALF + ((g) & 3) * 16; ca[g] = *(const f32x4*)(cosT + (size_t)row_ * 64 + (cw >> 1)); sa[g] = *(const f32x4*)(sinT + (size_t)row_ * 64 + (cw >> 1)); } while (0)
        if (ROPE) { EPIPROJ_LD(0); EPIPROJ_LD(1); EPIPROJ_LD(2); EPIPROJ_LD(3); asm volatile("" ::: "memory"); }
#pragma unroll
        for (int g = 0; g < 8; ++g) { const int ai = g >> 2, m = g & 3; const int row = row0 + ai * HALF + m * 16;
            if (ROPE && g == 2) { asm volatile("" ::: "memory"); EPIPROJ_LD(4); EPIPROJ_LD(5); EPIPROJ_LD(6); EPIPROJ_LD(7); asm volatile("" ::: "memory"); }
#pragma unroll
            for (int bj = 0; bj < 2; ++bj) {
                f32x4 v0 = acc[ai][bj][m][0], v1 = acc[ai][bj][m][1];
                if (ROPE) { const f32x4 cc = ca[g], ss = sa[g]; f32x4 r0, r1;
                    r0[0] = v0[0] * cc[0] - v0[1] * ss[0]; r0[1] = v0[1] * cc[0] + v0[0] * ss[0];
                    r0[2] = v0[2] * cc[1] - v0[3] * ss[1]; r0[3] = v0[3] * cc[1] + v0[2] * ss[1];
                    r1[0] = v1[0] * cc[2] - v1[1] * ss[2]; r1[1] = v1[1] * cc[2] + v1[0] * ss[2];
                    r1[2] = v1[2] * cc[3] - v1[3] * ss[3]; r1[3] = v1[3] * cc[3] + v1[2] * ss[3];
                    v0 = r0; v1 = r1; }
                v0 = v0 * sc; v1 = v1 * sc;
                u32x4 w; w.x = cvt_pk_bf16(v0[0], v0[1]); w.y = cvt_pk_bf16(v0[2], v0[3]); w.z = cvt_pk_bf16(v1[0], v1[1]); w.w = cvt_pk_bf16(v1[2], v1[3]);
                *(u32x4*)(O + (size_t)row * ldc + colt + bj * HALF + cw) = w; } }
#undef EPIPROJ_LD
    }
    __device__ __forceinline__ void operator()(const f32x4 (&acc)[2][2][4][2], const Unit& u, int wr, int wc, int fr, int fq) const {
        const int row0 = u.pm * BM + wr * 64 + fr; const int colt = (u.pn + pn0) * BM; const int cw = wc * 32 + 8 * fq;
        const int blk0 = 2 * (u.pn + pn0);
        const bool rope = blk0 < 16 || (blk0 < 40 && ((((blk0 - 16) >> 2) & 1) == 0)); const float sc = (blk0 < 16 ? qscale : 1.f) * osc;
        if (rope) body<true>(acc, row0, colt, cw, sc); else body<false>(acc, row0, colt, cw, sc);
    }
};
struct EpiResid {
    static constexpr bool PERM = false, AFTER_DRAIN = false;
    const float* base; float* out; int ldc; float scale;
    __device__ __forceinline__ void operator()(const f32x4 (&acc)[2][2][4][2], const Unit& u, int wr, int wc, int fr, int fq) const {
        const int row0 = u.pm * BM + wr * 64 + fr, col0 = u.pn * BM + wc * 32 + 4 * fq;
        f32x4 cur[2][2], nxt[2][2];
        { const size_t off = (size_t)row0 * ldc + col0;
#pragma unroll
          for (int bj = 0; bj < 2; ++bj)
#pragma unroll
              for (int n = 0; n < 2; ++n) cur[bj][n] = *(const f32x4*)(base + off + bj * HALF + n * 16); }
#pragma unroll
        for (int gi = 0; gi < 8; ++gi) { const int ai = gi >> 2, m = gi & 3; const size_t off = (size_t)(row0 + ai * HALF + m * 16) * ldc + col0;
            if (gi < 7) { const int ai2 = (gi + 1) >> 2, m2 = (gi + 1) & 3; const size_t off2 = (size_t)(row0 + ai2 * HALF + m2 * 16) * ldc + col0;
#pragma unroll
                for (int bj = 0; bj < 2; ++bj)
#pragma unroll
                    for (int n = 0; n < 2; ++n) nxt[bj][n] = *(const f32x4*)(base + off2 + bj * HALF + n * 16); }
            asm volatile("" ::: "memory");
#pragma unroll
            for (int bj = 0; bj < 2; ++bj)
#pragma unroll
                for (int n = 0; n < 2; ++n) *(f32x4*)(out + off + bj * HALF + n * 16) = cur[bj][n] + acc[ai][bj][m][n] * scale;
            asm volatile("" ::: "memory");
#pragma unroll
            for (int bj = 0; bj < 2; ++bj)
#pragma unroll
                for (int n = 0; n < 2; ++n) cur[bj][n] = nxt[bj][n]; }
    }
};

template <bool BASE_F32>
struct EpiResidH {
    static constexpr bool PERM = true, AFTER_DRAIN = false;
    const void* base; bf16_t* out; int ldc; float scale;
    __device__ __forceinline__ void ld(f32x4 (&d)[2][2], size_t off) const {
#pragma unroll
        for (int bj = 0; bj < 2; ++bj) {
            if (BASE_F32) { const float* b = (const float*)base + off + bj * HALF; d[bj][0] = *(const f32x4*)b; d[bj][1] = *(const f32x4*)(b + 4); }
            else { const u32x4 w = *(const u32x4*)((const bf16_t*)base + off + bj * HALF);
                d[bj][0] = (f32x4){__uint_as_float(w.x << 16), __uint_as_float(w.x & 0xffff0000u), __uint_as_float(w.y << 16), __uint_as_float(w.y & 0xffff0000u)};
                d[bj][1] = (f32x4){__uint_as_float(w.z << 16), __uint_as_float(w.z & 0xffff0000u), __uint_as_float(w.w << 16), __uint_as_float(w.w & 0xffff0000u)}; } }
    }
    __device__ __forceinline__ void operator()(const f32x4 (&acc)[2][2][4][2], const Unit& u, int wr, int wc, int fr, int fq) const {
        const int row0 = u.pm * BM + wr * 64 + fr, col0 = u.pn * BM + wc * 32 + 8 * fq;
        f32x4 cur[2][2], nxt[2][2];
        ld(cur, (size_t)row0 * ldc + col0);
#pragma unroll
        for (int gi = 0; gi < 8; ++gi) { const int ai = gi >> 2, m = gi & 3; const size_t off = (size_t)(row0 + ai * HALF + m * 16) * ldc + col0;
            if (gi < 7) { const int ai2 = (gi + 1) >> 2, m2 = (gi + 1) & 3; ld(nxt, (size_t)(row0 + ai2 * HALF + m2 * 16) * ldc + col0); }
            asm volatile("" ::: "memory");
#pragma unroll
            for (int bj = 0; bj < 2; ++bj) { const f32x4 v0 = cur[bj][0] + acc[ai][bj][m][0] * scale, v1 = cur[bj][1] + acc[ai][bj][m][1] * scale;
                u32x4 w; w.x = cvt_pk_bf16(v0[0], v0[1]); w.y = cvt_pk_bf16(v0[2], v0[3]); w.z = cvt_pk_bf16(v1[0], v1[1]); w.w = cvt_pk_bf16(v1[2], v1[3]);
                *(u32x4*)(out + off + bj * HALF) = w; }
            asm volatile("" ::: "memory");
#pragma unroll
            for (int bj = 0; bj < 2; ++bj) { cur[bj][0] = nxt[bj][0]; cur[bj][1] = nxt[bj][1]; } }
    }
};
struct EpiRelu2 {
    static constexpr bool PERM = true, AFTER_DRAIN = false;
    bf16_t* O; int ldc;
    __device__ __forceinline__ void operator()(const f32x4 (&acc)[2][2][4][2], const Unit& u, int wr, int wc, int fr, int fq) const {
        const int row0 = u.pm * BM + wr * 64 + fr; const int col0 = u.pn * BM + wc * 32 + 8 * fq;
#pragma unroll
        for (int ai = 0; ai < 2; ++ai)
#pragma unroll
            for (int m = 0; m < 4; ++m) { bf16_t* rowp = O + (size_t)(row0 + ai * HALF + m * 16) * ldc + col0;
#pragma unroll
                for (int bj = 0; bj < 2; ++bj) { f32x4 v0 = acc[ai][bj][m][0], v1 = acc[ai][bj][m][1];
#pragma unroll
                    for (int e = 0; e < 4; ++e) { const float a = fmaxf(v0[e], 0.f), b = fmaxf(v1[e], 0.f); v0[e] = a * a; v1[e] = b * b; }
                    u32x4 w; w.x = cvt_pk_bf16(v0[0], v0[1]); w.y = cvt_pk_bf16(v0[2], v0[3]); w.z = cvt_pk_bf16(v1[0], v1[1]); w.w = cvt_pk_bf16(v1[2], v1[3]);
                    *(u32x4*)(rowp + bj * HALF) = w; } }
    }
};

__device__ __forceinline__ unsigned pk4_fp8(float a, float b, float c, float d) {
    a = fminf(fmaxf(a, -448.f), 448.f); b = fminf(fmaxf(b, -448.f), 448.f); c = fminf(fmaxf(c, -448.f), 448.f); d = fminf(fmaxf(d, -448.f), 448.f);
    int w = __builtin_amdgcn_cvt_pk_fp8_f32(a, b, 0, false); w = __builtin_amdgcn_cvt_pk_fp8_f32(c, d, w, true); return (unsigned)w; }
struct EpiRelu2F8 {
    static constexpr bool PERM = true, AFTER_DRAIN = false;
    unsigned char* O; int ldc; float sc;
    __device__ __forceinline__ void operator()(const f32x4 (&acc)[2][2][4][2], const Unit& u, int wr, int wc, int fr, int fq) const {
        const int row0 = u.pm * BM + wr * 64 + fr; const int col0 = u.pn * BM + wc * 32 + 8 * fq;
        const int odd = fq & 1;
#pragma unroll
        for (int ai = 0; ai < 2; ++ai)
#pragma unroll
            for (int bj = 0; bj < 2; ++bj) { unsigned lo[4], hi[4];
#pragma unroll
                for (int m = 0; m < 4; ++m) { f32x4 v0 = acc[ai][bj][m][0], v1 = acc[ai][bj][m][1];
#pragma unroll
                    for (int e = 0; e < 4; ++e) { const float a = fmaxf(v0[e] * sc, 0.f), b = fmaxf(v1[e] * sc, 0.f); v0[e] = a * a; v1[e] = b * b; }
                    lo[m] = pk4_fp8(v0[0], v0[1], v0[2], v0[3]); hi[m] = pk4_fp8(v1[0], v1[1], v1[2], v1[3]); }
#pragma unroll
                for (int mp = 0; mp < 4; mp += 2) {
                    auto rl = __builtin_amdgcn_permlane16_swap(lo[mp], lo[mp + 1], false, false); auto rh = __builtin_amdgcn_permlane16_swap(hi[mp], hi[mp + 1], false, false);
                    u32x4 w; w.x = rl[0]; w.y = rh[0]; w.z = rl[1]; w.w = rh[1];
                    *(u32x4*)(O + (size_t)(row0 + ai * HALF + (mp + odd) * 16) * ldc + col0 + bj * HALF - 8 * odd) = w; } }
    }
};
template <class Epi, class Sched, bool ALIGN_EPI = false, bool SP2 = false, bool F8 = false>
__device__ __forceinline__ void gemm_phase(PG8_LAS unsigned char* lds, const Gemm g, const Sched& S, const Epi& E) {
    int tid_o = threadIdx.x; asm volatile("" : "+v"(tid_o));
    const int tid = tid_o, wid = __builtin_amdgcn_readfirstlane(tid >> 6), lane = tid & 63, wr = wid >> 2, wc = wid & 3, fr = lane & 15, fq = lane >> 4;
    const int K = g.K, nt = K / BK;
    unsigned voffA[2], voffB[2];
#pragma unroll
    for (int i = 0; i < 2; ++i) { int R, C; stage_rc(tid * 16 + i * 8192, R, C); const int Rb = Epi::PERM ? ((R & ~31) + perm32(R & 31)) : R;
        voffA[i] = (unsigned)(R * K + C) * 2u; voffB[i] = (unsigned)(Rb * K + C) * 2u; }
    const size_t kstep = (size_t)(BK * 2);
    const size_t hstep = (size_t)HALF * K * 2;
    const size_t tstep = 2 * hstep;
    const unsigned ldsw = (unsigned)wid * 1024u;
    const int aoff = lds_byte(wr * 64 + fr, fq * 8), boff = lds_byte(wc * 32 + fr, fq * 8);
#define PG8_SA(b, h) (((b) * 2 + (h)) * HTB)
#define PG8_SB(b, h) ((4 + (b) * 2 + (h)) * HTB)
#define PG8_STAGE(bufoff, gbase, voff) do { _Pragma("unroll") for (int _i = 0; _i < 2; ++_i) \
        __builtin_amdgcn_global_load_lds((const unsigned*)((const char*)(gbase) + (voff)[_i]), (PG8_LAS unsigned*)(lds + (bufoff) + ldsw + _i * 8192), 16, 0, 0); } while (0)
#define PG8_LDA(dst, b, h) do { if constexpr (F8) { _Pragma("unroll") for (int m = 0; m < 4; ++m) { const i32x4 x0_ = *(const PG8_LAS i32x4*)(lds + PG8_SA(b, h) + aoff + m * 2048), x1_ = *(const PG8_LAS i32x4*)(lds + PG8_SA(b, h) + aoff + m * 2048 + 1024); \
        dst##8[m] = __builtin_shufflevector(x0_, x1_, 0, 1, 2, 3, 4, 5, 6, 7); } } else { _Pragma("unroll") for (int m = 0; m < 4; ++m) _Pragma("unroll") for (int k = 0; k < 2; ++k) dst[m][k] = *(const PG8_LAS bf16x8*)(lds + PG8_SA(b, h) + aoff + m * 2048 + k * 1024); } } while (0)
#define PG8_LDB(dst, b, h) do { if constexpr (F8) { _Pragma("unroll") for (int n = 0; n < 2; ++n) { const i32x4 x0_ = *(const PG8_LAS i32x4*)(lds + PG8_SB(b, h) + boff + n * 2048), x1_ = *(const PG8_LAS i32x4*)(lds + PG8_SB(b, h) + boff + n * 2048 + 1024); \
        dst##8[n] = __builtin_shufflevector(x0_, x1_, 0, 1, 2, 3, 4, 5, 6, 7); } } else { _Pragma("unroll") for (int n = 0; n < 2; ++n) _Pragma("unroll") for (int k = 0; k < 2; ++k) dst[n][k] = *(const PG8_LAS bf16x8*)(lds + PG8_SB(b, h) + boff + n * 2048 + k * 1024); } } while (0)
#define PG8_CAT(x0, x1) __builtin_shufflevector(__builtin_bit_cast(i32x4, x0), __builtin_bit_cast(i32x4, x1), 0, 1, 2, 3, 4, 5, 6, 7)
#define PG8_MMA(ai, bj, At, Bt) do { __builtin_amdgcn_s_setprio(1); if constexpr (F8) { _Pragma("unroll") for (int m = 0; m < 4; ++m) _Pragma("unroll") for (int n = 0; n < 2; ++n) \
        asm volatile("v_mfma_scale_f32_16x16x128_f8f6f4 %0, %1, %2, %0, %3, %3 op_sel_hi:[0,0,0]" : "+v"(acc[ai][bj][m][n]) : "v"(Bt##8[n]), "v"(At##8[m]), "v"(f8scale)); } else { \
        _Pragma("unroll") for (int m = 0; m < 4; ++m) _Pragma("unroll") for (int n = 0; n < 2; ++n) _Pragma("unroll") for (int k = 0; k < 2; ++k) \
        acc[ai][bj][m][n] = __builtin_amdgcn_mfma_f32_16x16x32_bf16(Bt[n][k], At[m][k], acc[ai][bj][m][n], 0, 0, 0); } __builtin_amdgcn_s_setprio(0); } while (0)
#define PG8_WAIT_V(n) asm volatile("s_waitcnt vmcnt(" #n ")" ::: "memory")
#define PG8_WAIT_L(n) asm volatile("s_waitcnt lgkmcnt(" #n ")" ::: "memory")
#define PG8_BAR __builtin_amdgcn_s_barrier()
#define PG8_SCHED __builtin_amdgcn_sched_barrier(0)
    Unit cur, nxt; int ui = 0;
    if (!S.next(0, cur)) return;
    f32x4 acc[2][2][4][2];
#pragma unroll
    for (int a = 0; a < 2; ++a)
#pragma unroll
        for (int b = 0; b < 2; ++b)
#pragma unroll
            for (int m = 0; m < 4; ++m)
#pragma unroll
                for (int n = 0; n < 2; ++n) acc[a][b][m][n] = (f32x4){0.f, 0.f, 0.f, 0.f};
    int f8scale = 0x7F7F7F7F; asm volatile("" : "+v"(f8scale));
    bf16x8 At[4][2], B0[2][2], B1[2][2]; i32x8 At8[4], B08[2], B18[2];
    const char* cA = (const char*)g.A + (size_t)cur.pm * tstep; const char* cB = (const char*)g.Bt + (size_t)cur.pn * tstep;
    S.a_ready(cur);
    if constexpr (SP2) {
        PG8_STAGE(PG8_SB(0, 0), cB, voffB); PG8_STAGE(PG8_SB(0, 1), cB + hstep, voffB); PG8_STAGE(PG8_SA(0, 0), cA, voffA); PG8_STAGE(PG8_SA(0, 1), cA + hstep, voffA);
        if (wr == 1) PG8_BAR;
        PG8_WAIT_V(2); PG8_BAR;
        PG8_STAGE(PG8_SB(1, 0), cB + kstep, voffB); PG8_STAGE(PG8_SA(1, 0), cA + kstep, voffA); PG8_STAGE(PG8_SB(1, 1), cB + hstep + kstep, voffB);
        PG8_WAIT_V(6); PG8_BAR;
    } else {
        PG8_STAGE(PG8_SB(0, 0), cB, voffB); PG8_STAGE(PG8_SA(0, 0), cA, voffA); PG8_STAGE(PG8_SB(0, 1), cB + hstep, voffB); PG8_STAGE(PG8_SA(0, 1), cA + hstep, voffA);
        if (wr == 1) PG8_BAR;
        PG8_WAIT_V(4); PG8_BAR;
        PG8_STAGE(PG8_SB(1, 0), cB + kstep, voffB); PG8_STAGE(PG8_SA(1, 0), cA + kstep, voffA); PG8_STAGE(PG8_SB(1, 1), cB + hstep + kstep, voffB);
        PG8_WAIT_V(6); PG8_BAR;
    }
    for (;;) {
        const bool has_next = S.next(ui + 1, nxt);
        const char* nA = has_next ? (const char*)g.A + (size_t)nxt.pm * tstep : cA; const char* nB = has_next ? (const char*)g.Bt + (size_t)nxt.pn * tstep : cB;
        for (int t = 0; t < nt; t += 2) {
            const bool last = (t == nt - 2);
            const char* a1 = cA + (size_t)(t + 1) * kstep;
            const char* a2 = last ? nA : cA + (size_t)(t + 2) * kstep; const char* b2 = last ? nB : cB + (size_t)(t + 2) * kstep;
            const char* a3 = a2 + kstep; const char* b3 = b2 + kstep;
            if (last && has_next) S.a_ready(nxt);
            if constexpr (SP2) {
            PG8_LDB(B0, 0, 0); PG8_LDB(B1, 0, 1); PG8_SCHED; PG8_LDA(At, 0, 0); PG8_STAGE(PG8_SA(1, 1), a1 + hstep, voffA);
            PG8_WAIT_V(8); PG8_WAIT_L(0); PG8_BAR; PG8_MMA(0, 0, At, B0); PG8_MMA(0, 1, At, B1); PG8_BAR; PG8_SCHED;
            PG8_LDA(At, 0, 1); PG8_STAGE(PG8_SB(0, 0), b2, voffB); PG8_STAGE(PG8_SB(0, 1), b2 + hstep, voffB); PG8_STAGE(PG8_SA(0, 0), a2, voffA);
            PG8_WAIT_V(8); PG8_WAIT_L(0); PG8_BAR; PG8_MMA(1, 0, At, B0); PG8_MMA(1, 1, At, B1); PG8_BAR; PG8_SCHED;
            PG8_LDB(B0, 1, 0); PG8_LDB(B1, 1, 1); PG8_SCHED; PG8_LDA(At, 1, 0); PG8_STAGE(PG8_SA(0, 1), a2 + hstep, voffA);
            PG8_WAIT_V(8); PG8_WAIT_L(0); PG8_BAR; PG8_MMA(0, 0, At, B0); PG8_MMA(0, 1, At, B1); PG8_BAR; PG8_SCHED;
            PG8_LDA(At, 1, 1); PG8_STAGE(PG8_SB(1, 0), b3, voffB); PG8_STAGE(PG8_SB(1, 1), b3 + hstep, voffB); PG8_STAGE(PG8_SA(1, 0), a3, voffA);
            PG8_WAIT_V(8); PG8_WAIT_L(0); PG8_BAR; PG8_MMA(1, 0, At, B0); PG8_MMA(1, 1, At, B1); PG8_BAR; PG8_SCHED;
            } else {
            PG8_LDB(B0, 0, 0); PG8_SCHED; PG8_LDA(At, 0, 0); PG8_STAGE(PG8_SA(1, 1), a1 + hstep, voffA);
            PG8_WAIT_L(8); PG8_BAR; PG8_WAIT_L(0); PG8_MMA(0, 0, At, B0); PG8_BAR; PG8_SCHED;
            PG8_LDB(B1, 0, 1); PG8_STAGE(PG8_SB(0, 0), b2, voffB);
            PG8_BAR; PG8_WAIT_L(0); PG8_MMA(0, 1, At, B1); PG8_BAR;
            PG8_LDA(At, 0, 1); PG8_STAGE(PG8_SA(0, 0), a2, voffA);
            PG8_BAR; PG8_WAIT_L(0); PG8_MMA(1, 0, At, B0); PG8_BAR; PG8_SCHED;
            PG8_STAGE(PG8_SB(0, 1), b2 + hstep, voffB);
            PG8_WAIT_V(6); PG8_BAR; PG8_MMA(1, 1, At, B1); PG8_BAR;
            PG8_LDB(B0, 1, 0); PG8_SCHED; PG8_LDA(At, 1, 0); PG8_STAGE(PG8_SA(0, 1), a2 + hstep, voffA);
            PG8_WAIT_L(8); PG8_BAR; PG8_WAIT_L(0); PG8_MMA(0, 0, At, B0); PG8_BAR; PG8_SCHED;
            PG8_LDB(B1, 1, 1); PG8_STAGE(PG8_SB(1, 0), b3, voffB);
            PG8_BAR; PG8_WAIT_L(0); PG8_MMA(0, 1, At, B1); PG8_BAR;
            PG8_LDA(At, 1, 1); PG8_STAGE(PG8_SA(1, 0), a3, voffA);
            PG8_BAR; PG8_WAIT_L(0); PG8_MMA(1, 0, At, B0); PG8_BAR; PG8_SCHED;
            PG8_STAGE(PG8_SB(1, 1), b3 + hstep, voffB);
            PG8_WAIT_V(6); PG8_BAR; PG8_MMA(1, 1, At, B1); PG8_BAR;
            }
        }
        if constexpr (ALIGN_EPI) { if (wr == 0) PG8_BAR; }
        if constexpr (F8) asm volatile("s_nop 15\n\ts_nop 15" ::: "memory");
        if constexpr (!Epi::AFTER_DRAIN) { E(acc, cur, wr, wc, fr, fq); S.done(cur); }
        if (!has_next) break;
#pragma unroll
        for (int a = 0; a < 2; ++a)
#pragma unroll
            for (int b = 0; b < 2; ++b)
#pragma unroll
                for (int m = 0; m < 4; ++m)
#pragma unroll
                    for (int n = 0; n < 2; ++n) acc[a][b][m][n] = (f32x4){0.f, 0.f, 0.f, 0.f};
        cur = nxt; cA = nA; cB = nB; ++ui;
        if constexpr (ALIGN_EPI) { if (wr == 1) PG8_BAR; }
    }
    PG8_WAIT_V(0);
    if constexpr (!ALIGN_EPI) { if (wr == 0) PG8_BAR; }
    PG8_BAR;
    if constexpr (Epi::AFTER_DRAIN) { E.fused(acc, cur, wr, wc, fr, fq, lds, wid, lane); S.done(cur); }
#undef PG8_SA
#undef PG8_SB
#undef PG8_STAGE
#undef PG8_LDA
#undef PG8_LDB
#undef PG8_MMA
#undef PG8_CAT
#undef PG8_WAIT_V
#undef PG8_WAIT_L
#undef PG8_BAR
#undef PG8_SCHED
}
}

constexpr int NWAVES = 8;
constexpr int S = 8192, DM = 4096, FF = 16384, DEPTH = 2;
constexpr int NSRC = 11344, NPROJ = 11520;
constexpr int OFF_Q = 0, OFF_KC = 2048, OFF_VC = 2560, OFF_KS = 3072, OFF_VS = 3584, OFF_KW = 4096, OFF_VW = 4608, OFF_XBC = 5120, OFF_Z = 9216, OFF_G = 11264, OFF_DT = 11312;
constexpr int NH = 16, NKV = 4, HD = 128, NCMP = 511, NSEL = 128, SELTOP = 16, WIN = 512;
constexpr int SSM_W = 2048, SSM_H = 32, SSM_P = 64, SSM_G = 8, SSM_N = 128, CONVD = 4096, CHUNK = 256, NCHUNK = S / CHUNK;
constexpr float EPS = 1e-5f;
constexpr float QSCALE = 0.08838834764831845f * 1.4426950408889634f;

constexpr size_t MiB = 1u << 20;
constexpr size_t WS_CTL = 0, CTL_ZERO_BYTES = 1 * MiB;
constexpr size_t SZ_WIN = (size_t)NPROJ * DM * 2, SZ_WO = (size_t)DM * DM * 2, SZ_WUP = (size_t)FF * DM * 2, SZ_WDN = (size_t)DM * FF * 2;
constexpr size_t WS_WIN = 2 * MiB;
constexpr size_t WS_WO = WS_WIN + DEPTH * SZ_WIN;
constexpr size_t WS_WUP = WS_WO + DEPTH * SZ_WO;
constexpr size_t WS_WDN = WS_WUP + DEPTH * SZ_WUP;
constexpr size_t WS_H = WS_WDN + DEPTH * SZ_WDN;
constexpr size_t WS_XN = WS_H + (size_t)S * DM * 4;
constexpr size_t WS_PROJ = WS_XN + (size_t)S * DM * 2;
constexpr size_t WS_ACT = WS_PROJ + (size_t)S * NPROJ * 2;
constexpr size_t WS_CAT = WS_ACT + (size_t)S * FF * 2;
constexpr size_t WS_ATT = WS_CAT + (size_t)S * DM * 2;
constexpr size_t WS_XBC = WS_ATT + (size_t)S * 2048 * 4;
constexpr size_t WS_Y = WS_XBC + (size_t)S * CONVD * 2;
constexpr size_t WS_ST = WS_Y + (size_t)S * 2048 * 4;
constexpr size_t WS_PREV = WS_ST + (size_t)NCHUNK * SSM_H * SSM_P * SSM_N * 4;
constexpr size_t WS_KC = WS_PREV + (size_t)NCHUNK * SSM_H * SSM_P * SSM_N * 4;
constexpr size_t WS_VC = WS_KC + (size_t)NKV * 512 * HD * 2;
constexpr size_t WS_DT = WS_VC + (size_t)NKV * 512 * HD * 2;
constexpr size_t WS_ADT = WS_DT + (size_t)S * 32 * 4;
constexpr size_t WS_COS = WS_ADT + (size_t)S * 32 * 4;
constexpr size_t WS_SIN = WS_COS + (size_t)S * 64 * 4;
constexpr size_t WS_BMP = WS_SIN + (size_t)S * 64 * 4;
constexpr size_t WS_ACSG = WS_BMP + (size_t)S * 16 * 4;
constexpr size_t WS_DEC = WS_ACSG + (size_t)S * 32 * 4;
constexpr size_t WS_W1T = WS_DEC + 4096;
constexpr size_t WS_W2T = WS_W1T + (size_t)DEPTH * 2 * 128 * 4096 * 2;
constexpr size_t WS_B1P = WS_W2T + (size_t)DEPTH * 2 * 128 * 128 * 2;
constexpr size_t WS_END = WS_B1P + (size_t)DEPTH * 2 * 16 * 128 * 4;
constexpr int CW_BAR = 4096, CW_P1 = 8192;
constexpr int P1_SPLIT = 10240;

constexpr int RING_OFF = 0, RING_BYTES = 131072;
constexpr int LDSCTL_OFF = 143360, MISC_OFF = LDSCTL_OFF + 320;
constexpr int LDS_BYTES = 147456;

#define GAS __attribute__((address_space(1)))
#define LAS __attribute__((address_space(3)))
typedef unsigned short bf16;
typedef unsigned v4u __attribute__((ext_vector_type(4)));
typedef float f32x4 __attribute__((ext_vector_type(4)));
typedef short bf16x8 __attribute__((ext_vector_type(8)));
typedef GAS unsigned gu32;
typedef GAS unsigned long long gu64;
#define RLX_AGENT __ATOMIC_RELAXED, __HIP_MEMORY_SCOPE_AGENT
#define LDS_WAIT() asm volatile("s_waitcnt lgkmcnt(0)" ::: "memory")
#define VM_WAIT() asm volatile("s_waitcnt vmcnt(0)" ::: "memory")
__device__ __forceinline__ unsigned long long rt() { return __builtin_amdgcn_s_memrealtime(); }
__device__ __forceinline__ unsigned f2bf(float f) { unsigned u = __builtin_bit_cast(unsigned, f); return (u + 0x7fffu + ((u >> 16) & 1u)) >> 16; }
__device__ __forceinline__ unsigned pk2(float lo, float hi) { return f2bf(lo) | (f2bf(hi) << 16); }

#define XB_TMO      128
#define XB_XCNT(j)  (256  + 64 * (j))
#define XB_XSUB(j)  (1280 + 64 * (j))
#define XB_XGEN(j)  (2304 + 64 * (j))
#define XB_TOP      3328
#define XB_TOPGEN   3392
#define XCD_BAR_WORDS 3456
#define XB_SPIN_CAP (1u << 18)

__device__ __forceinline__ unsigned xb_ld(unsigned* p)              { return __hip_atomic_load(p, __ATOMIC_RELAXED, __HIP_MEMORY_SCOPE_AGENT); }
__device__ __forceinline__ unsigned xb_add(unsigned* p, unsigned v) { return __hip_atomic_fetch_add(p, v, __ATOMIC_RELAXED, __HIP_MEMORY_SCOPE_AGENT); }
__device__ __forceinline__ unsigned xb_xcc_id() { return (unsigned)__builtin_amdgcn_s_getreg((3 << 11) | 20) & 0xFu; }
#define XB_SPIN(cond, bar) do { unsigned _sp = 0; while (cond) { __builtin_amdgcn_s_sleep(1); \
    if ((++_sp & 255u) == 0u) { if (xb_ld(&(bar)[XB_TMO])) break; if (_sp > XB_SPIN_CAP) { atomicAdd(&(bar)[XB_TMO], 1u); break; } } } } while (0)

__device__ __forceinline__ int bx_l() { int b = (int)blockIdx.x; asm volatile("" : "+s"(b)); return b; }
struct XcdBarrier {
    unsigned* bar; unsigned x;
    volatile LAS unsigned* st;
};

__device__ __forceinline__ XcdBarrier xcd_barrier_post(unsigned* bar, volatile LAS unsigned* st) {
    XcdBarrier b; b.bar = bar; b.x = xb_xcc_id(); b.st = st;
    if (threadIdx.x == 0) (void)xb_add(&bar[XB_XCNT(b.x)], 1u);
    return b;
}
__device__ __forceinline__ void xcd_barrier_complete(unsigned* bar, unsigned x, unsigned& nloc, unsigned& nx) {
    const unsigned G = gridDim.x * gridDim.y * gridDim.z;
    unsigned sum, cnt, mine, sp = 0u;
    for (;;) {
        sum = 0u; cnt = 0u; mine = 0u;
#pragma unroll
        for (unsigned j = 0; j < 16; ++j) { const unsigned c = xb_ld(&bar[XB_XCNT(j)]); sum += c; cnt += (c > 0u) ? 1u : 0u; mine = (j == x) ? c : mine; }
        if (sum == G) break;
        __builtin_amdgcn_s_sleep(1);
        if ((++sp & 255u) == 0u) { if (xb_ld(&bar[XB_TMO])) break; if (sp > XB_SPIN_CAP) { atomicAdd(&bar[XB_TMO], 1u); break; } }
    }
    nloc = mine > 0u ? mine : 1u; nx = cnt > 0u ? cnt : 1u;
}

__device__ __forceinline__ void xcd_barrier(const XcdBarrier& b) {
    asm volatile("s_waitcnt vmcnt(0)" ::: "memory");
    __syncthreads();
    if (threadIdx.x == 0) {
        unsigned* bar = b.bar;
        __builtin_amdgcn_s_waitcnt(0);
        unsigned nloc = b.st[0], nx = b.st[1];
        if (nloc == 0u) { xcd_barrier_complete(bar, b.x, nloc, nx); b.st[0] = nloc; b.st[1] = nx; }
        const unsigned old = xb_add(&bar[XB_XSUB(b.x)], 1u);
        const unsigned gen = old / nloc;
        if (old + 1u == (gen + 1u) * nloc) {
            __builtin_amdgcn_fence(__ATOMIC_RELEASE, "agent");
            asm volatile("s_waitcnt vmcnt(0)" ::: "memory");
            const unsigned og = xb_add(&bar[XB_TOP], 1u);
            const unsigned tg = og / nx;
            if (og + 1u == (tg + 1u) * nx) xb_add(&bar[XB_TOPGEN], 1u);
            else XB_SPIN(xb_ld(&bar[XB_TOPGEN]) == tg, bar);
            __builtin_amdgcn_fence(__ATOMIC_ACQUIRE, "agent");
            xb_add(&bar[XB_XGEN(b.x)], 1u);
            asm volatile("s_waitcnt vmcnt(0)" ::: "memory");
        } else {
            XB_SPIN(xb_ld(&bar[XB_XGEN(b.x)]) == gen, bar);
            __builtin_amdgcn_fence(__ATOMIC_ACQUIRE, "agent");
            asm volatile("s_waitcnt vmcnt(0)" ::: "memory");
        }
    }
    __syncthreads();
}


__device__ __forceinline__ float bf2f(unsigned short b) { return __builtin_bit_cast(float, (unsigned)b << 16); }
__device__ __forceinline__ float bflo(unsigned w) { return __builtin_bit_cast(float, w << 16); }
__device__ __forceinline__ float bfhi(unsigned w) { return __builtin_bit_cast(float, w & 0xffff0000u); }
__device__ __forceinline__ float wave_sum(float v) {
#pragma unroll
    for (int o = 1; o < 64; o <<= 1) v += __shfl_xor(v, o);
    return v;
}
__device__ __forceinline__ float wave_max(float v) {
#pragma unroll
    for (int o = 1; o < 64; o <<= 1) v = fmaxf(v, __shfl_xor(v, o));
    return v;
}

struct Frame {
    LAS unsigned char* lds;
    volatile LAS unsigned* MISC;
    gu32* ctl;
    int tid, lane, wave;
    int vcu, G;
};

__device__ __forceinline__ int src_col_in(int c) {
    if (c < 5120) { const int blk = c >> 7, p = c & 127; const bool rope = blk < 16 || ((((blk - 16) >> 2) & 1) == 0); const int d = rope ? (p >> 1) + 64 * (p & 1) : p; return blk * 128 + d; }
    if (c < OFF_Z) return c + 2096;
    if (c < OFF_G) return c - 4048;
    if (c < OFF_DT) return 5120 + (c - OFF_G);
    if (c < NSRC) return c;
    return -1;
}
__device__ __forceinline__ int nat_dim(int p) { return (p >> 1) + 64 * (p & 1); }
template <int MAP, bool KS, bool KPERM = false>
__device__ __forceinline__ void p0_transpose_item(const float* W, int K, int Nsrc, int nblk, bf16* WT, const float* ksA, const float* ksB, int ksplit, LAS float* scr, int item, int lane) {
    const int kb = item / nblk, nb = item % nblk, k0 = 64 * kb, n0 = 32 * nb;
    const int nr = n0 + (lane & 31); const int sc = MAP == 1 ? src_col_in(nr) : (MAP == 2 ? nat_dim(nr) : nr);
    float v[32];
#pragma unroll
    for (int i = 0; i < 32; ++i) { const int k = k0 + 2 * i + (lane >> 5); const int ksrc = KPERM ? ((k & ~127) + nat_dim(k & 127)) : k;
        v[i] = sc >= 0 ? W[(size_t)ksrc * Nsrc + sc] : 0.f; }
#pragma unroll
    for (int i = 0; i < 32; ++i) { const int kk = 2 * i + (lane >> 5); const int k = k0 + kk;
        if (KS) v[i] *= (k < ksplit ? ksA[k] : ksB[k - ksplit]);
        scr[kk * 33 + (lane & 31)] = v[i]; }
    LDS_WAIT(); asm volatile("" ::: "memory");
    const int c = lane & 7;
#pragma unroll
    for (int j = 0; j < 4; ++j) { const int n = (lane >> 3) + 8 * j; const LAS float* s = scr + (8 * c) * 33 + n;
        v4u o; o.x = pk2(s[0 * 33], s[1 * 33]); o.y = pk2(s[2 * 33], s[3 * 33]); o.z = pk2(s[4 * 33], s[5 * 33]); o.w = pk2(s[6 * 33], s[7 * 33]);
        *(GAS v4u*)(WT + (size_t)(n0 + n) * K + k0 + 8 * c) = o; }
    LDS_WAIT(); asm volatile("" ::: "memory");
}

template <bool KS, int MAP = 0>
__device__ __forceinline__ void p0_transpose_item_f8(const float* W, int K, int Nsrc, int nblk, unsigned char* WT, float wscale, const float* ksA, const float* ksB, int ksplit, LAS float* scr, int item, int lane) {
    const int pr = item >> 1, kb = 2 * (pr / nblk) + (item & 1), nb = pr % nblk, k0 = 64 * kb, n0 = 32 * nb;
    const int nr = n0 + (lane & 31); const int sc = MAP == 1 ? src_col_in(nr) : nr;
    float v[32];
#pragma unroll
    for (int i = 0; i < 32; ++i) v[i] = sc >= 0 ? W[(size_t)(k0 + 2 * i + (lane >> 5)) * Nsrc + sc] : 0.f;
#pragma unroll
    for (int i = 0; i < 32; ++i) { const int k = k0 + 2 * i + (lane >> 5); float x = v[i] * wscale; if (KS) x *= (k < ksplit ? ksA[k] : ksB[k - ksplit]); scr[(2 * i + (lane >> 5)) * 33 + (lane & 31)] = x; }
    LDS_WAIT(); asm volatile("" ::: "memory");
    const int c = lane & 7;
#pragma unroll
    for (int j = 0; j < 4; ++j) { const int n = (lane >> 3) + 8 * j; const LAS float* s = scr + (8 * c) * 33 + n;
        const unsigned long long o = (unsigned long long)pg8::pk4_fp8(s[0 * 33], s[1 * 33], s[2 * 33], s[3 * 33]) | ((unsigned long long)pg8::pk4_fp8(s[4 * 33], s[5 * 33], s[6 * 33], s[7 * 33]) << 32);
        *(GAS unsigned long long*)(WT + (size_t)(n0 + n) * K + k0 + 8 * c) = o; }
    LDS_WAIT(); asm volatile("" ::: "memory");
}
__device__ __forceinline__ void rms_row_to_bf16(const float* xrow, bf16* orow, int lane) {
    const GAS f32x4* xr = (const GAS f32x4*)xrow + lane;
    f32x4 v[16]; float s = 0.f;
#pragma unroll
    for (int j = 0; j < 16; ++j) { v[j] = xr[64 * j]; s += (v[j].x * v[j].x + v[j].y * v[j].y) + (v[j].z * v[j].z + v[j].w * v[j].w); }
    const float rstd = 1.f / sqrtf(wave_sum(s) * (1.f / DM) + EPS);
    GAS unsigned long long* o8 = (GAS unsigned long long*)orow + lane;
#pragma unroll
    for (int j = 0; j < 16; ++j) o8[64 * j] = (unsigned long long)pk2(v[j].x * rstd, v[j].y * rstd) | ((unsigned long long)pk2(v[j].z * rstd, v[j].w * rstd) << 32);
}
constexpr float XN8_SCALE = 4.f, WUP8_SCALE = 64.f;
__device__ __forceinline__ void rms_rowh_to_fp8(const bf16* xrow, unsigned char* orow, int lane) {
    const GAS v4u* xr = (const GAS v4u*)xrow + lane;
    v4u v[8]; float s = 0.f;
#pragma unroll
    for (int j = 0; j < 8; ++j) { v[j] = xr[64 * j]; const float a0 = bflo(v[j].x), a1 = bfhi(v[j].x), a2 = bflo(v[j].y), a3 = bfhi(v[j].y), a4 = bflo(v[j].z), a5 = bfhi(v[j].z), a6 = bflo(v[j].w), a7 = bfhi(v[j].w);
        s += ((a0 * a0 + a1 * a1) + (a2 * a2 + a3 * a3)) + ((a4 * a4 + a5 * a5) + (a6 * a6 + a7 * a7)); }
    const float rstd = XN8_SCALE / sqrtf(wave_sum(s) * (1.f / DM) + EPS);
    GAS unsigned long long* o8 = (GAS unsigned long long*)orow + lane;
#pragma unroll
    for (int j = 0; j < 8; ++j) o8[64 * j] = (unsigned long long)pg8::pk4_fp8(bflo(v[j].x) * rstd, bfhi(v[j].x) * rstd, bflo(v[j].y) * rstd, bfhi(v[j].y) * rstd) | ((unsigned long long)pg8::pk4_fp8(bflo(v[j].z) * rstd, bfhi(v[j].z) * rstd, bflo(v[j].w) * rstd, bfhi(v[j].w) * rstd) << 32);
}
__device__ __forceinline__ void rms2f_to_bf16(const float* X, bf16* O, int m0, int mstep, int lane) {
    f32x4 v[2][16];
#pragma unroll
    for (int i = 0; i < 2; ++i) { const GAS f32x4* xr = (const GAS f32x4*)(X + (size_t)(m0 + i * mstep) * DM) + lane;
#pragma unroll
        for (int j = 0; j < 16; ++j) v[i][j] = xr[64 * j]; }
    asm volatile("" ::: "memory");
#pragma unroll
    for (int i = 0; i < 2; ++i) { float s = 0.f;
#pragma unroll
        for (int j = 0; j < 16; ++j) s += (v[i][j].x * v[i][j].x + v[i][j].y * v[i][j].y) + (v[i][j].z * v[i][j].z + v[i][j].w * v[i][j].w);
        const float rstd = 1.f / sqrtf(wave_sum(s) * (1.f / DM) + EPS);
        GAS unsigned long long* o8 = (GAS unsigned long long*)(O + (size_t)(m0 + i * mstep) * DM) + lane;
#pragma unroll
        for (int j = 0; j < 16; ++j) o8[64 * j] = (unsigned long long)pk2(v[i][j].x * rstd, v[i][j].y * rstd) | ((unsigned long long)pk2(v[i][j].z * rstd, v[i][j].w * rstd) << 32); }
}
__device__ __forceinline__ void final2h(const bf16* H, float* out, const float* nf, int m0, int mstep, int lane) {
    v4u v[2][8]; f32x4 g[16]; const GAS f32x4* w4 = (const GAS f32x4*)nf + 2 * lane;
#pragma unroll
    for (int i = 0; i < 2; ++i) { const GAS v4u* xr = (const GAS v4u*)(H + (size_t)(m0 + i * mstep) * DM) + lane;
#pragma unroll
        for (int j = 0; j < 8; ++j) v[i][j] = xr[64 * j]; }
#pragma unroll
    for (int j = 0; j < 8; ++j) { g[2 * j] = w4[128 * j]; g[2 * j + 1] = w4[128 * j + 1]; }
    asm volatile("" ::: "memory");
#pragma unroll
    for (int i = 0; i < 2; ++i) { float s = 0.f;
#pragma unroll
        for (int j = 0; j < 8; ++j) { const float a0 = bflo(v[i][j].x), a1 = bfhi(v[i][j].x), a2 = bflo(v[i][j].y), a3 = bfhi(v[i][j].y), a4 = bflo(v[i][j].z), a5 = bfhi(v[i][j].z), a6 = bflo(v[i][j].w), a7 = bfhi(v[i][j].w);
            s += ((a0 * a0 + a1 * a1) + (a2 * a2 + a3 * a3)) + ((a4 * a4 + a5 * a5) + (a6 * a6 + a7 * a7)); }
        const float rstd = 1.f / sqrtf(wave_sum(s) * (1.f / DM) + EPS);
        GAS f32x4* o4 = (GAS f32x4*)(out + (size_t)(m0 + i * mstep) * DM) + 2 * lane;
#pragma unroll
        for (int j = 0; j < 8; ++j) { o4[128 * j] = (f32x4){bflo(v[i][j].x), bfhi(v[i][j].x), bflo(v[i][j].y), bfhi(v[i][j].y)} * rstd * g[2 * j]; o4[128 * j + 1] = (f32x4){bflo(v[i][j].z), bfhi(v[i][j].z), bflo(v[i][j].w), bfhi(v[i][j].w)} * rstd * g[2 * j + 1]; } }
}
__device__ __forceinline__ void rms4h_to_fp8(const bf16* H, unsigned char* X, int m0, int mstep, int lane) {
    v4u v[4][8];
#pragma unroll
    for (int i = 0; i < 4; ++i) { const GAS v4u* xr = (const GAS v4u*)(H + (size_t)(m0 + i * mstep) * DM) + lane;
#pragma unroll
        for (int j = 0; j < 8; ++j) v[i][j] = xr[64 * j]; }
    asm volatile("" ::: "memory");
#pragma unroll
    for (int i = 0; i < 4; ++i) { float s = 0.f;
#pragma unroll
        for (int j = 0; j < 8; ++j) { const float a0 = bflo(v[i][j].x), a1 = bfhi(v[i][j].x), a2 = bflo(v[i][j].y), a3 = bfhi(v[i][j].y), a4 = bflo(v[i][j].z), a5 = bfhi(v[i][j].z), a6 = bflo(v[i][j].w), a7 = bfhi(v[i][j].w);
            s += ((a0 * a0 + a1 * a1) + (a2 * a2 + a3 * a3)) + ((a4 * a4 + a5 * a5) + (a6 * a6 + a7 * a7)); }
        const float rstd = XN8_SCALE / sqrtf(wave_sum(s) * (1.f / DM) + EPS);
        GAS unsigned long long* o8 = (GAS unsigned long long*)(X + (size_t)(m0 + i * mstep) * DM) + lane;
#pragma unroll
        for (int j = 0; j < 8; ++j) o8[64 * j] = (unsigned long long)pg8::pk4_fp8(bflo(v[i][j].x) * rstd, bfhi(v[i][j].x) * rstd, bflo(v[i][j].y) * rstd, bfhi(v[i][j].y) * rstd) | ((unsigned long long)pg8::pk4_fp8(bflo(v[i][j].z) * rstd, bfhi(v[i][j].z) * rstd, bflo(v[i][j].w) * rstd, bfhi(v[i][j].w) * rstd) << 32); }
}
constexpr int PROJ_F8_FROM = 1;
constexpr int WO_F8_FROM = 1;
__device__ __forceinline__ void rms_row_to_fp8(const float* xrow, unsigned char* orow, int lane) {
    const GAS f32x4* xr = (const GAS f32x4*)xrow + lane;
    f32x4 v[16]; float s = 0.f;
#pragma unroll
    for (int j = 0; j < 16; ++j) { v[j] = xr[64 * j]; s += (v[j].x * v[j].x + v[j].y * v[j].y) + (v[j].z * v[j].z + v[j].w * v[j].w); }
    const float rstd = XN8_SCALE / sqrtf(wave_sum(s) * (1.f / DM) + EPS);
    GAS unsigned* o4 = (GAS unsigned*)orow + lane;
#pragma unroll
    for (int j = 0; j < 16; ++j) o4[64 * j] = pg8::pk4_fp8(v[j].x * rstd, v[j].y * rstd, v[j].z * rstd, v[j].w * rstd);
}

typedef float f32x16 __attribute__((ext_vector_type(16)));
typedef short s16x4 __attribute__((ext_vector_type(4)));
__device__ __forceinline__ int crow(int r, int hi) { return (r & 3) + 8 * (r >> 2) + 4 * hi; }
__device__ __forceinline__ unsigned cvtpk(float lo, float hi) { unsigned r; asm volatile("v_cvt_pk_bf16_f32 %0, %1, %2" : "=v"(r) : "v"(lo), "v"(hi)); return r; }
__device__ __forceinline__ void stage4_tr(LAS bf16* dst  , int ld, v4u w0, v4u w1, v4u w2, v4u w3, float d0, float d1, float d2, float d3) {
    const unsigned a0[4] = {w0.x, w0.y, w0.z, w0.w}, a1[4] = {w1.x, w1.y, w1.z, w1.w}, a2[4] = {w2.x, w2.y, w2.z, w2.w}, a3[4] = {w3.x, w3.y, w3.z, w3.w};
#pragma unroll
    for (int jj = 0; jj < 4; ++jj) {
        const unsigned long long lo = (unsigned long long)cvtpk(bflo(a0[jj]) * d0, bflo(a1[jj]) * d1) | ((unsigned long long)cvtpk(bflo(a2[jj]) * d2, bflo(a3[jj]) * d3) << 32);
        const unsigned long long hi = (unsigned long long)cvtpk(bfhi(a0[jj]) * d0, bfhi(a1[jj]) * d1) | ((unsigned long long)cvtpk(bfhi(a2[jj]) * d2, bfhi(a3[jj]) * d3) << 32);
        *(LAS unsigned long long*)(dst + (2 * jj) * ld) = lo; *(LAS unsigned long long*)(dst + (2 * jj + 1) * ld) = hi; }
}
constexpr int SSD_LD = 264;
constexpr int SSD_XT2 = 0, SSD_BN = 2 * 64 * SSD_LD * 2, SSD_ACS = SSD_BN + 256 * 256, SSD_DTL = SSD_ACS + 4096, SSD_LDS_END = SSD_DTL + 4096;
constexpr int SSD_BT = 0, SSD_XT = 128 * SSD_LD * 2;
static_assert(SSD_LDS_END <= LDSCTL_OFF && SSD_XT + 64 * SSD_LD * 2 <= SSD_ACS, "ssd lds");
__device__ __forceinline__ void ssd1_unit(LAS unsigned char* lds, int c, int g, const bf16* XBC, const bf16* PROJ, const float* dtb, const float* alog, bf16* Y, float* ST, float* DEC, float* ACSG, int tid_in) {
    int tid = tid_in; asm volatile("" : "+v"(tid));
    const int lane = tid & 63, wave = __builtin_amdgcn_readfirstlane(tid >> 6), l32 = lane & 31, hi = lane >> 5;
    LAS bf16* XT2 = (LAS bf16*)(lds + SSD_XT2); LAS unsigned char* BN = lds + SSD_BN; LAS float* acs = (LAS float*)(lds + SSD_ACS); LAS float* dtl = (LAS float*)(lds + SSD_DTL);
    const int t0 = c * CHUNK;
    __syncthreads();
    if (wave < 4) { const int h = 4 * g + wave; float a[4], run = 0.f; const float nA = -expf(alog[h]), db = dtb[h];
#pragma unroll
        for (int i = 0; i < 4; ++i) { const float xr = bf2f(PROJ[(size_t)(t0 + 4 * lane + i) * NPROJ + OFF_DT + h]) + db; const float sp = xr > 20.f ? xr : log1pf(expf(xr));
            a[i] = sp * nA; run += a[i]; a[i] = run; dtl[wave * 256 + 4 * lane + i] = sp; }
        float inc = run;
#pragma unroll
        for (int d = 1; d < 64; d <<= 1) { const float v = __shfl_up(inc, d); if (lane >= d) inc += v; }
        const float excl = inc - run;
#pragma unroll
        for (int i = 0; i < 4; ++i) { const float v = a[i] + excl; acs[wave * 256 + 4 * lane + i] = v; ACSG[(size_t)(t0 + 4 * lane + i) * 32 + h] = v; }
        if (lane == 63) DEC[c * 32 + h] = expf(inc);
    }
#pragma unroll
    for (int i = 0; i < 8; ++i) { const int idx = tid + 512 * i, s = idx >> 4, ch = idx & 15;
        const v4u w = *(const GAS v4u*)(XBC + (size_t)(t0 + s) * CONVD + 2048 + g * 128 + 8 * ch);
        *(LAS v4u*)(BN + s * 256 + ((ch ^ (s & 7)) << 4)) = w; }
    __syncthreads();
#pragma unroll 1
    for (int rd = 0; rd < 2; ++rd) {
        { const int s0 = 4 * lane;
#pragma unroll
          for (int cq = 0; cq < 2; ++cq) { const int cb = 8 * (2 * wave + cq), hq = cb >> 6, pb = cb & 63;
            const bf16* xp = XBC + (size_t)(t0 + s0) * CONVD + (4 * g + 2 * rd) * 64 + cb;
            const v4u w0 = *(const GAS v4u*)xp, w1 = *(const GAS v4u*)(xp + CONVD), w2 = *(const GAS v4u*)(xp + 2 * CONVD), w3 = *(const GAS v4u*)(xp + 3 * CONVD);
            const f32x4 dv = *(const LAS f32x4*)(dtl + (2 * rd + hq) * 256 + s0);
            stage4_tr(XT2 + (hq * 64 + pb) * SSD_LD + s0, SSD_LD, w0, w1, w2, w3, dv[0], dv[1], dv[2], dv[3]); } }
        __syncthreads();
        { const int hq = wave >> 2, hh = 2 * rd + hq, h = 4 * g + hh;
#pragma unroll 1
          for (int task = 0; task < 2; ++task) {
            const int lt = task ? 7 - (wave & 3) : (wave & 3); const int lloc = 32 * lt + l32, lrow = t0 + lloc;
            bf16x8 cf[8];
#pragma unroll
            for (int kk = 0; kk < 8; ++kk) cf[kk] = *(const GAS bf16x8*)(XBC + (size_t)lrow * CONVD + 3072 + g * 128 + 16 * kk + 8 * hi);
            const float acl = acs[hh * 256 + lloc];
            f32x16 ya0 = {}, ya1 = {};
            for (int j = 0; j <= lt; ++j) {
                f32x16 gt = {};
                { const int s = 32 * j + l32; const LAS unsigned char* brow = BN + s * 256; const int sw = s & 7;
#pragma unroll
                  for (int kk = 0; kk < 8; ++kk) { const bf16x8 a = *(const LAS bf16x8*)(brow + (((2 * kk + hi) ^ sw) << 4)); gt = __builtin_amdgcn_mfma_f32_32x32x16_bf16(a, cf[kk], gt, 0, 0, 0); } }
                float e[16];
#pragma unroll
                for (int q = 0; q < 4; ++q) { const f32x4 av = *(const LAS f32x4*)(acs + hh * 256 + 32 * j + 8 * q + 4 * hi);
#pragma unroll
                    for (int i = 0; i < 4; ++i) { const int r = 4 * q + i, s = 32 * j + crow(r, hi); const float ev = __expf(fminf(acl - av[i], 0.f)); e[r] = (s <= lloc) ? gt[r] * ev : 0.f; } }
                v4u w0 = {cvtpk(e[0], e[1]), cvtpk(e[2], e[3]), cvtpk(e[4], e[5]), cvtpk(e[6], e[7])}, w1 = {cvtpk(e[8], e[9]), cvtpk(e[10], e[11]), cvtpk(e[12], e[13]), cvtpk(e[14], e[15])};
                const bf16x8 pk0 = __builtin_bit_cast(bf16x8, w0), pk1 = __builtin_bit_cast(bf16x8, w1);
#pragma unroll
                for (int pt = 0; pt < 2; ++pt) {
                    const LAS bf16* xr = XT2 + (hq * 64 + 32 * pt + l32) * SSD_LD + 32 * j + 4 * hi;
                    const s16x4 a0 = *(const LAS s16x4*)(xr), a1 = *(const LAS s16x4*)(xr + 8), a2 = *(const LAS s16x4*)(xr + 16), a3 = *(const LAS s16x4*)(xr + 24);
                    const bf16x8 af0 = {a0[0], a0[1], a0[2], a0[3], a1[0], a1[1], a1[2], a1[3]}, af1 = {a2[0], a2[1], a2[2], a2[3], a3[0], a3[1], a3[2], a3[3]};
                    if (pt == 0) { ya0 = __builtin_amdgcn_mfma_f32_32x32x16_bf16(af0, pk0, ya0, 0, 0, 0); ya0 = __builtin_amdgcn_mfma_f32_32x32x16_bf16(af1, pk1, ya0, 0, 0, 0); }
                    else { ya1 = __builtin_amdgcn_mfma_f32_32x32x16_bf16(af0, pk0, ya1, 0, 0, 0); ya1 = __builtin_amdgcn_mfma_f32_32x32x16_bf16(af1, pk1, ya1, 0, 0, 0); }
                }
            }
            bf16* yrow = Y + (size_t)lrow * 2048 + h * 64 + 4 * hi;
#pragma unroll
            for (int q = 0; q < 4; ++q) { *(GAS unsigned long long*)(yrow + 8 * q) = (unsigned long long)cvtpk(ya0[4 * q], ya0[4 * q + 1]) | ((unsigned long long)cvtpk(ya0[4 * q + 2], ya0[4 * q + 3]) << 32);
                                          *(GAS unsigned long long*)(yrow + 32 + 8 * q) = (unsigned long long)cvtpk(ya1[4 * q], ya1[4 * q + 1]) | ((unsigned long long)cvtpk(ya1[4 * q + 2], ya1[4 * q + 3]) << 32); }
          } }
        __syncthreads();
    }
    LAS bf16* BT = (LAS bf16*)(lds + SSD_BT); LAS bf16* XT = (LAS bf16*)(lds + SSD_XT);
    { const int s0 = 4 * lane;
#pragma unroll
      for (int cq = 0; cq < 2; ++cq) { const int nb = 8 * (2 * wave + cq);
        const bf16* bp = XBC + (size_t)(t0 + s0) * CONVD + 2048 + g * 128 + nb;
        const v4u w0 = *(const GAS v4u*)bp, w1 = *(const GAS v4u*)(bp + CONVD), w2 = *(const GAS v4u*)(bp + 2 * CONVD), w3 = *(const GAS v4u*)(bp + 3 * CONVD);
        stage4_tr(BT + nb * SSD_LD + s0, SSD_LD, w0, w1, w2, w3, 1.f, 1.f, 1.f, 1.f); } }
    for (int hh = 0; hh < 4; ++hh) {
        const int h = 4 * g + hh;
        { const float aend = acs[hh * 256 + 255]; const int s0 = 4 * lane, pb = 8 * wave;
          const bf16* xp = XBC + (size_t)(t0 + s0) * CONVD + h * 64 + pb;
          const v4u w0 = *(const GAS v4u*)xp, w1 = *(const GAS v4u*)(xp + CONVD), w2 = *(const GAS v4u*)(xp + 2 * CONVD), w3 = *(const GAS v4u*)(xp + 3 * CONVD);
          const f32x4 dv = *(const LAS f32x4*)(dtl + hh * 256 + s0), av = *(const LAS f32x4*)(acs + hh * 256 + s0);
          stage4_tr(XT + pb * SSD_LD + s0, SSD_LD, w0, w1, w2, w3, dv[0] * __expf(aend - av[0]), dv[1] * __expf(aend - av[1]), dv[2] * __expf(aend - av[2]), dv[3] * __expf(aend - av[3])); }
        __syncthreads();
        { const int pt = wave >> 2, nt = wave & 3; f32x16 acc = {};
          const LAS bf16* ar = XT + (32 * pt + l32) * SSD_LD + 8 * hi; const LAS bf16* br = BT + (32 * nt + l32) * SSD_LD + 8 * hi;
#pragma unroll
          for (int kk = 0; kk < 16; ++kk) { const bf16x8 a = *(const LAS bf16x8*)(ar + 16 * kk), b = *(const LAS bf16x8*)(br + 16 * kk); acc = __builtin_amdgcn_mfma_f32_32x32x16_bf16(a, b, acc, 0, 0, 0); }
          float* sp = ST + ((size_t)(c * 32 + h) * 64 + 32 * pt) * 128 + 32 * nt + l32;
#pragma unroll
          for (int r = 0; r < 16; ++r) sp[(size_t)crow(r, hi) * 128] = acc[r]; }
        __syncthreads();
    }
}
constexpr int S3_LD = 68;
__device__ __forceinline__ void ssd3_unit(LAS unsigned char* lds, int c, int g, const bf16* XBC, const bf16* PROJ, const bf16* Y, bf16* Y2, const bf16* PREV, const float* ACSG, const float* dsk, unsigned char* CAT, bool cat_f8, int tid_in) {
    int tid = tid_in; asm volatile("" : "+v"(tid));
    const int lane = tid & 63, wave = __builtin_amdgcn_readfirstlane(tid >> 6), l32 = lane & 31, hi = lane >> 5;
    LAS float* T = (LAS float*)(lds + 65536) + wave * (32 * S3_LD);
    const int t0 = c * CHUNK; const int lrow = t0 + 32 * wave + l32;
    asm volatile("s_waitcnt vmcnt(0) lgkmcnt(0)" ::: "memory"); __builtin_amdgcn_s_barrier();
    { const int sr = tid >> 4, spc = tid & 15, slc = spc ^ (sr & 7);
      const char* psrc = (const char*)(PREV + ((size_t)(c * 32 + 4 * g) * 64 + sr) * 128 + 8 * slc);
#pragma unroll
      for (int q = 0; q < 8; ++q)
          __builtin_amdgcn_global_load_lds((const unsigned*)(psrc + (size_t)q * (32 * 128 * 2)), (LAS unsigned*)(lds + q * 8192 + wave * 1024), 16, 0, 0); }
    const int q8 = (lane & 7) * 8, tl0 = lane >> 3;
    bf16x8 cf[8];
#pragma unroll
    for (int kk = 0; kk < 8; ++kk) cf[kk] = *(const GAS bf16x8*)(XBC + (size_t)lrow * CONVD + 3072 + g * 128 + 16 * kk + 8 * hi);
    float ss[4] = {0.f, 0.f, 0.f, 0.f};
    asm volatile("s_waitcnt vmcnt(0)" ::: "memory"); __builtin_amdgcn_s_barrier(); asm volatile("" ::: "memory");
    const int sw = l32 & 7;
#pragma unroll
    for (int hh = 0; hh < 4; ++hh) { const int h = 4 * g + hh; const float dk = dsk[h];
        f32x16 acc0 = {}, acc1 = {};
        const LAS unsigned char* pr = lds + hh * 16384 + l32 * 256;
#pragma unroll
        for (int kk = 0; kk < 8; ++kk) { const int cx = ((2 * kk + hi) ^ sw) << 4; const bf16x8 w0 = *(const LAS bf16x8*)(pr + cx), w1 = *(const LAS bf16x8*)(pr + 8192 + cx);
            acc0 = __builtin_amdgcn_mfma_f32_32x32x16_bf16(cf[kk], w0, acc0, 0, 0, 0);
            acc1 = __builtin_amdgcn_mfma_f32_32x32x16_bf16(cf[kk], w1, acc1, 0, 0, 0); }
        asm volatile("" ::: "memory");
#pragma unroll
        for (int r = 0; r < 16; ++r) { T[crow(r, hi) * S3_LD + l32] = acc0[r]; T[crow(r, hi) * S3_LD + 32 + l32] = acc1[r]; }
        asm volatile("s_waitcnt lgkmcnt(0)" ::: "memory");
#pragma unroll
        for (int ip = 0; ip < 2; ++ip) {
            v4u yw[2]; v4u xw[2], zw[2]; float ea[2];
#pragma unroll
            for (int ii = 0; ii < 2; ++ii) { const int i = 2 * ip + ii; const int t = t0 + 32 * wave + tl0 + 8 * i; const int ch = h * 64 + q8;
                yw[ii] = *(const GAS v4u*)(Y + (size_t)t * 2048 + ch);
                xw[ii] = *(const GAS v4u*)(XBC + (size_t)t * CONVD + ch); zw[ii] = *(const GAS v4u*)(PROJ + (size_t)t * NPROJ + OFF_Z + ch); ea[ii] = __expf(ACSG[(size_t)t * 32 + h]); }
#pragma unroll
            for (int ii = 0; ii < 2; ++ii) { const int i = 2 * ip + ii; const LAS f32x4* tp = (const LAS f32x4*)(T + (tl0 + 8 * i) * S3_LD + q8); const f32x4 a0 = tp[0], a1 = tp[1];
                const float xv[8] = {bflo(xw[ii].x), bfhi(xw[ii].x), bflo(xw[ii].y), bfhi(xw[ii].y), bflo(xw[ii].z), bfhi(xw[ii].z), bflo(xw[ii].w), bfhi(xw[ii].w)};
                const float zv[8] = {bflo(zw[ii].x), bfhi(zw[ii].x), bflo(zw[ii].y), bfhi(zw[ii].y), bflo(zw[ii].z), bfhi(zw[ii].z), bflo(zw[ii].w), bfhi(zw[ii].w)};
                const float ydv[8] = {bflo(yw[ii].x), bfhi(yw[ii].x), bflo(yw[ii].y), bfhi(yw[ii].y), bflo(yw[ii].z), bfhi(yw[ii].z), bflo(yw[ii].w), bfhi(yw[ii].w)};
                float y[8];
#pragma unroll
                for (int j = 0; j < 8; ++j) { const float a = j < 4 ? a0[j & 3] : a1[j & 3], yd = ydv[j];
                    float v = a * ea[ii] + yd + dk * xv[j]; v *= zv[j] / (1.f + __expf(-zv[j])); y[j] = v; ss[i] += v * v; }
                *(GAS v4u*)(Y2 + (size_t)(t0 + 32 * wave + tl0 + 8 * i) * 2048 + h * 64 + q8) = (v4u){cvtpk(y[0], y[1]), cvtpk(y[2], y[3]), cvtpk(y[4], y[5]), cvtpk(y[6], y[7])}; }
            asm volatile("" ::: "memory");
        }
        asm volatile("s_waitcnt lgkmcnt(0)" ::: "memory");
    }
    asm volatile("s_waitcnt vmcnt(0)" ::: "memory");
    float rs[4];
#pragma unroll
    for (int i = 0; i < 4; ++i) { float s = ss[i]; s += __shfl_xor(s, 1); s += __shfl_xor(s, 2); s += __shfl_xor(s, 4); rs[i] = 1.f / sqrtf(s * (1.f / 256.f) + EPS); }
#pragma unroll
    for (int hh = 0; hh < 4; ++hh)
#pragma unroll
        for (int i = 0; i < 4; ++i) { const int t = t0 + 32 * wave + tl0 + 8 * i; const float r = rs[i];
            const unsigned long long* yp = (const unsigned long long*)(Y2 + (size_t)t * 2048 + (4 * g + hh) * 64 + q8);
            const unsigned long long u0 = __hip_atomic_load(yp, __ATOMIC_RELAXED, __HIP_MEMORY_SCOPE_AGENT), u1 = __hip_atomic_load(yp + 1, __ATOMIC_RELAXED, __HIP_MEMORY_SCOPE_AGENT);
            const v4u w = {(unsigned)u0, (unsigned)(u0 >> 32), (unsigned)u1, (unsigned)(u1 >> 32)};
            if (cat_f8) {
            const unsigned long long o = (unsigned long long)pg8::pk4_fp8(bflo(w.x) * r, bfhi(w.x) * r, bflo(w.y) * r, bfhi(w.y) * r) | ((unsigned long long)pg8::pk4_fp8(bflo(w.z) * r, bfhi(w.z) * r, bflo(w.w) * r, bfhi(w.w) * r) << 32);
            *(GAS unsigned long long*)(CAT + (size_t)t * DM + 2048 + (4 * g + hh) * 64 + q8) = o; }
            else *(GAS v4u*)((bf16*)CAT + (size_t)t * DM + 2048 + (4 * g + hh) * 64 + q8) = (v4u){cvtpk(bflo(w.x) * r, bfhi(w.x) * r), cvtpk(bflo(w.y) * r, bfhi(w.y) * r), cvtpk(bflo(w.z) * r, bfhi(w.z) * r), cvtpk(bflo(w.w) * r, bfhi(w.w) * r)}; }
}

#define KSWZ(row, colB) ((row) * 256 + ((colB) ^ (((row) & 7) << 4)))
#define SBAR() __builtin_amdgcn_sched_barrier(0)
__device__ __forceinline__ int v_st(int k, int c) { const int kk = (k & ~0xC) | ((k & 4) << 1) | ((k & 8) >> 1); return ((kk >> 3) * 4 + (c >> 5)) * 512 + ((kk & 7) * 32 + (c & 31)) * 2; }
__device__ __forceinline__ int v_rd_base(int lane) { return ((lane & 3) << 3) | (((lane >> 2) & 3) << 6) | (((lane >> 4) & 1) << 5) | (((lane >> 5) & 1) << 8); }
constexpr int v_rd_off(int d0, int ks, int half) { return d0 * 512 + ks * 4096 + half * 2048; }
constexpr int AT_K = 0, AT_V = 49152, AT_WS = 98304, AT_IMP = AT_WS + 2048, AT_IMPLD = 129, AT_CARRY = AT_IMP + 64 * AT_IMPLD * 4, AT_BM = AT_CARRY + 2048, AT_END = AT_BM + 1024;
static_assert(AT_END <= LDSCTL_OFF, "attention lds");
constexpr float AT_THR = 11.5f;

__device__ __forceinline__ void at_qkt(f32x16& p0, f32x16& p1, const LAS unsigned char* Kt, int l32, int hi, const bf16x8 (&qr)[8], const f32x16& cinit) {
    const LAS unsigned char* kb[4];
#pragma unroll
    for (int dd = 0; dd < 4; ++dd) kb[dd] = Kt + KSWZ(l32, (dd * 16 + hi * 8) * 2);
#pragma unroll
    for (int d0 = 0; d0 < 8; ++d0) { const LAS unsigned char* a = kb[d0 & 3] + (d0 >> 2) * 128;
        const bf16x8 b0 = *(const LAS bf16x8*)a, b1 = *(const LAS bf16x8*)(a + 32 * 256);
        if (d0 == 0) { p0 = __builtin_amdgcn_mfma_f32_32x32x16_bf16(b0, qr[0], cinit, 0, 0, 0); p1 = __builtin_amdgcn_mfma_f32_32x32x16_bf16(b1, qr[0], cinit, 0, 0, 0); }
        else { p0 = __builtin_amdgcn_mfma_f32_32x32x16_bf16(b0, qr[d0], p0, 0, 0, 0); p1 = __builtin_amdgcn_mfma_f32_32x32x16_bf16(b1, qr[d0], p1, 0, 0, 0); } }
}
__device__ __forceinline__ void at_pv(f32x16 (&o)[4], int vb, bf16x8 pa0, bf16x8 pa1, bf16x8 pa2, bf16x8 pa3) {
#define TRRD(dst, off) asm volatile("ds_read_b64_tr_b16 %0, %1 offset:%2" : "=&v"(dst) : "v"(vb), "i"(off) : "memory")
#define PV_D0(d0) do { s16x4 l0, l1, l2, l3, h0, h1, h2, h3; constexpr int b_ = v_rd_off(d0, 0, 0); \
        TRRD(l0, b_); TRRD(h0, b_ + 2048); TRRD(l1, b_ + 4096); TRRD(h1, b_ + 6144); TRRD(l2, b_ + 8192); TRRD(h2, b_ + 10240); TRRD(l3, b_ + 12288); TRRD(h3, b_ + 14336); \
        asm volatile("s_waitcnt lgkmcnt(0)" ::: "memory"); SBAR(); \
        o[d0] = __builtin_amdgcn_mfma_f32_32x32x16_bf16(pa0, (bf16x8){l0[0], l0[1], l0[2], l0[3], h0[0], h0[1], h0[2], h0[3]}, o[d0], 0, 0, 0); \
        o[d0] = __builtin_amdgcn_mfma_f32_32x32x16_bf16(pa1, (bf16x8){l1[0], l1[1], l1[2], l1[3], h1[0], h1[1], h1[2], h1[3]}, o[d0], 0, 0, 0); \
        o[d0] = __builtin_amdgcn_mfma_f32_32x32x16_bf16(pa2, (bf16x8){l2[0], l2[1], l2[2], l2[3], h2[0], h2[1], h2[2], h2[3]}, o[d0], 0, 0, 0); \
        o[d0] = __builtin_amdgcn_mfma_f32_32x32x16_bf16(pa3, (bf16x8){l3[0], l3[1], l3[2], l3[3], h3[0], h3[1], h3[2], h3[3]}, o[d0], 0, 0, 0); } while (0)
    PV_D0(0); PV_D0(1); PV_D0(2); PV_D0(3);
#undef PV_D0
#undef TRRD
}
__device__ __forceinline__ float max3f(float a, float b, float c) { float r; asm("v_max3_f32 %0, %1, %2, %3" : "=v"(r) : "v"(a), "v"(b), "v"(c)); return r; }
__device__ __forceinline__ float at_softmax(f32x16& p0, f32x16& p1, float& m_reg, f32x16& negm, float& l_reg, bf16x8& pa0, bf16x8& pa1, bf16x8& pa2, bf16x8& pa3, bool rowsel, bool use_rowsel) {
    float ma = max3f(p0[0], p0[1], p0[2]), mb = max3f(p0[3], p0[4], p0[5]), mc = max3f(p0[6], p0[7], p0[8]), md = max3f(p0[9], p0[10], p0[11]);
    ma = max3f(ma, p0[12], p0[13]); mb = max3f(mb, p0[14], p0[15]); mc = max3f(mc, p1[0], p1[1]); md = max3f(md, p1[2], p1[3]);
    ma = max3f(ma, p1[4], p1[5]); mb = max3f(mb, p1[6], p1[7]); mc = max3f(mc, p1[8], p1[9]); md = max3f(md, p1[10], p1[11]);
    ma = max3f(ma, p1[12], p1[13]); mb = max3f(mb, p1[14], p1[15]);
    float pmax = fmaxf(max3f(ma, mb, mc), md);
    if (use_rowsel && !rowsel) pmax = -__builtin_inff();
    { auto rr = __builtin_amdgcn_permlane32_swap(__float_as_uint(pmax), __float_as_uint(pmax), false, false); pmax = fmaxf(__uint_as_float(rr[0]), __uint_as_float(rr[1])); }
    float alpha = 1.f;
    if (!__all(pmax <= AT_THR)) {
        const float d = fmaxf(pmax, 0.f); alpha = __builtin_amdgcn_exp2f(-d); m_reg += d;
#pragma unroll
        for (int r = 0; r < 16; ++r) { p0[r] -= d; p1[r] -= d; negm[r] = -m_reg; }
    }
    float s0 = 0.f, s1 = 0.f, s2 = 0.f, s3 = 0.f;
#pragma unroll
    for (int r = 0; r < 16; r += 4) { p0[r] = __builtin_amdgcn_exp2f(p0[r]); p0[r + 1] = __builtin_amdgcn_exp2f(p0[r + 1]); p0[r + 2] = __builtin_amdgcn_exp2f(p0[r + 2]); p0[r + 3] = __builtin_amdgcn_exp2f(p0[r + 3]);
        s0 += p0[r]; s1 += p0[r + 1]; s2 += p0[r + 2]; s3 += p0[r + 3]; }
#pragma unroll
    for (int r = 0; r < 16; r += 4) { p1[r] = __builtin_amdgcn_exp2f(p1[r]); p1[r + 1] = __builtin_amdgcn_exp2f(p1[r + 1]); p1[r + 2] = __builtin_amdgcn_exp2f(p1[r + 2]); p1[r + 3] = __builtin_amdgcn_exp2f(p1[r + 3]);
        s0 += p1[r]; s1 += p1[r + 1]; s2 += p1[r + 2]; s3 += p1[r + 3]; }
    float ps = (s0 + s1) + (s2 + s3);
    if (use_rowsel && !rowsel) ps = 0.f;
    { auto rr = __builtin_amdgcn_permlane32_swap(__float_as_uint(ps), __float_as_uint(ps), false, false); ps = __uint_as_float(rr[0]) + __uint_as_float(rr[1]); }
    l_reg = l_reg * alpha + ps;
    const unsigned keep = (use_rowsel && !rowsel) ? 0u : 0xffffffffu;
#define PK4(P, B_, OUT) do { unsigned a0 = cvtpk(P[B_+0], P[B_+1]), a1 = cvtpk(P[B_+2], P[B_+3]); unsigned b0 = cvtpk(P[B_+4], P[B_+5]), b1 = cvtpk(P[B_+6], P[B_+7]); \
        if (use_rowsel) { a0 &= keep; a1 &= keep; b0 &= keep; b1 &= keep; } \
        auto r0 = __builtin_amdgcn_permlane32_swap(a0, b0, false, false); auto r1 = __builtin_amdgcn_permlane32_swap(a1, b1, false, false); \
        v4u w = {r0[0], r1[0], r0[1], r1[1]}; OUT = __builtin_bit_cast(bf16x8, w); } while (0)
    PK4(p0, 0, pa0); PK4(p0, 8, pa1); PK4(p1, 0, pa2); PK4(p1, 8, pa3);
#undef PK4
    return alpha;
}
template <int MODE>
__device__ __forceinline__ void at_mask(f32x16& p0, f32x16& p1, int kb, int hi, int tq, int lim, bool rowsel) {
    const float NEG = -__builtin_inff();
#pragma unroll
    for (int r = 0; r < 16; ++r) { const int k0 = kb + (r & 3) + 8 * (r >> 2) + 4 * hi, k1 = k0 + 32;
        bool v0, v1;
        if (MODE == 0) { v0 = k0 <= lim; v1 = k1 <= lim; }
        else if (MODE == 1) { v0 = rowsel && k0 <= tq; v1 = rowsel && k1 <= tq; }
        else { v0 = (unsigned)(tq - k0) < (unsigned)WIN; v1 = (unsigned)(tq - k1) < (unsigned)WIN; }
        if (!v0) p0[r] = NEG; if (!v1) p1[r] = NEG; }
}
template <int MODE>
__device__ __forceinline__ void at_branch(LAS unsigned char* lds, const bf16x8 (&qr)[8], const bf16* Kb, const bf16* Vb, int ld, int jlo, int NT, int tq, int lim, const LAS unsigned* bmrow,
                                          bf16* Obase, float& m_out, float& l_out, int tid_in) {
    int tid = tid_in; asm volatile("" : "+v"(tid));
    const int lane = tid & 63, wave = __builtin_amdgcn_readfirstlane(tid >> 6), l32 = lane & 31, hi = lane >> 5;
    LAS unsigned char* K_lds = lds + AT_K; LAS unsigned char* V_lds = lds + AT_V;
    LAS float* wsl = (LAS float*)(lds + AT_WS) + wave * 64;
    const int vb0 = (int)(unsigned)(size_t)V_lds + v_rd_base(lane);
    const int ksr = tid >> 4, kslc = (tid & 15) ^ (ksr & 7);
    const int vkk = (tid >> 7) * 8 + ((tid & 31) >> 2), vk = (vkk & ~0xC) | ((vkk & 4) << 1) | ((vkk & 8) >> 1), vc = ((tid >> 5) & 3) * 32 + (tid & 3) * 8;
    const char* ksrc = (const char*)(Kb + (size_t)ksr * ld + 8 * kslc); const char* vsrc = (const char*)(Vb + (size_t)vk * ld + vc);
    const size_t half_b = (size_t)32 * ld * 2, tile_b = (size_t)64 * ld * 2; const unsigned ldsw = (unsigned)wave * 1024u;
#define AT_ISSUE(j, stg) do { const size_t jo_ = (size_t)(j) * tile_b; \
        __builtin_amdgcn_global_load_lds((const GAS unsigned*)(ksrc + jo_), (LAS unsigned*)(K_lds + (stg) * 16384 + ldsw), 16, 0, 0); \
        __builtin_amdgcn_global_load_lds((const GAS unsigned*)(ksrc + jo_ + half_b), (LAS unsigned*)(K_lds + (stg) * 16384 + 8192 + ldsw), 16, 0, 0); \
        __builtin_amdgcn_global_load_lds((const GAS unsigned*)(vsrc + jo_), (LAS unsigned*)(V_lds + (stg) * 16384 + ldsw), 16, 0, 0); \
        __builtin_amdgcn_global_load_lds((const GAS unsigned*)(vsrc + jo_ + half_b), (LAS unsigned*)(V_lds + (stg) * 16384 + 8192 + ldsw), 16, 0, 0); } while (0)
    float m_reg = -1e4f, l_reg = 0.f; f32x16 o[4] = {};
    f32x16 negm;
#pragma unroll
    for (int r = 0; r < 16; ++r) negm[r] = 1e4f;
    const int tq_min = __builtin_amdgcn_readfirstlane(tq), lim_min = (tq_min - 31) >> 4;
    asm volatile("s_waitcnt vmcnt(0) lgkmcnt(0)" ::: "memory"); __builtin_amdgcn_s_barrier(); asm volatile("" ::: "memory");
    AT_ISSUE(jlo, 0); if (NT > 1) AT_ISSUE(jlo + 1, 1);
    int stg = 0;
    for (int t = 0; t < NT; ++t) {
        const int j = jlo + t; const int buf = stg;
        if (t + 1 < NT) asm volatile("s_waitcnt vmcnt(4)" ::: "memory"); else asm volatile("s_waitcnt vmcnt(0)" ::: "memory");
        __builtin_amdgcn_s_barrier(); asm volatile("" ::: "memory");
        if (t + 2 < NT) { const int s2 = stg == 0 ? 2 : stg - 1; AT_ISSUE(j + 2, s2); }
        bool rowsel = true;
        if (MODE == 1) rowsel = ((bmrow[j >> 5] >> (j & 31)) & 1u) != 0u;
        if (MODE != 1 || __any(rowsel)) {
        f32x16 p0, p1;
        at_qkt(p0, p1, K_lds + buf * 16384, l32, hi, qr, negm);
        const bool need_mask = MODE == 0 ? (64 * j + 63 > lim_min) : (MODE == 1 ? (64 * j + 63 > tq_min) : (64 * j + 63 > tq_min || 64 * j <= tq_min + 7 - WIN));
        if (need_mask) at_mask<MODE>(p0, p1, 64 * j, hi, tq, lim, true);
        bf16x8 pa0, pa1, pa2, pa3;
        const float alpha = at_softmax(p0, p1, m_reg, negm, l_reg, pa0, pa1, pa2, pa3, rowsel, MODE == 1);
        if (__any(alpha < 1.f)) { if (hi == 0) wsl[l32] = alpha; asm volatile("s_waitcnt lgkmcnt(0)" ::: "memory");
#pragma unroll
            for (int d = 0; d < 4; ++d)
#pragma unroll
                for (int r = 0; r < 16; ++r) o[d][r] *= wsl[crow(r, hi)]; }
        at_pv(o, vb0 + buf * 16384, pa0, pa1, pa2, pa3);
        }
        stg = stg == 2 ? 0 : stg + 1;
    }
    asm volatile("s_waitcnt lgkmcnt(0)" ::: "memory");
    if (hi == 0) wsl[32 + l32] = l_reg > 0.f ? 1.f / l_reg : 0.f;
    asm volatile("s_waitcnt lgkmcnt(0)" ::: "memory");
#pragma unroll
    for (int r = 0; r < 16; ++r) { const int q = crow(r, hi); const float rli = wsl[32 + q]; bf16* op = Obase + (size_t)(8 * wave + (q >> 2)) * 2048 + (q & 3) * 128 + l32;
#pragma unroll
        for (int d0 = 0; d0 < 4; ++d0) op[d0 * 32] = (bf16)f2bf(o[d0][r] * rli); }
    m_out = m_reg; l_out = l_reg;
#undef AT_ISSUE
}
__device__ __forceinline__ void at_importance(LAS unsigned char* lds, const bf16x8 (&qr)[8], const bf16* Kb, int nct, int lim, float m_reg, float l_reg, int tid_in) {
    int tid = tid_in; asm volatile("" : "+v"(tid));
    const int lane = tid & 63, wave = __builtin_amdgcn_readfirstlane(tid >> 6), l32 = lane & 31, hi = lane >> 5;
    LAS unsigned char* K_lds = lds + AT_K;
    LAS float* S4L = (LAS float*)(lds + AT_V); LAS float* LASTL = (LAS float*)(lds + AT_V + 16384);
    LAS float* imp = (LAS float*)(lds + AT_IMP); LAS float* carry = (LAS float*)(lds + AT_CARRY);
    const int sr = tid >> 4, sc = (tid & 15) * 8, kws = KSWZ(sr, sc * 2);
    const int head = l32 & 3, tok = 8 * wave + (l32 >> 2);
    const float linv = l_reg > 0.f ? 1.f / l_reg : 0.f; const f32x16 zero16 = {};
    bf16x8 st_k0, st_k1;
    __syncthreads();
    if (tid < 256) carry[tid] = 0.f;
    { const bf16* kp_ = Kb + (size_t)sr * 128 + sc; st_k0 = *(const GAS bf16x8*)kp_; st_k1 = *(const GAS bf16x8*)(kp_ + 32 * 128); }
    *(LAS bf16x8*)(K_lds + kws) = st_k0; *(LAS bf16x8*)(K_lds + kws + 32 * 256) = st_k1;
    __syncthreads();
    for (int t = 0; t < nct; ++t) {
        const int buf = t & 1;
        if (t + 1 < nct) { const bf16* kp_ = Kb + (size_t)(64 * (t + 1) + sr) * 128 + sc; st_k0 = *(const GAS bf16x8*)kp_; st_k1 = *(const GAS bf16x8*)(kp_ + 32 * 128); }
        f32x16 p0, p1;
        at_qkt(p0, p1, K_lds + buf * 16384, l32, hi, qr, zero16);
        at_mask<0>(p0, p1, 64 * t, hi, 0, lim, true);
#pragma unroll
        for (int r = 0; r < 16; ++r) { p0[r] = __builtin_amdgcn_exp2f(p0[r] - m_reg) * linv; p1[r] = __builtin_amdgcn_exp2f(p1[r] - m_reg) * linv; }
        LAS float* sp = S4L + (head * 64 + tok) * 16 + hi; LAS float* lp = LASTL + (head * 64 + tok) * 16 + hi;
#pragma unroll
        for (int q = 0; q < 4; ++q) { sp[2 * q] = (p0[4 * q] + p0[4 * q + 1]) + (p0[4 * q + 2] + p0[4 * q + 3]); lp[2 * q] = p0[4 * q + 3];
                                      sp[8 + 2 * q] = (p1[4 * q] + p1[4 * q + 1]) + (p1[4 * q + 2] + p1[4 * q + 3]); lp[8 + 2 * q] = p1[4 * q + 3]; }
        if (t + 1 < nct) { *(LAS bf16x8*)(K_lds + (buf ^ 1) * 16384 + kws) = st_k0; *(LAS bf16x8*)(K_lds + (buf ^ 1) * 16384 + kws + 32 * 256) = st_k1; }
        __syncthreads();
#pragma unroll
        for (int i = 0; i < 2; ++i) { const int item = tid + 512 * i, tk = item >> 4, gq = item & 15; float a = 0.f;
#pragma unroll
            for (int h = 0; h < 4; ++h) a += S4L[(h * 64 + tk) * 16 + gq] + (gq > 0 ? LASTL[(h * 64 + tk) * 16 + gq - 1] : carry[(t & 1) * 256 + h * 64 + tk]);
            imp[tk * AT_IMPLD + 16 * t + gq] = a; }
        if (tid < 256) carry[((t + 1) & 1) * 256 + tid] = LASTL[tid * 16 + 15];
        __syncthreads();
    }
}
__device__ __forceinline__ void at_topk(LAS unsigned char* lds, int tb, int tid_in) {
    int tid = tid_in; asm volatile("" : "+v"(tid));
    const int lane = tid & 63, wave = __builtin_amdgcn_readfirstlane(tid >> 6);
    const LAS float* imp = (const LAS float*)(lds + AT_IMP); LAS unsigned* bm = (LAS unsigned*)(lds + AT_BM);
    const int nforced = tb >= 2 ? 3 : tb + 1, nfree = SELTOP - nforced, ncand = tb - 2 > 0 ? tb - 2 : 0;
    const int j0 = lane, j1 = lane + 64;
    const bool c0 = j0 >= 1 && j0 <= tb - 2, c1 = j1 <= tb - 2;
    const bool f0 = (j0 == 0) || (j0 == tb) || (j0 == tb - 1), f1 = (j1 == tb) || (j1 == tb - 1);
    for (int i = 0; i < 8; ++i) { const int tk = wave * 8 + i;
        const unsigned k0 = c0 ? __float_as_uint(imp[tk * AT_IMPLD + j0]) + 1u : 0u, k1 = c1 ? __float_as_uint(imp[tk * AT_IMPLD + j1]) + 1u : 0u;
        bool s0, s1;
        if (ncand <= nfree) { s0 = c0; s1 = c1; }
        else {
            unsigned T = 0u;
            for (int b = 31; b >= 0; --b) { const unsigned cnd = T | (1u << b); const int cnt = __popcll(__ballot(k0 >= cnd)) + __popcll(__ballot(k1 >= cnd)); if (cnt >= nfree) T = cnd; }
            const bool g0 = k0 > T, g1 = k1 > T; const int ngt = __popcll(__ballot(g0)) + __popcll(__ballot(g1)); const int need = nfree - ngt;
            const unsigned long long e0 = __ballot(k0 == T), e1 = __ballot(k1 == T); const unsigned long long below = (1ull << lane) - 1ull;
            const int rk0 = __popcll(e0 & below), rk1 = __popcll(e0) + __popcll(e1 & below);
            s0 = g0 || (k0 == T && rk0 < need); s1 = g1 || (k1 == T && rk1 < need);
        }
        const unsigned long long m0 = __ballot(s0 || f0), m1 = __ballot(s1 || f1);
        if (lane == 0) { bm[tk * 4 + 0] = (unsigned)m0; bm[tk * 4 + 1] = (unsigned)(m0 >> 32); bm[tk * 4 + 2] = (unsigned)m1; bm[tk * 4 + 3] = (unsigned)(m1 >> 32); }
    }
}
__device__ __forceinline__ void attn_unit(LAS unsigned char* lds, int g, int tb, const bf16* PROJ, const bf16* KC, const bf16* VC, bf16* AO, int tid) {
    const int lane = tid & 63, wave = __builtin_amdgcn_readfirstlane(tid >> 6), l32 = lane & 31, hi = lane >> 5;
    const int tokl = 8 * wave + (l32 >> 2), head = 4 * g + (l32 & 3), T0 = 64 * tb, tq = T0 + tokl;
    bf16x8 qr[8];
#pragma unroll
    for (int d0 = 0; d0 < 8; ++d0) qr[d0] = *(const GAS bf16x8*)(PROJ + (size_t)tq * NPROJ + OFF_Q + head * 128 + d0 * 16 + hi * 8);
    bf16* Orow0 = AO + (size_t)T0 * 2048 + 4 * g * 128;
    const int nct = tb / 16 + 1; const int lim = (tq - 31) >> 4;
    float m_c, l_c, m_d, l_d;
    at_branch<0>(lds, qr, KC + (size_t)g * 512 * 128, VC + (size_t)g * 512 * 128, 128, 0, nct, tq, lim, nullptr, Orow0, m_c, l_c, tid);
    at_importance(lds, qr, KC + (size_t)g * 512 * 128, nct, lim, m_c, l_c, tid);
    __syncthreads();
    at_topk(lds, tb, tid);
    __syncthreads();
    const LAS unsigned* bmrow = (const LAS unsigned*)(lds + AT_BM) + tokl * 4;
    at_branch<1>(lds, qr, PROJ + OFF_KS + g * 128, PROJ + OFF_VS + g * 128, NPROJ, 0, tb + 1, tq, 0, bmrow, Orow0 + (size_t)S * 2048, m_d, l_d, tid);
    const int jlo = tb - 8 > 0 ? tb - 8 : 0;
    at_branch<2>(lds, qr, PROJ + OFF_KW + g * 128, PROJ + OFF_VW + g * 128, NPROJ, jlo, tb - jlo + 1, tq, 0, nullptr, Orow0 + (size_t)2 * S * 2048, m_d, l_d, tid);
    __syncthreads();
}


constexpr int CM_RED = 0, CM_H = 16384, CM_HLD = 136;
constexpr int CM_STG = 8192 + 32768, CM_NSTG = 3;
static_assert(CM_NSTG * CM_STG <= 131072, "compression ring");
__device__ __forceinline__ void cmp_unit(LAS unsigned char* lds, int kv, int g, int ib, const bf16* PROJ, const bf16* W1T, const bf16* W2T, const float* B1P, bf16* OUT, int tid_in) {
    int tid = tid_in; asm volatile("" : "+v"(tid));
    const int lane = tid & 63, wave = __builtin_amdgcn_readfirstlane(tid >> 6), l32 = lane & 31, hi = lane >> 5, nt = wave & 3, kh = wave >> 2;
    LAS float* red = (LAS float*)(lds + CM_RED); LAS bf16* Hs = (LAS bf16*)(lds + CM_H);
    const int coff = (kv == 0 ? OFF_KC : OFF_VC) + g * 128;
    const int sr = tid >> 4, spc = tid & 15, slc = spc ^ (sr & 7);
    const int ia = 32 * ib + sr, iac = ia < 510 ? ia : 510;
    const char* asrc = (const char*)(PROJ + (size_t)(16 * iac) * NPROJ + coff + 8 * slc);
    const char* bsrc = (const char*)(W1T + (size_t)sr * 4096 + 8 * slc);
    const unsigned ldsw = (unsigned)wave * 1024u;
#define CM_ISSUE(l_, stg_) do { LAS unsigned char* sb_ = lds + (stg_) * CM_STG; \
        __builtin_amdgcn_global_load_lds((const unsigned*)(asrc + (size_t)(l_) * (NPROJ * 2)), (LAS unsigned*)(sb_ + ldsw), 16, 0, 0); \
        _Pragma("unroll") for (int q_ = 0; q_ < 4; ++q_) \
            __builtin_amdgcn_global_load_lds((const unsigned*)(bsrc + (size_t)q_ * (32 * 4096 * 2) + (size_t)(l_) * 256), (LAS unsigned*)(sb_ + 8192 + q_ * 8192 + ldsw), 16, 0, 0); } while (0)
    f32x16 acc = {};
    asm volatile("s_waitcnt vmcnt(0) lgkmcnt(0)" ::: "memory"); __builtin_amdgcn_s_barrier();
    CM_ISSUE(0, 0); CM_ISSUE(1, 1);
    const int sw = l32 & 7;
    for (int l = 0; l < 32; ++l) { const int stg = l % CM_NSTG;
        if (l + 1 < 32) asm volatile("s_waitcnt vmcnt(5)" ::: "memory"); else asm volatile("s_waitcnt vmcnt(0)" ::: "memory");
        __builtin_amdgcn_s_barrier(); asm volatile("" ::: "memory");
        if (l + 2 < 32) CM_ISSUE(l + 2, (l + 2) % CM_NSTG);
        const LAS unsigned char* ap = lds + stg * CM_STG + l32 * 256; const LAS unsigned char* bp = lds + stg * CM_STG + 8192 + (32 * nt + l32) * 256;
#pragma unroll
        for (int kk = 0; kk < 4; ++kk) { const int c = (2 * (4 * kh + kk) + hi) ^ sw;
            const bf16x8 a = *(const LAS bf16x8*)(ap + 16 * c), b = *(const LAS bf16x8*)(bp + 16 * c); acc = __builtin_amdgcn_mfma_f32_32x32x16_bf16(a, b, acc, 0, 0, 0); }
    }
#undef CM_ISSUE
    asm volatile("s_waitcnt lgkmcnt(0)" ::: "memory"); __builtin_amdgcn_s_barrier(); asm volatile("" ::: "memory");
    if (kh == 1) {
#pragma unroll
        for (int r = 0; r < 16; ++r) red[(nt * 16 + r) * 64 + lane] = acc[r]; }
    __syncthreads();
    if (kh == 0) { const int n = 32 * nt + l32; float b1 = 0.f;
#pragma unroll
        for (int kc = 0; kc < 16; ++kc) b1 += B1P[kc * 128 + n];
#pragma unroll
        for (int r = 0; r < 16; ++r) { float v = acc[r] + red[(nt * 16 + r) * 64 + lane] + b1; v = v / (1.f + __expf(-v)); Hs[crow(r, hi) * CM_HLD + n] = (bf16)f2bf(v); } }
    __syncthreads();
    if (wave < 4) { f32x16 a2 = {};
#pragma unroll
        for (int kk = 0; kk < 8; ++kk) { const bf16x8 a = *(const LAS bf16x8*)(Hs + l32 * CM_HLD + 16 * kk + 8 * hi), b = *(const GAS bf16x8*)(W2T + (size_t)(32 * wave + l32) * 128 + 16 * kk + 8 * hi);
            a2 = __builtin_amdgcn_mfma_f32_32x32x16_bf16(a, b, a2, 0, 0, 0); }
#pragma unroll
        for (int r = 0; r < 16; ++r) { const int irow = 32 * ib + crow(r, hi); OUT[(size_t)irow * 128 + 32 * wave + l32] = irow < NCMP ? (bf16)f2bf(a2[r]) : (bf16)0; } }
    __syncthreads();
}

struct Args { const float* in[18]; float* out; unsigned char* ws; };


__global__ void __launch_bounds__(NWAVES * 64, 2) hybrid_fwd(Args args) {
    extern __shared__ __attribute__((aligned(16))) unsigned char lds[];
    Frame F;
    F.lds = (LAS unsigned char*)lds;
    F.MISC = (volatile LAS unsigned*)(F.lds + MISC_OFF);
    F.tid = threadIdx.x; F.lane = F.tid & 63; F.wave = __builtin_amdgcn_readfirstlane(F.tid >> 6);
    F.G = gridDim.x; { const int bx = blockIdx.x; F.vcu = (F.G % 8 == 0) ? (bx % 8) * (F.G / 8) + bx / 8 : bx; }
    unsigned char* ws = args.ws;
    F.ctl = (gu32*)(ws + WS_CTL);
    for (int u = F.tid; u < (LDS_BYTES - LDSCTL_OFF) / 4; u += NWAVES * 64) ((LAS unsigned*)(F.lds + LDSCTL_OFF))[u] = 0u;
    __syncthreads();
    (void)xcd_barrier_post((unsigned*)(F.ctl + CW_BAR), F.MISC + 8);
#define GRID_BAR() do { unsigned long long wz_ = 0; asm volatile("" : "+s"(wz_)); unsigned char* wsb_ = args.ws + wz_;     XcdBarrier b_; b_.bar = (unsigned*)((gu32*)(wsb_ + WS_CTL) + CW_BAR); b_.x = xb_xcc_id(); b_.st = (volatile LAS unsigned*)(F.lds + MISC_OFF) + 8; xcd_barrier(b_); } while (0)
#define PHASE_IDS() int tid_l_ = threadIdx.x; asm volatile("" : "+v"(tid_l_)); const int tid = tid_l_, lane = tid & 63, wave = __builtin_amdgcn_readfirstlane(tid >> 6); \
    const int gw = F.vcu * NWAVES + wave, NGW = F.G * NWAVES, gt = F.vcu * (NWAVES * 64) + tid, NGT = F.G * NWAVES * 64; (void)gw; (void)NGW; (void)gt; (void)NGT; (void)lane

    const float* x_in = args.in[0];
    bf16* XN = (bf16*)(ws + WS_XN); float* COS = (float*)(ws + WS_COS); float* SIN = (float*)(ws + WS_SIN);
    {
        PHASE_IDS();
        LAS float* scr = (LAS float*)(F.lds + RING_OFF + wave * 16384);
        constexpr int I_IN = (DM / 64) * (NPROJ / 32), I_O = (DM / 64) * (DM / 32), I_UP = (DM / 64) * (FF / 32), I_DN = (FF / 64) * (DM / 32);
        constexpr int I_L = I_IN + I_O + I_UP + I_DN;
        for (int rep = 0; rep < REP_PRO; ++rep)
        for (int it = gw; it < DEPTH * I_L; it += NGW) {
            const int l = it / I_L; int r = it % I_L;
            if (r < I_IN) { if (l >= PROJ_F8_FROM) p0_transpose_item_f8<true, 1>(args.in[2] + (size_t)l * DM * NSRC, DM, NSRC, NPROJ / 32, (unsigned char*)(ws + WS_WIN + l * SZ_WIN), WUP8_SCALE, args.in[1] + l * DM, args.in[1] + l * DM, DM, scr, r, lane);
                else p0_transpose_item<1, true>(args.in[2] + (size_t)l * DM * NSRC, DM, NSRC, NPROJ / 32, (bf16*)(ws + WS_WIN + l * SZ_WIN), args.in[1] + l * DM, args.in[1] + l * DM, DM, scr, r, lane); continue; } r -= I_IN;
            if (r < I_O) { if (l >= WO_F8_FROM) p0_transpose_item_f8<true>(args.in[13] + (size_t)l * DM * DM, DM, DM, DM / 32, (unsigned char*)(ws + WS_WO + l * SZ_WO), 64.f, args.in[6] + l * 2048, args.in[12] + l * 2048, 2048, scr, r, lane);
                else p0_transpose_item<0, true>(args.in[13] + (size_t)l * DM * DM, DM, DM, DM / 32, (bf16*)(ws + WS_WO + l * SZ_WO), args.in[6] + l * 2048, args.in[12] + l * 2048, 2048, scr, r, lane); continue; } r -= I_O;
            if (r < I_UP) { p0_transpose_item_f8<true>(args.in[15] + (size_t)l * DM * FF, DM, FF, FF / 32, (unsigned char*)(ws + WS_WUP + l * SZ_WUP), WUP8_SCALE, args.in[14] + l * DM, args.in[14] + l * DM, DM, scr, r, lane); continue; } r -= I_UP;
            p0_transpose_item_f8<false>(args.in[16] + (size_t)l * FF * DM, FF, DM, DM / 32, (unsigned char*)(ws + WS_WDN + l * SZ_WDN), 128.f, args.in[16], args.in[16], 0, scr, r, lane);
        }
        for (int it = gw; it < DEPTH * 2 * (256 + 8); it += NGW) { const int lk = it / 264, r = it % 264, kvv = lk & 1;
            const float* w1 = args.in[4] + (size_t)lk * 4096 * 128; const float* w2 = args.in[5] + (size_t)lk * 128 * 128;
            bf16* w1t = (bf16*)(ws + WS_W1T) + (size_t)lk * 128 * 4096; bf16* w2t = (bf16*)(ws + WS_W2T) + (size_t)lk * 128 * 128;
            if (r < 256) { if (kvv == 0) p0_transpose_item<0, false, true>(w1, 4096, 128, 4, w1t, w1, w1, 0, scr, r, lane); else p0_transpose_item<0, false, false>(w1, 4096, 128, 4, w1t, w1, w1, 0, scr, r, lane); }
            else { if (kvv == 0) p0_transpose_item<2, false, false>(w2, 128, 128, 4, w2t, w2, w2, 0, scr, r - 256, lane); else p0_transpose_item<0, false, false>(w2, 128, 128, 4, w2t, w2, w2, 0, scr, r - 256, lane); } }
        for (int e = gt; e < DEPTH * 2 * 16 * 128; e += NGT) { const int n = e & 127, kc = (e >> 7) & 15, lk = e >> 11;
            const float* w1 = args.in[4] + ((size_t)lk * 4096 + kc * 256) * 128 + n; const float* ps = args.in[3] + (size_t)lk * 4096 + kc * 256; float a = 0.f;
#pragma unroll 32
            for (int k = 0; k < 256; ++k) a += ps[k] * w1[(size_t)k * 128];
            ((float*)(ws + WS_B1P))[e] = a; }
        for (int e = gt; e < S * 64; e += NGT) { const int t = e >> 6, i = e & 63;
            const float inv = 1.0f / powf(10000.0f, (float)i * (1.0f / 64.0f)); const float ang = (float)t * inv;
            COS[e] = cosf(ang); SIN[e] = sinf(ang); }
        if (F.G == 256) { rms2f_to_bf16(x_in, XN, gw, NGW, lane); rms2f_to_bf16(x_in, XN, gw + 2 * NGW, NGW, lane); }
        else for (int m = gw; m < S; m += NGW) rms_row_to_bf16(x_in + (size_t)m * DM, XN + (size_t)m * DM, lane);
    }
    GRID_BAR();

    for (int L = 0; L < DEPTH; ++L) {
        { unsigned long long wz = 0; asm volatile("" : "+s"(wz)); ws = args.ws + wz; }
        bf16* Hres = (bf16*)(ws + WS_H);     static_assert(DEPTH == 2 && WO_F8_FROM == 1 && PROJ_F8_FROM == 1, "the phase instantiations below are written for this precision plan");
        bf16* XN = (bf16*)(ws + WS_XN); bf16* PROJ = (bf16*)(ws + WS_PROJ); bf16* ACT = (bf16*)(ws + WS_ACT); unsigned char* CAT = (unsigned char*)(ws + WS_CAT);     const bool wo_f8 = L >= WO_F8_FROM;
        float* ATT = (float*)(ws + WS_ATT); bf16* XBC = (bf16*)(ws + WS_XBC); bf16* Y = (bf16*)(ws + WS_Y);
        bf16* KC = (bf16*)(ws + WS_KC); bf16* VC = (bf16*)(ws + WS_VC); float* DT = (float*)(ws + WS_DT); float* ADT = (float*)(ws + WS_ADT);
        float* COS = (float*)(ws + WS_COS); float* SIN = (float*)(ws + WS_SIN); unsigned* BMP = (unsigned*)(ws + WS_BMP);
        bf16* AO = (bf16*)(ws + WS_ACT);     float* STT = (float*)(ws + WS_ST); bf16* PREVB = (bf16*)(ws + WS_PREV);     float* ACSG = (float*)(ws + WS_ACSG); float* DEC = (float*)(ws + WS_DEC);

        {
            const bool split = (L < PROJ_F8_FROM) && (F.G == 256);
            if (L >= PROJ_F8_FROM) { pg8::StaticOrder So; So.init(S, NPROJ, F.G, (int)blockIdx.x); pg8::Gemm g{XN, (const bf16*)(ws + WS_WIN + L * SZ_WIN), S, NPROJ, DM / 2};
                pg8::EpiProj E{PROJ, NPROJ, COS, SIN, QSCALE, 1.f / (XN8_SCALE * WUP8_SCALE), 0};
                pg8::gemm_phase<pg8::EpiProj, pg8::StaticOrder, true, true, true>(F.lds + RING_OFF, g, So, E); }
            else {
#pragma unroll 1
                for (int part = 0; part < (split ? 2 : 1); ++part) { const int c0p = part ? P1_SPLIT : 0, ncp = split ? (part ? NPROJ - P1_SPLIT : P1_SPLIT) : NPROJ;
                    pg8::StaticOrder So; So.init(S, ncp, F.G, (int)blockIdx.x); pg8::Gemm g{XN, (const bf16*)(ws + WS_WIN + L * SZ_WIN) + (size_t)c0p * DM, S, ncp, DM};
                    pg8::EpiProj E{PROJ, NPROJ, COS, SIN, QSCALE, 1.f, c0p / 256};
                    pg8::gemm_phase<pg8::EpiProj, pg8::StaticOrder, true, true>(F.lds + RING_OFF, g, So, E);
                    if (split && part == 0) GRID_BAR(); } }
        }
        {
            const bool split = (L < PROJ_F8_FROM) && (F.G == 256); const int bxp = bx_l(); const bool early = split && bxp >= (NPROJ - P1_SPLIT) / 256 * 32;
            const int ew = ((F.vcu >> 5) * 12 + ((F.vcu & 31) - 20));
#pragma unroll 1
            for (int pass = 0; pass < 2; ++pass) {
                const bool run = pass == 0 ? early : !split;
                if (run) {
                    PHASE_IDS();
#pragma unroll 1
                    for (int pv = (pass == 0 ? ew : F.vcu); pv < (pass == 0 ? 256 : F.vcu + 1); pv += 96) {
                        asm volatile("s_waitcnt vmcnt(0) lgkmcnt(0)" ::: "memory"); __syncthreads();
            for (int rep = 0; rep < REP_CMP; ++rep)
            for (int u = pv; u < 2 * NKV * 16; u += F.G) { const int kvv = u >> 6, g = (u >> 4) & 3, ib = u & 15; const int lk = L * 2 + kvv;
                cmp_unit(F.lds + RING_OFF, kvv, g, ib, PROJ, (const bf16*)(ws + WS_W1T) + (size_t)lk * 128 * 4096, (const bf16*)(ws + WS_W2T) + (size_t)lk * 128 * 128,
                         (const float*)(ws + WS_B1P) + (size_t)lk * 16 * 128, (kvv == 0 ? KC : VC) + (size_t)g * 512 * 128, tid); }
            { const float* cvw = args.in[7] + (size_t)L * 4 * CONVD; const float* cvb = args.in[8] + (size_t)L * CONVD; const int c0 = 8 * tid;
              float wv[4][8], bv[8];
#pragma unroll
              for (int j = 0; j < 8; ++j) bv[j] = cvb[c0 + j];
#pragma unroll
              for (int k = 0; k < 4; ++k)
#pragma unroll
                  for (int j = 0; j < 8; ++j) wv[k][j] = cvw[k * CONVD + c0 + j];
              const bool cv_w = (F.G == 256); const int nblk = cv_w ? (pv < 128 ? 1 : 7) : 1, blk0 = cv_w ? (pv < 128 ? pv : 128 + 7 * (pv - 128)) : pv, bstep = cv_w ? 1 : F.G, bend = cv_w ? blk0 + nblk : S / 8;
              for (int rep = 0; rep < REP_CONV; ++rep)
              for (int blk = blk0; blk < bend; blk += bstep) { const int t0 = 8 * blk;
                v4u rw[11];
#pragma unroll
                for (int i = 0; i < 11; ++i) { const int tt = t0 - 3 + i; rw[i] = tt >= 0 ? *(const GAS v4u*)(PROJ + (size_t)tt * NPROJ + OFF_XBC + c0) : (v4u){0u, 0u, 0u, 0u}; }
#pragma unroll
                for (int o8 = 0; o8 < 8; ++o8) { float a[8];
#pragma unroll
                    for (int j = 0; j < 8; ++j) a[j] = bv[j];
#pragma unroll
                    for (int k = 0; k < 4; ++k) { const v4u w = rw[o8 + k];
                        const float f[8] = {bflo(w.x), bfhi(w.x), bflo(w.y), bfhi(w.y), bflo(w.z), bfhi(w.z), bflo(w.w), bfhi(w.w)};
#pragma unroll
                        for (int j = 0; j < 8; ++j) a[j] += f[j] * wv[k][j]; }
#pragma unroll
                    for (int j = 0; j < 8; ++j) a[j] = a[j] / (1.f + __expf(-a[j]));
                    v4u o; o.x = pk2(a[0], a[1]); o.y = pk2(a[2], a[3]); o.z = pk2(a[4], a[5]); o.w = pk2(a[6], a[7]);
                    *(GAS v4u*)(XBC + (size_t)(t0 + o8) * CONVD + c0) = o; } } }
                    }
                }
                if (pass == 0) { GRID_BAR(); for (int rb = 0; rb < REP_BAR; ++rb) GRID_BAR(); }
            }
        }
        if (!((L < PROJ_F8_FROM) && (F.G == 256))) GRID_BAR();
        {
            PHASE_IDS();
            for (int rep = 0; rep < REP_ATTN; ++rep)
            for (int u = F.vcu; u < 256; u += F.G) { const int g = u & 3, tbp = u >> 2;
#pragma unroll 1
                for (int uu = 0; uu < 2; ++uu) attn_unit(F.lds + RING_OFF, g, uu ? tbp : 127 - tbp, PROJ, KC, VC, AO, tid); }
        }
        __syncthreads();
        {
            PHASE_IDS();
            for (int rep = 0; rep < REP_SSD; ++rep)
            for (int u = F.vcu; u < NCHUNK * SSM_G; u += F.G) ssd1_unit(F.lds + RING_OFF, u >> 3, u & 7, XBC, PROJ, args.in[9] + L * 32, args.in[10] + L * 32, Y, STT, DEC, ACSG, tid);
        }
        GRID_BAR();
        {
            PHASE_IDS();
            for (int rep = 0; rep < REP_AN; ++rep)
            for (int t = gw; t < S; t += NGW) {
                f32x4 v[8]; float s = 0.f;
#pragma unroll
                for (int j = 0; j < 8; ++j) { const int hd = 2 * j + (lane >> 5); const bf16* gp = PROJ + (size_t)t * NPROJ + OFF_G + hd;
                    const float g0 = 1.f / (1.f + __expf(-bf2f(gp[0]))), g1 = 1.f / (1.f + __expf(-bf2f(gp[16]))), g2 = 1.f / (1.f + __expf(-bf2f(gp[32])));
                    const size_t off = (size_t)t * 2048 + 256 * j + 4 * lane;
                    const unsigned long long u0 = *(const GAS unsigned long long*)(AO + off), u1 = *(const GAS unsigned long long*)(AO + (size_t)S * 2048 + off), u2 = *(const GAS unsigned long long*)(AO + (size_t)2 * S * 2048 + off);
                    const f32x4 a0 = {bflo((unsigned)u0), bfhi((unsigned)u0), bflo((unsigned)(u0 >> 32)), bfhi((unsigned)(u0 >> 32))}, a1 = {bflo((unsigned)u1), bfhi((unsigned)u1), bflo((unsigned)(u1 >> 32)), bfhi((unsigned)(u1 >> 32))},
                                a2 = {bflo((unsigned)u2), bfhi((unsigned)u2), bflo((unsigned)(u2 >> 32)), bfhi((unsigned)(u2 >> 32))};
                    v[j] = a0 * g0 + a1 * g1 + a2 * g2; s += (v[j].x * v[j].x + v[j].y * v[j].y) + (v[j].z * v[j].z + v[j].w * v[j].w); }
                const float rstd = 1.f / sqrtf(wave_sum(s) * (1.f / 2048.f) + EPS);
                if (wo_f8) { GAS unsigned* o4 = (GAS unsigned*)(CAT + (size_t)t * DM) + lane;
#pragma unroll
                    for (int j = 0; j < 8; ++j) o4[64 * j] = pg8::pk4_fp8(v[j].x * rstd, v[j].y * rstd, v[j].z * rstd, v[j].w * rstd); }
                else { GAS unsigned long long* o8 = (GAS unsigned long long*)((bf16*)CAT + (size_t)t * DM) + lane;
#pragma unroll
                    for (int j = 0; j < 8; ++j) o8[64 * j] = (unsigned long long)pk2(v[j].x * rstd, v[j].y * rstd) | ((unsigned long long)pk2(v[j].z * rstd, v[j].w * rstd) << 32); }
            }
            for (int rep = 0; rep < REP_SCAN; ++rep)
            for (int e = gt; e < SSM_H * SSM_P * SSM_N; e += NGT) { const int h = e >> 13; float st = 0.f; float sv[NCHUNK], dv[NCHUNK];
#pragma unroll
                for (int c = 0; c < NCHUNK; ++c) { sv[c] = STT[(size_t)c * (SSM_H * SSM_P * SSM_N) + e]; dv[c] = DEC[c * 32 + h]; }
#pragma unroll
                for (int c = 0; c < NCHUNK; ++c) { PREVB[(size_t)c * (SSM_H * SSM_P * SSM_N) + e] = (bf16)f2bf(st); st = dv[c] * st + sv[c]; } }
        }
        GRID_BAR();
        {
            PHASE_IDS();
            const float* dsk = args.in[11] + L * 32;
            for (int rep = 0; rep < REP_SSD3; ++rep)
            for (int u = F.vcu; u < NCHUNK * SSM_G; u += F.G) ssd3_unit(F.lds + RING_OFF, u >> 3, u & 7, XBC, PROJ, Y, (bf16*)ATT, PREVB, ACSG, dsk, CAT, wo_f8, tid);
        }
        GRID_BAR();
        {
            pg8::StaticOrder So; So.init(S, DM, F.G, (int)blockIdx.x);
            if (wo_f8) { pg8::Gemm g{(const bf16*)CAT, (const bf16*)(ws + WS_WO + L * SZ_WO), S, DM, DM / 2};
                pg8::EpiResidH<false> E{Hres, (pg8::bf16_t*)Hres, DM, 1.f / 64.f};
                pg8::gemm_phase<pg8::EpiResidH<false>, pg8::StaticOrder, true, true, true>(F.lds + RING_OFF, g, So, E); }
            else { pg8::Gemm g{(const bf16*)CAT, (const bf16*)(ws + WS_WO + L * SZ_WO), S, DM, DM};
                pg8::EpiResidH<true> E{x_in, (pg8::bf16_t*)Hres, DM, 1.f};
                pg8::gemm_phase<pg8::EpiResidH<true>, pg8::StaticOrder, true, true>(F.lds + RING_OFF, g, So, E); }
        }
        GRID_BAR();
        { PHASE_IDS(); if (F.G == 256) rms4h_to_fp8(Hres, (unsigned char*)XN, gw, NGW, lane); else for (int m = gw; m < S; m += NGW) rms_rowh_to_fp8(Hres + (size_t)m * DM, (unsigned char*)XN + (size_t)m * DM, lane); }
        GRID_BAR();
        {
            pg8::Gemm g{XN, (const bf16*)(ws + WS_WUP + L * SZ_WUP), S, FF, DM / 2}; pg8::StaticOrder So; So.init(S, FF, F.G, (int)blockIdx.x);
            pg8::EpiRelu2F8 E{(unsigned char*)ACT, FF, 1.f / (XN8_SCALE * WUP8_SCALE)};
            for (int rep = 0; rep < REP_UP; ++rep)
            pg8::gemm_phase<pg8::EpiRelu2F8, pg8::StaticOrder, true, true, true>(F.lds + RING_OFF, g, So, E);
        }
        GRID_BAR();
        {
            pg8::Gemm g{ACT, (const bf16*)(ws + WS_WDN + L * SZ_WDN), S, DM, FF / 2}; pg8::StaticOrder So; So.init(S, DM, F.G, (int)blockIdx.x);
            pg8::EpiResidH<false> E{Hres, (pg8::bf16_t*)Hres, DM, 1.f / 128.f};
            pg8::gemm_phase<pg8::EpiResidH<false>, pg8::StaticOrder, true, true, true>(F.lds + RING_OFF, g, So, E);
        }
        GRID_BAR();
        if (L + 1 < DEPTH) { PHASE_IDS(); if (F.G == 256) rms4h_to_fp8(Hres, (unsigned char*)XN, gw, NGW, lane); else for (int m = gw; m < S; m += NGW) rms_rowh_to_fp8(Hres + (size_t)m * DM, (unsigned char*)XN + (size_t)m * DM, lane); GRID_BAR(); }
        else {
            PHASE_IDS();
            const float* nf = args.in[17];
            if (F.G == 256) { final2h(Hres, args.out, nf, gw, NGW, lane); final2h(Hres, args.out, nf, gw + 2 * NGW, NGW, lane); }
            else
            for (int m = gw; m < S; m += NGW) {
                const GAS v4u* xr = (const GAS v4u*)(Hres + (size_t)m * DM) + lane; v4u v[8]; float s = 0.f;
#pragma unroll
                for (int j = 0; j < 8; ++j) { v[j] = xr[64 * j]; const float a0 = bflo(v[j].x), a1 = bfhi(v[j].x), a2 = bflo(v[j].y), a3 = bfhi(v[j].y), a4 = bflo(v[j].z), a5 = bfhi(v[j].z), a6 = bflo(v[j].w), a7 = bfhi(v[j].w);
                    s += ((a0 * a0 + a1 * a1) + (a2 * a2 + a3 * a3)) + ((a4 * a4 + a5 * a5) + (a6 * a6 + a7 * a7)); }
                const float rstd = 1.f / sqrtf(wave_sum(s) * (1.f / DM) + EPS);
                GAS f32x4* o4 = (GAS f32x4*)(args.out + (size_t)m * DM) + 2 * lane; const GAS f32x4* w4 = (const GAS f32x4*)nf + 2 * lane;
#pragma unroll
                for (int j = 0; j < 8; ++j) { const f32x4 g0 = w4[128 * j], g1 = w4[128 * j + 1];
                    o4[128 * j] = (f32x4){bflo(v[j].x), bfhi(v[j].x), bflo(v[j].y), bfhi(v[j].y)} * rstd * g0; o4[128 * j + 1] = (f32x4){bflo(v[j].z), bfhi(v[j].z), bflo(v[j].w), bfhi(v[j].w)} * rstd * g1; }
            }
        }
    }
}

extern "C" void kernel_launch(void* const* d_in, const int* in_sizes, int n_in, void* d_out, int out_size, void* d_ws, size_t ws_size, hipStream_t stream) {
    static int grid = 0;
    if (grid == 0) {
        if (n_in != 18 || in_sizes[0] != S * DM || out_size != S * DM || ws_size < WS_END) { fprintf(stderr, "kernel_launch: shape/workspace mismatch: n_in %d in0 %d out %d ws %zu (need %zu)\n", n_in, n_in > 0 ? in_sizes[0] : -1, out_size, ws_size, (size_t)WS_END); grid = -1; return; }
        int dev = 0, cus = 0, per_cu = 0;
        if (hipGetDevice(&dev) != hipSuccess || hipDeviceGetAttribute(&cus, hipDeviceAttributeMultiprocessorCount, dev) != hipSuccess) { grid = -1; return; }
        if (hipFuncSetAttribute((const void*)hybrid_fwd, hipFuncAttributeMaxDynamicSharedMemorySize, LDS_BYTES) != hipSuccess) { fprintf(stderr, "kernel_launch: hipFuncSetAttribute failed\n"); grid = -1; return; }
        if (hipOccupancyMaxActiveBlocksPerMultiprocessor(&per_cu, (const void*)hybrid_fwd, NWAVES * 64, LDS_BYTES) != hipSuccess || per_cu < 1) fprintf(stderr, "kernel_launch: occupancy query reports %d\n", per_cu);
        (void)hipGetLastError();
        grid = cus;
    }
    if (grid < 0) return;
    if (hipMemsetAsync((char*)d_ws + WS_CTL, 0, CTL_ZERO_BYTES, stream) != hipSuccess) return;
    Args a{};
    for (int i = 0; i < 18; ++i) a.in[i] = (const float*)d_in[i];
    a.out = (float*)d_out; a.ws = (unsigned char*)d_ws;
    hipLaunchKernelGGL(hybrid_fwd, dim3(grid), dim3(NWAVES * 64), LDS_BYTES, stream, a);
}
```

```cpp
#include <hip/hip_runtime.h>
#include <cstdio>
#include <cstdint>
#include <cmath>
#ifndef REP_ATTN
#define REP_ATTN 1
#endif
#ifndef REP_UP
#define REP_UP 1
#endif
#ifndef REP_CMP
#define REP_CMP 1
#endif
#ifndef REP_PRO
#define REP_PRO 1
#endif
#ifndef REP_SSD
#define REP_SSD 1
#endif
#ifndef REP_LIGHT
#define REP_LIGHT 1
#endif
#ifndef REP_RMS
#define REP_RMS 1
#endif
#ifndef REP_CONV
#define REP_CONV 1
#endif
#ifndef REP_AN
#define REP_AN 1
#endif
#ifndef REP_SCAN
#define REP_SCAN 1
#endif
#ifndef REP_PROJ
#define REP_PROJ 1
#endif
#ifndef REP_BAR
#define REP_BAR 0
#endif
#ifndef REP_FIN
#define REP_FIN 1
#endif
#ifndef REP_SSD3
#define REP_SSD3 1
#endif
namespace pg8 {
#define PG8_LAS __attribute__((address_space(3)))
typedef unsigned short bf16_t;
typedef short bf16x8 __attribute__((ext_vector_type(8)));
typedef float f32x4 __attribute__((ext_vector_type(4)));
typedef unsigned u32x4 __attribute__((ext_vector_type(4)));
typedef int i32x4 __attribute__((ext_vector_type(4)));
typedef int i32x8 __attribute__((ext_vector_type(8)));
constexpr int BM = 256, BK = 64, HALF = 128, HTB = HALF * BK * 2  , STAGE_BYTES = 8 * HTB, NXCD = 8, WGM = 8;

__host__ __device__ __forceinline__ int lds_byte(int r, int c) { const int st = (r >> 4) * 2 + (c >> 5), rr = r & 15, cc = c & 31, ob = rr * 64 + cc * 2; return st * 1024 + (ob ^ (((ob >> 9) & 1) << 5)); }
__host__ __device__ __forceinline__ void stage_rc(int b, int& R, int& C) { const int st = b / 1024, sb = b % 1024, swz = sb ^ (((sb >> 9) & 1) << 5); R = (st >> 1) * 16 + swz / 64; C = (st & 1) * 32 + (swz % 64) / 2; }
__host__ __device__ __forceinline__ int perm32(int rho) { const int n = rho >> 4, i = rho & 15; return 8 * (i >> 2) + 4 * n + (i & 3); }

struct Unit { int pm, pn; };
struct Gemm { const bf16_t* A; const bf16_t* Bt; int M, N, K; };

struct StaticOrder {
    int nM, nN, nwg, G, c;
    __host__ __device__ void init(int M, int N, int G_, int c_) { nM = M / BM; nN = N / BM; nwg = nM * nN; G = G_; c = c_; }
    __host__ __device__ bool next(int i, Unit& u) const {
        const long L = (long)i * G + c; if (L >= nwg) return false;
        int wgid = (int)L; { const int q = nwg / NXCD, r = nwg % NXCD, xcd = wgid % NXCD, off = wgid / NXCD; wgid = (xcd < r ? xcd * (q + 1) : r * (q + 1) + (xcd - r) * q) + off; }
        const int nig = WGM * nN, gid = wgid / nig, fm = gid * WGM, gsz = (nM - fm) < WGM ? (nM - fm) : WGM;
        u.pm = fm + ((wgid % nig) % gsz); u.pn = (wgid % nig) / gsz; return true;
    }
    __device__ __forceinline__ void a_ready(const Unit&) const {}
    __device__ __forceinline__ void done(const Unit&) const {}
};

__device__ __forceinline__ unsigned cvt_pk_bf16(float lo, float hi) { unsigned r; asm volatile("v_cvt_pk_bf16_f32 %0, %1, %2" : "=v"(r) : "v"(lo), "v"(hi)); return r; }
typedef float f32x2 __attribute__((ext_vector_type(2)));
struct EpiProj {
    static constexpr bool PERM = true, AFTER_DRAIN = false;
    bf16_t* O; int ldc; const float* cosT; const float* sinT; float qscale; float osc; int pn0;
    template <bool ROPE>
    __device__ __forceinline__ void body(const f32x4 (&acc)[2][2][4][2], int row0, int colt, int cw, float sc) const {
        f32x4 ca[8], sa[8];
#define EPIPROJ_LD(g) do { const int row_ = row0 + ((g) >> 2) * HALF + ((g) & 3) * 16; ca[g] = *(const f32x4*)(cosT + (size_t)row_ * 64 + (cw >> 1)); sa[g] = *(const f32x4*)(sinT + (size_t)row_ * 64 + (cw >> 1)); } while (0)
        if (ROPE) { EPIPROJ_LD(0); EPIPROJ_LD(1); EPIPROJ_LD(2); EPIPROJ_LD(3); asm volatile("" ::: "memory"); }
#pragma unroll
        for (int g = 0; g < 8; ++g) { const int ai = g >> 2, m = g & 3; const int row = row0 + ai * HALF + m * 16;
            if (ROPE && g == 2) { asm volatile("" ::: "memory"); EPIPROJ_LD(4); EPIPROJ_LD(5); EPIPROJ_LD(6); EPIPROJ_LD(7); asm volatile("" ::: "memory"); }
#pragma unroll
            for (int bj = 0; bj < 2; ++bj) {
                f32x4 v0 = acc[ai][bj][m][0], v1 = acc[ai][bj][m][1];
                if (ROPE) { const f32x4 cc = ca[g], ss = sa[g]; f32x4 r0, r1;
                    r0[0] = v0[0] * cc[0] - v0[1] * ss[0]; r0[1] = v0[1] * cc[0] + v0[0] * ss[0];
                    r0[2] = v0[2] * cc[1] - v0[3] * ss[1]; r0[3] = v0[3] * cc[1] + v0[2] * ss[1];
                    r1[0] = v1[0] * cc[2] - v1[1] * ss[2]; r1[1] = v1[1] * cc[2] + v1[0] * ss[2];
                    r1[2] = v1[2] * cc[3] - v1[3] * ss[3]; r1[3] = v1[3] * cc[3] + v1[2] * ss[3];
                    v0 = r0; v1 = r1; }
                v0 = v0 * sc; v1 = v1 * sc;
                u32x4 w; w.x = cvt_pk_bf16(v0[0], v0[1]); w.y = cvt_pk_bf16(v0[2], v0[3]); w.z = cvt_pk_bf16(v1[0], v1[1]); w.w = cvt_pk_bf16(v1[2], v1[3]);
                *(u32x4*)(O + (size_t)row * ldc + colt + bj * HALF + cw) = w; } }
#undef EPIPROJ_LD
    }
    __device__ __forceinline__ void operator()(const f32x4 (&acc)[2][2][4][2], const Unit& u, int wr, int wc, int fr, int fq) const {
        const int row0 = u.pm * BM + wr * 64 + fr; const int colt = (u.pn + pn0) * BM; const int cw = wc * 32 + 8 * fq;
        const int blk0 = 2 * (u.pn + pn0);
        const bool rope = blk0 < 16 || (blk0 < 40 && ((((blk0 - 16) >> 2) & 1) == 0)); const float sc = (blk0 < 16 ? qscale : 1.f) * osc;
        if (rope) body<true>(acc, row0, colt, cw, sc); else body<false>(acc, row0, colt, cw, sc);
    }
};
struct EpiResid {
    static constexpr bool PERM = false, AFTER_DRAIN = false;
    const float* base; float* out; int ldc; float scale;
    __device__ __forceinline__ void operator()(const f32x4 (&acc)[2][2][4][2], const Unit& u, int wr, int wc, int fr, int fq) const {
        const int row0 = u.pm * BM + wr * 64 + fr, col0 = u.pn * BM + wc * 32 + 4 * fq;
        f32x4 cur[2][2], nxt[2][2];
        { const size_t off = (size_t)row0 * ldc + col0;
#pragma unroll
          for (int bj = 0; bj < 2; ++bj)
#pragma unroll
              for (int n = 0; n < 2; ++n) cur[bj][n] = *(const f32x4*)(base + off + bj * HALF + n * 16); }
#pragma unroll
        for (int gi = 0; gi < 8; ++gi) { const int ai = gi >> 2, m = gi & 3; const size_t off = (size_t)(row0 + ai * HALF + m * 16) * ldc + col0;
            if (gi < 7) { const int ai2 = (gi + 1) >> 2, m2 = (gi + 1) & 3; const size_t off2 = (size_t)(row0 + ai2 * HALF + m2 * 16) * ldc + col0;
#pragma unroll
                for (int bj = 0; bj < 2; ++bj)
#pragma unroll
                    for (int n = 0; n < 2; ++n) nxt[bj][n] = *(const f32x4*)(base + off2 + bj * HALF + n * 16); }
            asm volatile("" ::: "memory");
#pragma unroll
            for (int bj = 0; bj < 2; ++bj)
#pragma unroll
                for (int n = 0; n < 2; ++n) *(f32x4*)(out + off + bj * HALF + n * 16) = cur[bj][n] + acc[ai][bj][m][n] * scale;
            asm volatile("" ::: "memory");
#pragma unroll
            for (int bj = 0; bj < 2; ++bj)
#pragma unroll
                for (int n = 0; n < 2; ++n) cur[bj][n] = nxt[bj][n]; }
    }
};

template <bool BASE_F32>
struct EpiResidH {
    static constexpr bool PERM = true, AFTER_DRAIN = false;
    const void* base; bf16_t* out; int ldc; float scale;
    __device__ __forceinline__ void ld(f32x4 (&d)[2][2], size_t off) const {
#pragma unroll
        for (int bj = 0; bj < 2; ++bj) {
            if (BASE_F32) { const float* b = (const float*)base + off + bj * HALF; d[bj][0] = *(const f32x4*)b; d[bj][1] = *(const f32x4*)(b + 4); }
            else { const u32x4 w = *(const u32x4*)((const bf16_t*)base + off + bj * HALF);
                d[bj][0] = (f32x4){__uint_as_float(w.x << 16), __uint_as_float(w.x & 0xffff0000u), __uint_as_float(w.y << 16), __uint_as_float(w.y & 0xffff0000u)};
                d[bj][1] = (f32x4){__uint_as_float(w.z << 16), __uint_as_float(w.z & 0xffff0000u), __uint_as_float(w.w << 16), __uint_as_float(w.w & 0xffff0000u)}; } }
    }
    __device__ __forceinline__ void operator()(const f32x4 (&acc)[2][2][4][2], const Unit& u, int wr, int wc, int fr, int fq) const {
        const int row0 = u.pm * BM + wr * 64 + fr, col0 = u.pn * BM + wc * 32 + 8 * fq;
        f32x4 cur[2][2], nxt[2][2];
        ld(cur, (size_t)row0 * ldc + col0);
#pragma unroll
        for (int gi = 0; gi < 8; ++gi) { const int ai = gi >> 2, m = gi & 3; const size_t off = (size_t)(row0 + ai * HALF + m * 16) * ldc + col0;
            if (gi < 7) { const int ai2 = (gi + 1) >> 2, m2 = (gi + 1) & 3; ld(nxt, (size_t)(row0 + ai2 * HALF + m2 * 16) * ldc + col0); }
            asm volatile("" ::: "memory");
#pragma unroll
            for (int bj = 0; bj < 2; ++bj) { const f32x4 v0 = cur[bj][0] + acc[ai][bj][m][0] * scale, v1 = cur[bj][1] + acc[ai][bj][m][1] * scale;
                u32x4 w; w.x = cvt_pk_bf16(v0[0], v0[1]); w.y = cvt_pk_bf16(v0[2], v0[3]); w.z = cvt_pk_bf16(v1[0], v1[1]); w.w = cvt_pk_bf16(v1[2], v1[3]);
                *(u32x4*)(out + off + bj * HALF) = w; }
            asm volatile("" ::: "memory");
#pragma unroll
            for (int bj = 0; bj < 2; ++bj) { cur[bj][0] = nxt[bj][0]; cur[bj][1] = nxt[bj][1]; } }
    }
};
struct EpiRelu2 {
    static constexpr bool PERM = true, AFTER_DRAIN = false;
    bf16_t* O; int ldc;
    __device__ __forceinline__ void operator()(const f32x4 (&acc)[2][2][4][2], const Unit& u, int wr, int wc, int fr, int fq) const {
        const int row0 = u.pm * BM + wr * 64 + fr; const int col0 = u.pn * BM + wc * 32 + 8 * fq;
#pragma unroll
        for (int ai = 0; ai < 2; ++ai)
#pragma unroll
            for (int m = 0; m < 4; ++m) { bf16_t* rowp = O + (size_t)(row0 + ai * HALF + m * 16) * ldc + col0;
#pragma unroll
                for (int bj = 0; bj < 2; ++bj) { f32x4 v0 = acc[ai][bj][m][0], v1 = acc[ai][bj][m][1];
#pragma unroll
                    for (int e = 0; e < 4; ++e) { const float a = fmaxf(v0[e], 0.f), b = fmaxf(v1[e], 0.f); v0[e] = a * a; v1[e] = b * b; }
                    u32x4 w; w.x = cvt_pk_bf16(v0[0], v0[1]); w.y = cvt_pk_bf16(v0[2], v0[3]); w.z = cvt_pk_bf16(v1[0], v1[1]); w.w = cvt_pk_bf16(v1[2], v1[3]);
                    *(u32x4*)(rowp + bj * HALF) = w; } }
    }
};

__device__ __forceinline__ unsigned pk4_fp8(float a, float b, float c, float d) {
    a = fminf(fmaxf(a, -448.f), 448.f); b = fminf(fmaxf(b, -448.f), 448.f); c = fminf(fmaxf(c, -448.f), 448.f); d = fminf(fmaxf(d, -448.f), 448.f);
    int w = __builtin_amdgcn_cvt_pk_fp8_f32(a, b, 0, false); w = __builtin_amdgcn_cvt_pk_fp8_f32(c, d, w, true); return (unsigned)w; }
struct EpiRelu2F8 {
    static constexpr bool PERM = true, AFTER_DRAIN = false;
    unsigned char* O; int ldc; float sc;
    __device__ __forceinline__ void operator()(const f32x4 (&acc)[2][2][4][2], const Unit& u, int wr, int wc, int fr, int fq) const {
        const int row0 = u.pm * BM + wr * 64 + fr; const int col0 = u.pn * BM + wc * 32 + 8 * fq;
        const int odd = fq & 1;
#pragma unroll
        for (int ai = 0; ai < 2; ++ai)
#pragma unroll
            for (int bj = 0; bj < 2; ++bj) { unsigned lo[4], hi[4];
#pragma unroll
                for (int m = 0; m < 4; ++m) { f32x4 v0 = acc[ai][bj][m][0], v1 = acc[ai][bj][m][1];
#pragma unroll
                    for (int e = 0; e < 4; ++e) { const float a = fmaxf(v0[e] * sc, 0.f), b = fmaxf(v1[e] * sc, 0.f); v0[e] = a * a; v1[e] = b * b; }
                    lo[m] = pk4_fp8(v0[0], v0[1], v0[2], v0[3]); hi[m] = pk4_fp8(v1[0], v1[1], v1[2], v1[3]); }
#pragma unroll
                for (int mp = 0; mp < 4; mp += 2) {
                    auto rl = __builtin_amdgcn_permlane16_swap(lo[mp], lo[mp + 1], false, false); auto rh = __builtin_amdgcn_permlane16_swap(hi[mp], hi[mp + 1], false, false);
                    u32x4 w; w.x = rl[0]; w.y = rh[0]; w.z = rl[1]; w.w = rh[1];
                    *(u32x4*)(O + (size_t)(row0 + ai * HALF + (mp + odd) * 16) * ldc + col0 + bj * HALF - 8 * odd) = w; } }
    }
};
template <class Epi, class Sched, bool ALIGN_EPI = false, bool SP2 = false, bool F8 = false>
__device__ __forceinline__ void gemm_phase(PG8_LAS unsigned char* lds, const Gemm g, const Sched& S, const Epi& E) {
    int tid_o = threadIdx.x; asm volatile("" : "+v"(tid_o));
    const int tid = tid_o, wid = __builtin_amdgcn_readfirstlane(tid >> 6), lane = tid & 63, wr = wid >> 2, wc = wid & 3, fr = lane & 15, fq = lane >> 4;
    const int K = g.K, nt = K / BK;
    unsigned voffA[2], voffB[2];
#pragma unroll
    for (int i = 0; i < 2; ++i) { int R, C; stage_rc(tid * 16 + i * 8192, R, C); const int Rb = Epi::PERM ? ((R & ~31) + perm32(R & 31)) : R;
        voffA[i] = (unsigned)(R * K + C) * 2u; voffB[i] = (unsigned)(Rb * K + C) * 2u; }
    const size_t kstep = (size_t)(BK * 2);
    const size_t hstep = (size_t)HALF * K * 2;
    const size_t tstep = 2 * hstep;
    const unsigned ldsw = (unsigned)wid * 1024u;
    const int aoff = lds_byte(wr * 64 + fr, fq * 8), boff = lds_byte(wc * 32 + fr, fq * 8);
#define PG8_SA(b, h) (((b) * 2 + (h)) * HTB)
#define PG8_SB(b, h) ((4 + (b) * 2 + (h)) * HTB)
#define PG8_STAGE(bufoff, gbase, voff) do { _Pragma("unroll") for (int _i = 0; _i < 2; ++_i) \
        __builtin_amdgcn_global_load_lds((const unsigned*)((const char*)(gbase) + (voff)[_i]), (PG8_LAS unsigned*)(lds + (bufoff) + ldsw + _i * 8192), 16, 0, 0); } while (0)
#define PG8_LDA(dst, b, h) do { if constexpr (F8) { _Pragma("unroll") for (int m = 0; m < 4; ++m) { const i32x4 x0_ = *(const PG8_LAS i32x4*)(lds + PG8_SA(b, h) + aoff + m * 2048), x1_ = *(const PG8_LAS i32x4*)(lds + PG8_SA(b, h) + aoff + m * 2048 + 1024); \
        dst##8[m] = __builtin_shufflevector(x0_, x1_, 0, 1, 2, 3, 4, 5, 6, 7); } } else { _Pragma("unroll") for (int m = 0; m < 4; ++m) _Pragma("unroll") for (int k = 0; k < 2; ++k) dst[m][k] = *(const PG8_LAS bf16x8*)(lds + PG8_SA(b, h) + aoff + m * 2048 + k * 1024); } } while (0)
#define PG8_LDB(dst, b, h) do { if constexpr (F8) { _Pragma("unroll") for (int n = 0; n < 2; ++n) { const i32x4 x0_ = *(const PG8_LAS i32x4*)(lds + PG8_SB(b, h) + boff + n * 2048), x1_ = *(const PG8_LAS i32x4*)(lds + PG8_SB(b, h) + boff + n * 2048 + 1024); \
        dst##8[n] = __builtin_shufflevector(x0_, x1_, 0, 1, 2, 3, 4, 5, 6, 7); } } else { _Pragma("unroll") for (int n = 0; n < 2; ++n) _Pragma("unroll") for (int k = 0; k < 2; ++k) dst[n][k] = *(const PG8_LAS bf16x8*)(lds + PG8_SB(b, h) + boff + n * 2048 + k * 1024); } } while (0)
#define PG8_CAT(x0, x1) __builtin_shufflevector(__builtin_bit_cast(i32x4, x0), __builtin_bit_cast(i32x4, x1), 0, 1, 2, 3, 4, 5, 6, 7)
#define PG8_MMA(ai, bj, At, Bt) do { __builtin_amdgcn_s_setprio(1); if constexpr (F8) { _Pragma("unroll") for (int m = 0; m < 4; ++m) _Pragma("unroll") for (int n = 0; n < 2; ++n) \
        asm volatile("v_mfma_scale_f32_16x16x128_f8f6f4 %0, %1, %2, %0, %3, %3 op_sel_hi:[0,0,0]" : "+v"(acc[ai][bj][m][n]) : "v"(Bt##8[n]), "v"(At##8[m]), "v"(f8scale)); } else { \
        _Pragma("unroll") for (int m = 0; m < 4; ++m) _Pragma("unroll") for (int n = 0; n < 2; ++n) _Pragma("unroll") for (int k = 0; k < 2; ++k) \
        acc[ai][bj][m][n] = __builtin_amdgcn_mfma_f32_16x16x32_bf16(Bt[n][k], At[m][k], acc[ai][bj][m][n], 0, 0, 0); } __builtin_amdgcn_s_setprio(0); } while (0)
#define PG8_WAIT_V(n) asm volatile("s_waitcnt vmcnt(" #n ")" ::: "memory")
#define PG8_WAIT_L(n) asm volatile("s_waitcnt lgkmcnt(" #n ")" ::: "memory")
#define PG8_BAR __builtin_amdgcn_s_barrier()
#define PG8_SCHED __builtin_amdgcn_sched_barrier(0)
    Unit cur, nxt; int ui = 0;
    if (!S.next(0, cur)) return;
    f32x4 acc[2][2][4][2];
#pragma unroll
    for (int a = 0; a < 2; ++a)
#pragma unroll
        for (int b = 0; b < 2; ++b)
#pragma unroll
            for (int m = 0; m < 4; ++m)
#pragma unroll
                for (int n = 0; n < 2; ++n) acc[a][b][m][n] = (f32x4){0.f, 0.f, 0.f, 0.f};
    int f8scale = 0x7F7F7F7F; asm volatile("" : "+v"(f8scale));
    bf16x8 At[4][2], B0[2][2], B1[2][2]; i32x8 At8[4], B08[2], B18[2];
    const char* cA = (const char*)g.A + (size_t)cur.pm * tstep; const char* cB = (const char*)g.Bt + (size_t)cur.pn * tstep;
    S.a_ready(cur);
    if constexpr (SP2) {
        PG8_STAGE(PG8_SB(0, 0), cB, voffB); PG8_STAGE(PG8_SB(0, 1), cB + hstep, voffB); PG8_STAGE(PG8_SA(0, 0), cA, voffA); PG8_STAGE(PG8_SA(0, 1), cA + hstep, voffA);
        if (wr == 1) PG8_BAR;
        PG8_WAIT_V(2); PG8_BAR;
        PG8_STAGE(PG8_SB(1, 0), cB + kstep, voffB); PG8_STAGE(PG8_SA(1, 0), cA + kstep, voffA); PG8_STAGE(PG8_SB(1, 1), cB + hstep + kstep, voffB);
        PG8_WAIT_V(6); PG8_BAR;
    } else {
        PG8_STAGE(PG8_SB(0, 0), cB, voffB); PG8_STAGE(PG8_SA(0, 0), cA, voffA); PG8_STAGE(PG8_SB(0, 1), cB + hstep, voffB); PG8_STAGE(PG8_SA(0, 1), cA + hstep, voffA);
        if (wr == 1) PG8_BAR;
        PG8_WAIT_V(4); PG8_BAR;
        PG8_STAGE(PG8_SB(1, 0), cB + kstep, voffB); PG8_STAGE(PG8_SA(1, 0), cA + kstep, voffA); PG8_STAGE(PG8_SB(1, 1), cB + hstep + kstep, voffB);
        PG8_WAIT_V(6); PG8_BAR;
    }
    for (;;) {
        const bool has_next = S.next(ui + 1, nxt);
        const char* nA = has_next ? (const char*)g.A + (size_t)nxt.pm * tstep : cA; const char* nB = has_next ? (const char*)g.Bt + (size_t)nxt.pn * tstep : cB;
        for (int t = 0; t < nt; t += 2) {
            const bool last = (t == nt - 2);
            const char* a1 = cA + (size_t)(t + 1) * kstep;
            const char* a2 = last ? nA : cA + (size_t)(t + 2) * kstep; const char* b2 = last ? nB : cB + (size_t)(t + 2) * kstep;
            const char* a3 = a2 + kstep; const char* b3 = b2 + kstep;
            if (last && has_next) S.a_ready(nxt);
            if constexpr (SP2) {
            PG8_LDB(B0, 0, 0); PG8_LDB(B1, 0, 1); PG8_SCHED; PG8_LDA(At, 0, 0); PG8_STAGE(PG8_SA(1, 1), a1 + hstep, voffA);
            PG8_WAIT_V(8); PG8_WAIT_L(0); PG8_BAR; PG8_MMA(0, 0, At, B0); PG8_MMA(0, 1, At, B1); PG8_BAR; PG8_SCHED;
            PG8_LDA(At, 0, 1); PG8_STAGE(PG8_SB(0, 0), b2, voffB); PG8_STAGE(PG8_SB(0, 1), b2 + hstep, voffB); PG8_STAGE(PG8_SA(0, 0), a2, voffA);
            PG8_WAIT_V(8); PG8_WAIT_L(0); PG8_BAR; PG8_MMA(1, 0, At, B0); PG8_MMA(1, 1, At, B1); PG8_BAR; PG8_SCHED;
            PG8_LDB(B0, 1, 0); PG8_LDB(B1, 1, 1); PG8_SCHED; PG8_LDA(At, 1, 0); PG8_STAGE(PG8_SA(0, 1), a2 + hstep, voffA);
            PG8_WAIT_V(8); PG8_WAIT_L(0); PG8_BAR; PG8_MMA(0, 0, At, B0); PG8_MMA(0, 1, At, B1); PG8_BAR; PG8_SCHED;
            PG8_LDA(At, 1, 1); PG8_STAGE(PG8_SB(1, 0), b3, voffB); PG8_STAGE(PG8_SB(1, 1), b3 + hstep, voffB); PG8_STAGE(PG8_SA(1, 0), a3, voffA);
            PG8_WAIT_V(8); PG8_WAIT_L(0); PG8_BAR; PG8_MMA(1, 0, At, B0); PG8_MMA(1, 1, At, B1); PG8_BAR; PG8_SCHED;
            } else {
            PG8_LDB(B0, 0, 0); PG8_SCHED; PG8_LDA(At, 0, 0); PG8_STAGE(PG8_SA(1, 1), a1 + hstep, voffA);
            PG8_WAIT_L(8); PG8_BAR; PG8_WAIT_L(0); PG8_MMA(0, 0, At, B0); PG8_BAR; PG8_SCHED;
            PG8_LDB(B1, 0, 1); PG8_STAGE(PG8_SB(0, 0), b2, voffB);
            PG8_BAR; PG8_WAIT_L(0); PG8_MMA(0, 1, At, B1); PG8_BAR;
            PG8_LDA(At, 0, 1); PG8_STAGE(PG8_SA(0, 0), a2, voffA);
            PG8_BAR; PG8_WAIT_L(0); PG8_MMA(1, 0, At, B0); PG8_BAR; PG8_SCHED;
            PG8_STAGE(PG8_SB(0, 1), b2 + hstep, voffB);
            PG8_WAIT_V(6); PG8_BAR; PG8_MMA(1, 1, At, B1); PG8_BAR;
            PG8_LDB(B0, 1, 0); PG8_SCHED; PG8_LDA(At, 1, 0); PG8_STAGE(PG8_SA(0, 1), a2 + hstep, voffA);
            PG8_WAIT_L(8); PG8_BAR; PG8_WAIT_L(0); PG8_MMA(0, 0, At, B0); PG8_BAR; PG8_SCHED;
            PG8_LDB(B1, 1, 1); PG8_STAGE(PG8_SB(1, 0), b3, voffB);
            PG8_BAR; PG8_WAIT_L(0); PG8_MMA(0, 1, At, B1); PG8_BAR;
            PG8_LDA(At, 1, 1); PG8_STAGE(PG8_SA(1, 0), a3, voffA);
            PG8_BAR; PG8_WAIT_L(0); PG8_MMA(1, 0, At, B0); PG8_BAR; PG8_SCHED;
            PG8_STAGE(PG8_SB(1, 1), b3 + hstep, voffB);
            PG8_WAIT_V(6); PG8_BAR; PG8_MMA(1, 1, At, B1); PG8_BAR;
            }
        }
        if constexpr (ALIGN_EPI) { if (wr == 0) PG8_BAR; }
        if constexpr (F8) asm volatile("s_nop 15\n\ts_nop 15" ::: "memory");
        if constexpr (!Epi::AFTER_DRAIN) { E(acc, cur, wr, wc, fr, fq); S.done(cur); }
        if (!has_next) break;
#pragma unroll
        for (int a = 0; a < 2; ++a)
#pragma unroll
            for (int b = 0; b < 2; ++b)
#pragma unroll
                for (int m = 0; m < 4; ++m)
#pragma unroll
                    for (int n = 0; n < 2; ++n) acc[a][b][m][n] = (f32x4){0.f, 0.f, 0.f, 0.f};
        cur = nxt; cA = nA; cB = nB; ++ui;
        if constexpr (ALIGN_EPI) { if (wr == 1) PG8_BAR; }
    }
    PG8_WAIT_V(0);
    if constexpr (!ALIGN_EPI) { if (wr == 0) PG8_BAR; }
    PG8_BAR;
    if constexpr (Epi::AFTER_DRAIN) { E.fused(acc, cur, wr, wc, fr, fq, lds, wid, lane); S.done(cur); }
#undef PG8_SA
#undef PG8_SB
#undef PG8_STAGE
#undef PG8_LDA
#undef PG8_LDB
#undef PG8_MMA
#undef PG8_CAT
#undef PG8_WAIT_V
#undef PG8_WAIT_L
#undef PG8_BAR
#undef PG8_SCHED
}
}

constexpr int NWAVES = 8;
constexpr int S = 8192, DM = 4096, FF = 16384, DEPTH = 2;
constexpr int NSRC = 11344, NPROJ = 11520;
constexpr int OFF_Q = 0, OFF_KC = 2048, OFF_VC = 2560, OFF_KS = 3072, OFF_VS = 3584, OFF_KW = 4096, OFF_VW = 4608, OFF_XBC = 5120, OFF_Z = 9216, OFF_G = 11264, OFF_DT = 11312;
constexpr int NH = 16, NKV = 4, HD = 128, NCMP = 511, NSEL = 128, SELTOP = 16, WIN = 512;
constexpr int SSM_W = 2048, SSM_H = 32, SSM_P = 64, SSM_G = 8, SSM_N = 128, CONVD = 4096, CHUNK = 256, NCHUNK = S / CHUNK;
constexpr float EPS = 1e-5f;
constexpr float QSCALE = 0.08838834764831845f * 1.4426950408889634f;

constexpr size_t MiB = 1u << 20;
constexpr size_t WS_CTL = 0, CTL_ZERO_BYTES = 1 * MiB;
constexpr size_t SZ_WIN = (size_t)NPROJ * DM * 2, SZ_WO = (size_t)DM * DM * 2, SZ_WUP = (size_t)FF * DM * 2, SZ_WDN = (size_t)DM * FF * 2;
constexpr size_t WS_WIN = 2 * MiB;
constexpr size_t WS_WO = WS_WIN + DEPTH * SZ_WIN;
constexpr size_t WS_WUP = WS_WO + DEPTH * SZ_WO;
constexpr size_t WS_WDN = WS_WUP + DEPTH * SZ_WUP;
constexpr size_t WS_H = WS_WDN + DEPTH * SZ_WDN;
constexpr size_t WS_XN = WS_H + (size_t)S * DM * 4;
constexpr size_t WS_PROJ = WS_XN + (size_t)S * DM * 2;
constexpr size_t WS_ACT = WS_PROJ + (size_t)S * NPROJ * 2;
constexpr size_t WS_CAT = WS_ACT + (size_t)S * FF * 2;
constexpr size_t WS_ATT = WS_CAT + (size_t)S * DM * 2;
constexpr size_t WS_XBC = WS_ATT + (size_t)S * 2048 * 4;
constexpr size_t WS_Y = WS_XBC + (size_t)S * CONVD * 2;
constexpr size_t WS_ST = WS_Y + (size_t)S * 2048 * 4;
constexpr size_t WS_PREV = WS_ST + (size_t)NCHUNK * SSM_H * SSM_P * SSM_N * 4;
constexpr size_t WS_KC = WS_PREV + (size_t)NCHUNK * SSM_H * SSM_P * SSM_N * 4;
constexpr size_t WS_VC = WS_KC + (size_t)NKV * 512 * HD * 2;
constexpr size_t WS_DT = WS_VC + (size_t)NKV * 512 * HD * 2;
constexpr size_t WS_ADT = WS_DT + (size_t)S * 32 * 4;
constexpr size_t WS_COS = WS_ADT + (size_t)S * 32 * 4;
constexpr size_t WS_SIN = WS_COS + (size_t)S * 64 * 4;
constexpr size_t WS_BMP = WS_SIN + (size_t)S * 64 * 4;
constexpr size_t WS_ACSG = WS_BMP + (size_t)S * 16 * 4;
constexpr size_t WS_DEC = WS_ACSG + (size_t)S * 32 * 4;
constexpr size_t WS_W1T = WS_DEC + 4096;
constexpr size_t WS_W2T = WS_W1T + (size_t)DEPTH * 2 * 128 * 4096 * 2;
constexpr size_t WS_B1P = WS_W2T + (size_t)DEPTH * 2 * 128 * 128 * 2;
constexpr size_t WS_END = WS_B1P + (size_t)DEPTH * 2 * 16 * 128 * 4;
constexpr int CW_BAR = 4096, CW_P1 = 8192;
constexpr int P1_SPLIT = 10240;

constexpr int RING_OFF = 0, RING_BYTES = 131072;
constexpr int LDSCTL_OFF = 143360, MISC_OFF = LDSCTL_OFF + 320;
constexpr int LDS_BYTES = 147456;

#define GAS __attribute__((address_space(1)))
#define LAS __attribute__((address_space(3)))
typedef unsigned short bf16;
typedef unsigned v4u __attribute__((ext_vector_type(4)));
typedef float f32x4 __attribute__((ext_vector_type(4)));
typedef short bf16x8 __attribute__((ext_vector_type(8)));
typedef GAS unsigned gu32;
typedef GAS unsigned long long gu64;
#define RLX_AGENT __ATOMIC_RELAXED, __HIP_MEMORY_SCOPE_AGENT
#define LDS_WAIT() asm volatile("s_waitcnt lgkmcnt(0)" ::: "memory")
#define VM_WAIT() asm volatile("s_waitcnt vmcnt(0)" ::: "memory")
__device__ __forceinline__ unsigned long long rt() { return __builtin_amdgcn_s_memrealtime(); }
__device__ __forceinline__ unsigned f2bf(float f) { unsigned u = __builtin_bit_cast(unsigned, f); return (u + 0x7fffu + ((u >> 16) & 1u)) >> 16; }
__device__ __forceinline__ unsigned pk2(float lo, float hi) { return f2bf(lo) | (f2bf(hi) << 16); }

#define XB_TMO      128
#define XB_XCNT(j)  (256  + 64 * (j))
#define XB_XSUB(j)  (1280 + 64 * (j))
#define XB_XGEN(j)  (2304 + 64 * (j))
#define XB_TOP      3328
#define XB_TOPGEN   3392
#define XCD_BAR_WORDS 3456
#define XB_SPIN_CAP (1u << 18)

__device__ __forceinline__ unsigned xb_ld(unsigned* p)              { return __hip_atomic_load(p, __ATOMIC_RELAXED, __HIP_MEMORY_SCOPE_AGENT); }
__device__ __forceinline__ unsigned xb_add(unsigned* p, unsigned v) { return __hip_atomic_fetch_add(p, v, __ATOMIC_RELAXED, __HIP_MEMORY_SCOPE_AGENT); }
__device__ __forceinline__ unsigned xb_xcc_id() { return (unsigned)__builtin_amdgcn_s_getreg((3 << 11) | 20) & 0xFu; }
#define XB_SPIN(cond, bar) do { unsigned _sp = 0; while (cond) { __builtin_amdgcn_s_sleep(1); \
    if ((++_sp & 255u) == 0u) { if (xb_ld(&(bar)[XB_TMO])) break; if (_sp > XB_SPIN_CAP) { atomicAdd(&(bar)[XB_TMO], 1u); break; } } } } while (0)

__device__ __forceinline__ int bx_l() { int b = (int)blockIdx.x; asm volatile("" : "+s"(b)); return b; }
struct XcdBarrier {
    unsigned* bar; unsigned x;
    volatile LAS unsigned* st;
};

__device__ __forceinline__ XcdBarrier xcd_barrier_post(unsigned* bar, volatile LAS unsigned* st) {
    XcdBarrier b; b.bar = bar; b.x = xb_xcc_id(); b.st = st;
    if (threadIdx.x == 0) (void)xb_add(&bar[XB_XCNT(b.x)], 1u);
    return b;
}
__device__ __forceinline__ void xcd_barrier_complete(unsigned* bar, unsigned x, unsigned& nloc, unsigned& nx) {
    const unsigned G = gridDim.x * gridDim.y * gridDim.z;
    unsigned sum, cnt, mine, sp = 0u;
    for (;;) {
        sum = 0u; cnt = 0u; mine = 0u;
#pragma unroll
        for (unsigned j = 0; j < 16; ++j) { const unsigned c = xb_ld(&bar[XB_XCNT(j)]); sum += c; cnt += (c > 0u) ? 1u : 0u; mine = (j == x) ? c : mine; }
        if (sum == G) break;
        __builtin_amdgcn_s_sleep(1);
        if ((++sp & 255u) == 0u) { if (xb_ld(&bar[XB_TMO])) break; if (sp > XB_SPIN_CAP) { atomicAdd(&bar[XB_TMO], 1u); break; } }
    }
    nloc = mine > 0u ? mine : 1u; nx = cnt > 0u ? cnt : 1u;
}

__device__ __forceinline__ void xcd_barrier(const XcdBarrier& b) {
    asm volatile("s_waitcnt vmcnt(0)" ::: "memory");
    __syncthreads();
    if (threadIdx.x == 0) {
        unsigned* bar = b.bar;
        __builtin_amdgcn_s_waitcnt(0);
        unsigned nloc = b.st[0], nx = b.st[1];
        if (nloc == 0u) { xcd_barrier_complete(bar, b.x, nloc, nx); b.st[0] = nloc; b.st[1] = nx; }
        const unsigned old = xb_add(&bar[XB_XSUB(b.x)], 1u);
        const unsigned gen = old / nloc;
        if (old + 1u == (gen + 1u) * nloc) {
            __builtin_amdgcn_fence(__ATOMIC_RELEASE, "agent");
            asm volatile("s_waitcnt vmcnt(0)" ::: "memory");
            const unsigned og = xb_add(&bar[XB_TOP], 1u);
            const unsigned tg = og / nx;
            if (og + 1u == (tg + 1u) * nx) xb_add(&bar[XB_TOPGEN], 1u);
            else XB_SPIN(xb_ld(&bar[XB_TOPGEN]) == tg, bar);
            __builtin_amdgcn_fence(__ATOMIC_ACQUIRE, "agent");
            xb_add(&bar[XB_XGEN(b.x)], 1u);
            asm volatile("s_waitcnt vmcnt(0)" ::: "memory");
        } else {
            XB_SPIN(xb_ld(&bar[XB_XGEN(b.x)]) == gen, bar);
            __builtin_amdgcn_fence(__ATOMIC_ACQUIRE, "agent");
            asm volatile("s_waitcnt vmcnt(0)" ::: "memory");
        }
    }
    __syncthreads();
}


__device__ __forceinline__ float bf2f(unsigned short b) { return __builtin_bit_cast(float, (unsigned)b << 16); }
__device__ __forceinline__ float bflo(unsigned w) { return __builtin_bit_cast(float, w << 16); }
__device__ __forceinline__ float bfhi(unsigned w) { return __builtin_bit_cast(float, w & 0xffff0000u); }
__device__ __forceinline__ float wave_sum(float v) {
#pragma unroll
    for (int o = 1; o < 64; o <<= 1) v += __shfl_xor(v, o);
    return v;
}
__device__ __forceinline__ float wave_max(float v) {
#pragma unroll
    for (int o = 1; o < 64; o <<= 1) v = fmaxf(v, __shfl_xor(v, o));
    return v;
}

struct Frame {
    LAS unsigned char* lds;
    volatile LAS unsigned* MISC;
    gu32* ctl;
    int tid, lane, wave;
    int vcu, G;
};

__device__ __forceinline__ int src_col_in(int c) {
    if (c < 5120) { const int blk = c >> 7, p = c & 127; const bool rope = blk < 16 || ((((blk - 16) >> 2) & 1) == 0); const int d = rope ? (p >> 1) + 64 * (p & 1) : p; return blk * 128 + d; }
    if (c < OFF_Z) return c + 2096;
    if (c < OFF_G) return c - 4048;
    if (c < OFF_DT) return 5120 + (c - OFF_G);
    if (c < NSRC) return c;
    return -1;
}
__device__ __forceinline__ int nat_dim(int p) { return (p >> 1) + 64 * (p & 1); }
template <int MAP, bool KS, bool KPERM = false>
__device__ __forceinline__ void p0_transpose_item(const float* W, int K, int Nsrc, int nblk, bf16* WT, const float* ksA, const float* ksB, int ksplit, LAS float* scr, int item, int lane) {
    const int kb = item / nblk, nb = item % nblk, k0 = 64 * kb, n0 = 32 * nb;
    const int nr = n0 + (lane & 31); const int sc = MAP == 1 ? src_col_in(nr) : (MAP == 2 ? nat_dim(nr) : nr);
    float v[32];
#pragma unroll
    for (int i = 0; i < 32; ++i) { const int k = k0 + 2 * i + (lane >> 5); const int ksrc = KPERM ? ((k & ~127) + nat_dim(k & 127)) : k;
        v[i] = sc >= 0 ? W[(size_t)ksrc * Nsrc + sc] : 0.f; }
#pragma unroll
    for (int i = 0; i < 32; ++i) { const int kk = 2 * i + (lane >> 5); const int k = k0 + kk;
        if (KS) v[i] *= (k < ksplit ? ksA[k] : ksB[k - ksplit]);
        scr[kk * 33 + (lane & 31)] = v[i]; }
    LDS_WAIT(); asm volatile("" ::: "memory");
    const int c = lane & 7;
#pragma unroll
    for (int j = 0; j < 4; ++j) { const int n = (lane >> 3) + 8 * j; const LAS float* s = scr + (8 * c) * 33 + n;
        v4u o; o.x = pk2(s[0 * 33], s[1 * 33]); o.y = pk2(s[2 * 33], s[3 * 33]); o.z = pk2(s[4 * 33], s[5 * 33]); o.w = pk2(s[6 * 33], s[7 * 33]);
        *(GAS v4u*)(WT + (size_t)(n0 + n) * K + k0 + 8 * c) = o; }
    LDS_WAIT(); asm volatile("" ::: "memory");
}

template <bool KS, int MAP = 0>
__device__ __forceinline__ void p0_transpose_item_f8(const float* W, int K, int Nsrc, int nblk, unsigned char* WT, float wscale, const float* ksA, const float* ksB, int ksplit, LAS float* scr, int item, int lane) {
    const int pr = item >> 1, kb = 2 * (pr / nblk) + (item & 1), nb = pr % nblk, k0 = 64 * kb, n0 = 32 * nb;
    const int nr = n0 + (lane & 31); const int sc = MAP == 1 ? src_col_in(nr) : nr;
    float v[32];
#pragma unroll
    for (int i = 0; i < 32; ++i) v[i] = sc >= 0 ? W[(size_t)(k0 + 2 * i + (lane >> 5)) * Nsrc + sc] : 0.f;
#pragma unroll
    for (int i = 0; i < 32; ++i) { const int k = k0 + 2 * i + (lane >> 5); float x = v[i] * wscale; if (KS) x *= (k < ksplit ? ksA[k] : ksB[k - ksplit]); scr[(2 * i + (lane >> 5)) * 33 + (lane & 31)] = x; }
    LDS_WAIT(); asm volatile("" ::: "memory");
    const int c = lane & 7;
#pragma unroll
    for (int j = 0; j < 4; ++j) { const int n = (lane >> 3) + 8 * j; const LAS float* s = scr + (8 * c) * 33 + n;
        const unsigned long long o = (unsigned long long)pg8::pk4_fp8(s[0 * 33], s[1 * 33], s[2 * 33], s[3 * 33]) | ((unsigned long long)pg8::pk4_fp8(s[4 * 33], s[5 * 33], s[6 * 33], s[7 * 33]) << 32);
        *(GAS unsigned long long*)(WT + (size_t)(n0 + n) * K + k0 + 8 * c) = o; }
    LDS_WAIT(); asm volatile("" ::: "memory");
}
__device__ __forceinline__ void rms_row_to_bf16(const float* xrow, bf16* orow, int lane) {
    const GAS f32x4* xr = (const GAS f32x4*)xrow + lane;
    f32x4 v[16]; float s = 0.f;
#pragma unroll
    for (int j = 0; j < 16; ++j) { v[j] = xr[64 * j]; s += (v[j].x * v[j].x + v[j].y * v[j].y) + (v[j].z * v[j].z + v[j].w * v[j].w); }
    const float rstd = 1.f / sqrtf(wave_sum(s) * (1.f / DM) + EPS);
    GAS unsigned long long* o8 = (GAS unsigned long long*)orow + lane;
#pragma unroll
    for (int j = 0; j < 16; ++j) o8[64 * j] = (unsigned long long)pk2(v[j].x * rstd, v[j].y * rstd) | ((unsigned long long)pk2(v[j].z * rstd, v[j].w * rstd) << 32);
}
constexpr float XN8_SCALE = 4.f, WUP8_SCALE = 64.f;
__device__ __forceinline__ void rms_rowh_to_fp8(const bf16* xrow, unsigned char* orow, int lane) {
    const GAS v4u* xr = (const GAS v4u*)xrow + lane;
    v4u v[8]; float s = 0.f;
#pragma unroll
    for (int j = 0; j < 8; ++j) { v[j] = xr[64 * j]; const float a0 = bflo(v[j].x), a1 = bfhi(v[j].x), a2 = bflo(v[j].y), a3 = bfhi(v[j].y), a4 = bflo(v[j].z), a5 = bfhi(v[j].z), a6 = bflo(v[j].w), a7 = bfhi(v[j].w);
        s += ((a0 * a0 + a1 * a1) + (a2 * a2 + a3 * a3)) + ((a4 * a4 + a5 * a5) + (a6 * a6 + a7 * a7)); }
    const float rstd = XN8_SCALE / sqrtf(wave_sum(s) * (1.f / DM) + EPS);
    GAS unsigned long long* o8 = (GAS unsigned long long*)orow + lane;
#pragma unroll
    for (int j = 0; j < 8; ++j) o8[64 * j] = (unsigned long long)pg8::pk4_fp8(bflo(v[j].x) * rstd, bfhi(v[j].x) * rstd, bflo(v[j].y) * rstd, bfhi(v[j].y) * rstd) | ((unsigned long long)pg8::pk4_fp8(bflo(v[j].z) * rstd, bfhi(v[j].z) * rstd, bflo(v[j].w) * rstd, bfhi(v[j].w) * rstd) << 32);
}
__device__ __forceinline__ void rms2f_to_bf16(const float* X, bf16* O, int m0, int mstep, int lane) {
    f32x4 v[2][16];
#pragma unroll
    for (int i = 0; i < 2; ++i) { const GAS f32x4* xr = (const GAS f32x4*)(X + (size_t)(m0 + i * mstep) * DM) + lane;
#pragma unroll
        for (int j = 0; j < 16; ++j) v[i][j] = xr[64 * j]; }
    asm volatile("" ::: "memory");
#pragma unroll
    for (int i = 0; i < 2; ++i) { float s = 0.f;
#pragma unroll
        for (int j = 0; j < 16; ++j) s += (v[i][j].x * v[i][j].x + v[i][j].y * v[i][j].y) + (v[i][j].z * v[i][j].z + v[i][j].w * v[i][j].w);
        const float rstd = 1.f / sqrtf(wave_sum(s) * (1.f / DM) + EPS);
        GAS unsigned long long* o8 = (GAS unsigned long long*)(O + (size_t)(m0 + i * mstep) * DM) + lane;
#pragma unroll
        for (int j = 0; j < 16; ++j) o8[64 * j] = (unsigned long long)pk2(v[i][j].x * rstd, v[i][j].y * rstd) | ((unsigned long long)pk2(v[i][j].z * rstd, v[i][j].w * rstd) << 32); }
}
__device__ __forceinline__ void final2h(const bf16* H, float* out, const float* nf, int m0, int mstep, int lane) {
    v4u v[2][8]; f32x4 g[16]; const GAS f32x4* w4 = (const GAS f32x4*)nf + 2 * lane;
#pragma unroll
    for (int i = 0; i < 2; ++i) { const GAS v4u* xr = (const GAS v4u*)(H + (size_t)(m0 + i * mstep) * DM) + lane;
#pragma unroll
        for (int j = 0; j < 8; ++j) v[i][j] = xr[64 * j]; }
#pragma unroll
    for (int j = 0; j < 8; ++j) { g[2 * j] = w4[128 * j]; g[2 * j + 1] = w4[128 * j + 1]; }
    asm volatile("" ::: "memory");
#pragma unroll
    for (int i = 0; i < 2; ++i) { float s = 0.f;
#pragma unroll
        for (int j = 0; j < 8; ++j) { const float a0 = bflo(v[i][j].x), a1 = bfhi(v[i][j].x), a2 = bflo(v[i][j].y), a3 = bfhi(v[i][j].y), a4 = bflo(v[i][j].z), a5 = bfhi(v[i][j].z), a6 = bflo(v[i][j].w), a7 = bfhi(v[i][j].w);
            s += ((a0 * a0 + a1 * a1) + (a2 * a2 + a3 * a3)) + ((a4 * a4 + a5 * a5) + (a6 * a6 + a7 * a7)); }
        const float rstd = 1.f / sqrtf(wave_sum(s) * (1.f / DM) + EPS);
        GAS f32x4* o4 = (GAS f32x4*)(out + (size_t)(m0 + i * mstep) * DM) + 2 * lane;
#pragma unroll
        for (int j = 0; j < 8; ++j) { o4[128 * j] = (f32x4){bflo(v[i][j].x), bfhi(v[i][j].x), bflo(v[i][j].y), bfhi(v[i][j].y)} * rstd * g[2 * j]; o4[128 * j + 1] = (f32x4){bflo(v[i][j].z), bfhi(v[i][j].z), bflo(v[i][j].w), bfhi(v[i][j].w)} * rstd * g[2 * j + 1]; } }
}
__device__ __forceinline__ void rms4h_to_fp8(const bf16* H, unsigned char* X, int m0, int mstep, int lane) {
    v4u v[4][8];
#pragma unroll
    for (int i = 0; i < 4; ++i) { const GAS v4u* xr = (const GAS v4u*)(H + (size_t)(m0 + i * mstep) * DM) + lane;
#pragma unroll
        for (int j = 0; j < 8; ++j) v[i][j] = xr[64 * j]; }
    asm volatile("" ::: "memory");
#pragma unroll
    for (int i = 0; i < 4; ++i) { float s = 0.f;
#pragma unroll
        for (int j = 0; j < 8; ++j) { const float a0 = bflo(v[i][j].x), a1 = bfhi(v[i][j].x), a2 = bflo(v[i][j].y), a3 = bfhi(v[i][j].y), a4 = bflo(v[i][j].z), a5 = bfhi(v[i][j].z), a6 = bflo(v[i][j].w), a7 = bfhi(v[i][j].w);
            s += ((a0 * a0 + a1 * a1) + (a2 * a2 + a3 * a3)) + ((a4 * a4 + a5 * a5) + (a6 * a6 + a7 * a7)); }
        const float rstd = XN8_SCALE / sqrtf(wave_sum(s) * (1.f / DM) + EPS);
        GAS unsigned long long* o8 = (GAS unsigned long long*)(X + (size_t)(m0 + i * mstep) * DM) + lane;
#pragma unroll
        for (int j = 0; j < 8; ++j) o8[64 * j] = (unsigned long long)pg8::pk4_fp8(bflo(v[i][j].x) * rstd, bfhi(v[i][j].x) * rstd, bflo(v[i][j].y) * rstd, bfhi(v[i][j].y) * rstd) | ((unsigned long long)pg8::pk4_fp8(bflo(v[i][j].z) * rstd, bfhi(v[i][j].z) * rstd, bflo(v[i][j].w) * rstd, bfhi(v[i][j].w) * rstd) << 32); }
}
constexpr int PROJ_F8_FROM = 1;
constexpr int WO_F8_FROM = 1;
__device__ __forceinline__ void rms_row_to_fp8(const float* xrow, unsigned char* orow, int lane) {
    const GAS f32x4* xr = (const GAS f32x4*)xrow + lane;
    f32x4 v[16]; float s = 0.f;
#pragma unroll
    for (int j = 0; j < 16; ++j) { v[j] = xr[64 * j]; s += (v[j].x * v[j].x + v[j].y * v[j].y) + (v[j].z * v[j].z + v[j].w * v[j].w); }
    const float rstd = XN8_SCALE / sqrtf(wave_sum(s) * (1.f / DM) + EPS);
    GAS unsigned* o4 = (GAS unsigned*)orow + lane;
#pragma unroll
    for (int j = 0; j < 16; ++j) o4[64 * j] = pg8::pk4_fp8(v[j].x * rstd, v[j].y * rstd, v[j].z * rstd, v[j].w * rstd);
}

typedef float f32x16 __attribute__((ext_vector_type(16)));
typedef short s16x4 __attribute__((ext_vector_type(4)));
__device__ __forceinline__ int crow(int r, int hi) { return (r & 3) + 8 * (r >> 2) + 4 * hi; }
__device__ __forceinline__ unsigned cvtpk(float lo, float hi) { unsigned r; asm volatile("v_cvt_pk_bf16_f32 %0, %1, %2" : "=v"(r) : "v"(lo), "v"(hi)); return r; }
__device__ __forceinline__ void stage4_tr(LAS bf16* dst  , int ld, v4u w0, v4u w1, v4u w2, v4u w3, float d0, float d1, float d2, float d3) {
    const unsigned a0[4] = {w0.x, w0.y, w0.z, w0.w}, a1[4] = {w1.x, w1.y, w1.z, w1.w}, a2[4] = {w2.x, w2.y, w2.z, w2.w}, a3[4] = {w3.x, w3.y, w3.z, w3.w};
#pragma unroll
    for (int jj = 0; jj < 4; ++jj) {
        const unsigned long long lo = (unsigned long long)cvtpk(bflo(a0[jj]) * d0, bflo(a1[jj]) * d1) | ((unsigned long long)cvtpk(bflo(a2[jj]) * d2, bflo(a3[jj]) * d3) << 32);
        const unsigned long long hi = (unsigned long long)cvtpk(bfhi(a0[jj]) * d0, bfhi(a1[jj]) * d1) | ((unsigned long long)cvtpk(bfhi(a2[jj]) * d2, bfhi(a3[jj]) * d3) << 32);
        *(LAS unsigned long long*)(dst + (2 * jj) * ld) = lo; *(LAS unsigned long long*)(dst + (2 * jj + 1) * ld) = hi; }
}
constexpr int SSD_LD = 264;
constexpr int SSD_XT2 = 0, SSD_BN = 2 * 64 * SSD_LD * 2, SSD_ACS = SSD_BN + 256 * 256, SSD_DTL = SSD_ACS + 4096, SSD_LDS_END = SSD_DTL + 4096;
constexpr int SSD_BT = 0, SSD_XT = 128 * SSD_LD * 2;
static_assert(SSD_LDS_END <= LDSCTL_OFF && SSD_XT + 64 * SSD_LD * 2 <= SSD_ACS, "ssd lds");
__device__ __forceinline__ void ssd1_unit(LAS unsigned char* lds, int c, int g, const bf16* XBC, const bf16* PROJ, const float* dtb, const float* alog, bf16* Y, float* ST, float* DEC, float* ACSG, int tid_in) {
    int tid = tid_in; asm volatile("" : "+v"(tid));
    const int lane = tid & 63, wave = __builtin_amdgcn_readfirstlane(tid >> 6), l32 = lane & 31, hi = lane >> 5;
    LAS bf16* XT2 = (LAS bf16*)(lds + SSD_XT2); LAS unsigned char* BN = lds + SSD_BN; LAS float* acs = (LAS float*)(lds + SSD_ACS); LAS float* dtl = (LAS float*)(lds + SSD_DTL);
    const int t0 = c * CHUNK;
    __syncthreads();
    if (wave < 4) { const int h = 4 * g + wave; float a[4], run = 0.f; const float nA = -expf(alog[h]), db = dtb[h];
#pragma unroll
        for (int i = 0; i < 4; ++i) { const float xr = bf2f(PROJ[(size_t)(t0 + 4 * lane + i) * NPROJ + OFF_DT + h]) + db; const float sp = xr > 20.f ? xr : log1pf(expf(xr));
            a[i] = sp * nA; run += a[i]; a[i] = run; dtl[wave * 256 + 4 * lane + i] = sp; }
        float inc = run;
#pragma unroll
        for (int d = 1; d < 64; d <<= 1) { const float v = __shfl_up(inc, d); if (lane >= d) inc += v; }
        const float excl = inc - run;
#pragma unroll
        for (int i = 0; i < 4; ++i) { const float v = a[i] + excl; acs[wave * 256 + 4 * lane + i] = v; ACSG[(size_t)(t0 + 4 * lane + i) * 32 + h] = v; }
        if (lane == 63) DEC[c * 32 + h] = expf(inc);
    }
#pragma unroll
    for (int i = 0; i < 8; ++i) { const int idx = tid + 512 * i, s = idx >> 4, ch = idx & 15;
        const v4u w = *(const GAS v4u*)(XBC + (size_t)(t0 + s) * CONVD + 2048 + g * 128 + 8 * ch);
        *(LAS v4u*)(BN + s * 256 + ((ch ^ (s & 7)) << 4)) = w; }
    __syncthreads();
#pragma unroll 1
    for (int rd = 0; rd < 2; ++rd) {
        { const int s0 = 4 * lane;
#pragma unroll
          for (int cq = 0; cq < 2; ++cq) { const int cb = 8 * (2 * wave + cq), hq = cb >> 6, pb = cb & 63;
            const bf16* xp = XBC + (size_t)(t0 + s0) * CONVD + (4 * g + 2 * rd) * 64 + cb;
            const v4u w0 = *(const GAS v4u*)xp, w1 = *(const GAS v4u*)(xp + CONVD), w2 = *(const GAS v4u*)(xp + 2 * CONVD), w3 = *(const GAS v4u*)(xp + 3 * CONVD);
            const f32x4 dv = *(const LAS f32x4*)(dtl + (2 * rd + hq) * 256 + s0);
            stage4_tr(XT2 + (hq * 64 + pb) * SSD_LD + s0, SSD_LD, w0, w1, w2, w3, dv[0], dv[1], dv[2], dv[3]); } }
        __syncthreads();
        { const int hq = wave >> 2, hh = 2 * rd + hq, h = 4 * g + hh;
#pragma unroll 1
          for (int task = 0; task < 2; ++task) {
            const int lt = task ? 7 - (wave & 3) : (wave & 3); const int lloc = 32 * lt + l32, lrow = t0 + lloc;
            bf16x8 cf[8];
#pragma unroll
            for (int kk = 0; kk < 8; ++kk) cf[kk] = *(const GAS bf16x8*)(XBC + (size_t)lrow * CONVD + 3072 + g * 128 + 16 * kk + 8 * hi);
            const float acl = acs[hh * 256 + lloc];
            f32x16 ya0 = {}, ya1 = {};
            for (int j = 0; j <= lt; ++j) {
                f32x16 gt = {};
                { const int s = 32 * j + l32; const LAS unsigned char* brow = BN + s * 256; const int sw = s & 7;
#pragma unroll
                  for (int kk = 0; kk < 8; ++kk) { const bf16x8 a = *(const LAS bf16x8*)(brow + (((2 * kk + hi) ^ sw) << 4)); gt = __builtin_amdgcn_mfma_f32_32x32x16_bf16(a, cf[kk], gt, 0, 0, 0); } }
                float e[16];
#pragma unroll
                for (int q = 0; q < 4; ++q) { const f32x4 av = *(const LAS f32x4*)(acs + hh * 256 + 32 * j + 8 * q + 4 * hi);
#pragma unroll
                    for (int i = 0; i < 4; ++i) { const int r = 4 * q + i, s = 32 * j + crow(r, hi); const float ev = __expf(fminf(acl - av[i], 0.f)); e[r] = (s <= lloc) ? gt[r] * ev : 0.f; } }
                v4u w0 = {cvtpk(e[0], e[1]), cvtpk(e[2], e[3]), cvtpk(e[4], e[5]), cvtpk(e[6], e[7])}, w1 = {cvtpk(e[8], e[9]), cvtpk(e[10], e[11]), cvtpk(e[12], e[13]), cvtpk(e[14], e[15])};
                const bf16x8 pk0 = __builtin_bit_cast(bf16x8, w0), pk1 = __builtin_bit_cast(bf16x8, w1);
#pragma unroll
                for (int pt = 0; pt < 2; ++pt) {
                    const LAS bf16* xr = XT2 + (hq * 64 + 32 * pt + l32) * SSD_LD + 32 * j + 4 * hi;
                    const s16x4 a0 = *(const LAS s16x4*)(xr), a1 = *(const LAS s16x4*)(xr + 8), a2 = *(const LAS s16x4*)(xr + 16), a3 = *(const LAS s16x4*)(xr + 24);
                    const bf16x8 af0 = {a0[0], a0[1], a0[2], a0[3], a1[0], a1[1], a1[2], a1[3]}, af1 = {a2[0], a2[1], a2[2], a2[3], a3[0], a3[1], a3[2], a3[3]};
                    if (pt == 0) { ya0 = __builtin_amdgcn_mfma_f32_32x32x16_bf16(af0, pk0, ya0, 0, 0, 0); ya0 = __builtin_amdgcn_mfma_f32_32x32x16_bf16(af1, pk1, ya0, 0, 0, 0); }
                    else { ya1 = __builtin_amdgcn_mfma_f32_32x32x16_bf16(af0, pk0, ya1, 0, 0, 0); ya1 = __builtin_amdgcn_mfma_f32_32x32x16_bf16(af1, pk1, ya1, 0, 0, 0); }
                }
            }
            bf16* yrow = Y + (size_t)lrow * 2048 + h * 64 + 4 * hi;
#pragma unroll
            for (int q = 0; q < 4; ++q) { *(GAS unsigned long long*)(yrow + 8 * q) = (unsigned long long)cvtpk(ya0[4 * q], ya0[4 * q + 1]) | ((unsigned long long)cvtpk(ya0[4 * q + 2], ya0[4 * q + 3]) << 32);
                                          *(GAS unsigned long long*)(yrow + 32 + 8 * q) = (unsigned long long)cvtpk(ya1[4 * q], ya1[4 * q + 1]) | ((unsigned long long)cvtpk(ya1[4 * q + 2], ya1[4 * q + 3]) << 32); }
          } }
        __syncthreads();
    }
    LAS bf16* BT = (LAS bf16*)(lds + SSD_BT); LAS bf16* XT = (LAS bf16*)(lds + SSD_XT);
    { const int s0 = 4 * lane;
#pragma unroll
      for (int cq = 0; cq < 2; ++cq) { const int nb = 8 * (2 * wave + cq);
        const bf16* bp = XBC + (size_t)(t0 + s0) * CONVD + 2048 + g * 128 + nb;
        const v4u w0 = *(const GAS v4u*)bp, w1 = *(const GAS v4u*)(bp + CONVD), w2 = *(const GAS v4u*)(bp + 2 * CONVD), w3 = *(const GAS v4u*)(bp + 3 * CONVD);
        stage4_tr(BT + nb * SSD_LD + s0, SSD_LD, w0, w1, w2, w3, 1.f, 1.f, 1.f, 1.f); } }
    for (int hh = 0; hh < 4; ++hh) {
        const int h = 4 * g + hh;
        { const float aend = acs[hh * 256 + 255]; const int s0 = 4 * lane, pb = 8 * wave;
          const bf16* xp = XBC + (size_t)(t0 + s0) * CONVD + h * 64 + pb;
          const v4u w0 = *(const GAS v4u*)xp, w1 = *(const GAS v4u*)(xp + CONVD), w2 = *(const GAS v4u*)(xp + 2 * CONVD), w3 = *(const GAS v4u*)(xp + 3 * CONVD);
          const f32x4 dv = *(const LAS f32x4*)(dtl + hh * 256 + s0), av = *(const LAS f32x4*)(acs + hh * 256 + s0);
          stage4_tr(XT + pb * SSD_LD + s0, SSD_LD, w0, w1, w2, w3, dv[0] * __expf(aend - av[0]), dv[1] * __expf(aend - av[1]), dv[2] * __expf(aend - av[2]), dv[3] * __expf(aend - av[3])); }
        __syncthreads();
        { const int pt = wave >> 2, nt = wave & 3; f32x16 acc = {};
          const LAS bf16* ar = XT + (32 * pt + l32) * SSD_LD + 8 * hi; const LAS bf16* br = BT + (32 * nt + l32) * SSD_LD + 8 * hi;
#pragma unroll
          for (int kk = 0; kk < 16; ++kk) { const bf16x8 a = *(const LAS bf16x8*)(ar + 16 * kk), b = *(const LAS bf16x8*)(br + 16 * kk); acc = __builtin_amdgcn_mfma_f32_32x32x16_bf16(a, b, acc, 0, 0, 0); }
          float* sp = ST + ((size_t)(c * 32 + h) * 64 + 32 * pt) * 128 + 32 * nt + l32;
#pragma unroll
          for (int r = 0; r < 16; ++r) sp[(size_t)crow(r, hi) * 128] = acc[r]; }
        __syncthreads();
    }
}
constexpr int S3_LD = 68;
__device__ __forceinline__ void ssd3_unit(LAS unsigned char* lds, int c, int g, const bf16* XBC, const bf16* PROJ, const bf16* Y, bf16* Y2, const bf16* PREV, const float* ACSG, const float* dsk, unsigned char* CAT, bool cat_f8, int tid_in) {
    int tid = tid_in; asm volatile("" : "+v"(tid));
    const int lane = tid & 63, wave = __builtin_amdgcn_readfirstlane(tid >> 6), l32 = lane & 31, hi = lane >> 5;
    LAS float* T = (LAS float*)(lds + 65536) + wave * (32 * S3_LD);
    const int t0 = c * CHUNK; const int lrow = t0 + 32 * wave + l32;
    asm volatile("s_waitcnt vmcnt(0) lgkmcnt(0)" ::: "memory"); __builtin_amdgcn_s_barrier();
    { const int sr = tid >> 4, spc = tid & 15, slc = spc ^ (sr & 7);
      const char* psrc = (const char*)(PREV + ((size_t)(c * 32 + 4 * g) * 64 + sr) * 128 + 8 * slc);
#pragma unroll
      for (int q = 0; q < 8; ++q)
          __builtin_amdgcn_global_load_lds((const unsigned*)(psrc + (size_t)q * (32 * 128 * 2)), (LAS unsigned*)(lds + q * 8192 + wave * 1024), 16, 0, 0); }
    const int q8 = (lane & 7) * 8, tl0 = lane >> 3;
    bf16x8 cf[8];
#pragma unroll
    for (int kk = 0; kk < 8; ++kk) cf[kk] = *(const GAS bf16x8*)(XBC + (size_t)lrow * CONVD + 3072 + g * 128 + 16 * kk + 8 * hi);
    float ss[4] = {0.f, 0.f, 0.f, 0.f};
    asm volatile("s_waitcnt vmcnt(0)" ::: "memory"); __builtin_amdgcn_s_barrier(); asm volatile("" ::: "memory");
    const int sw = l32 & 7;
#pragma unroll
    for (int hh = 0; hh < 4; ++hh) { const int h = 4 * g + hh; const float dk = dsk[h];
        f32x16 acc0 = {}, acc1 = {};
        const LAS unsigned char* pr = lds + hh * 16384 + l32 * 256;
#pragma unroll
        for (int kk = 0; kk < 8; ++kk) { const int cx = ((2 * kk + hi) ^ sw) << 4; const bf16x8 w0 = *(const LAS bf16x8*)(pr + cx), w1 = *(const LAS bf16x8*)(pr + 8192 + cx);
            acc0 = __builtin_amdgcn_mfma_f32_32x32x16_bf16(cf[kk], w0, acc0, 0, 0, 0);
            acc1 = __builtin_amdgcn_mfma_f32_32x32x16_bf16(cf[kk], w1, acc1, 0, 0, 0); }
        asm volatile("" ::: "memory");
#pragma unroll
        for (int r = 0; r < 16; ++r) { T[crow(r, hi) * S3_LD + l32] = acc0[r]; T[crow(r, hi) * S3_LD + 32 + l32] = acc1[r]; }
        asm volatile("s_waitcnt lgkmcnt(0)" ::: "memory");
#pragma unroll
        for (int ip = 0; ip < 2; ++ip) {
            v4u yw[2]; v4u xw[2], zw[2]; float ea[2];
#pragma unroll
            for (int ii = 0; ii < 2; ++ii) { const int i = 2 * ip + ii; const int t = t0 + 32 * wave + tl0 + 8 * i; const int ch = h * 64 + q8;
                yw[ii] = *(const GAS v4u*)(Y + (size_t)t * 2048 + ch);
                xw[ii] = *(const GAS v4u*)(XBC + (size_t)t * CONVD + ch); zw[ii] = *(const GAS v4u*)(PROJ + (size_t)t * NPROJ + OFF_Z + ch); ea[ii] = __expf(ACSG[(size_t)t * 32 + h]); }
#pragma unroll
            for (int ii = 0; ii < 2; ++ii) { const int i = 2 * ip + ii; const LAS f32x4* tp = (const LAS f32x4*)(T + (tl0 + 8 * i) * S3_LD + q8); const f32x4 a0 = tp[0], a1 = tp[1];
                const float xv[8] = {bflo(xw[ii].x), bfhi(xw[ii].x), bflo(xw[ii].y), bfhi(xw[ii].y), bflo(xw[ii].z), bfhi(xw[ii].z), bflo(xw[ii].w), bfhi(xw[ii].w)};
                const float zv[8] = {bflo(zw[ii].x), bfhi(zw[ii].x), bflo(zw[ii].y), bfhi(zw[ii].y), bflo(zw[ii].z), bfhi(zw[ii].z), bflo(zw[ii].w), bfhi(zw[ii].w)};
                const float ydv[8] = {bflo(yw[ii].x), bfhi(yw[ii].x), bflo(yw[ii].y), bfhi(yw[ii].y), bflo(yw[ii].z), bfhi(yw[ii].z), bflo(yw[ii].w), bfhi(yw[ii].w)};
                float y[8];
#pragma unroll
                for (int j = 0; j < 8; ++j) { const float a = j < 4 ? a0[j & 3] : a1[j & 3], yd = ydv[j];
                    float v = a * ea[ii] + yd + dk * xv[j]; v *= zv[j] / (1.f + __expf(-zv[j])); y[j] = v; ss[i] += v * v; }
                *(GAS v4u*)(Y2 + (size_t)(t0 + 32 * wave + tl0 + 8 * i) * 2048 + h * 64 + q8) = (v4u){cvtpk(y[0], y[1]), cvtpk(y[2], y[3]), cvtpk(y[4], y[5]), cvtpk(y[6], y[7])}; }
            asm volatile("" ::: "memory");
        }
        asm volatile("s_waitcnt lgkmcnt(0)" ::: "memory");
    }
    asm volatile("s_waitcnt vmcnt(0)" ::: "memory");
    float rs[4];
#pragma unroll
    for (int i = 0; i < 4; ++i) { float s = ss[i]; s += __shfl_xor(s, 1); s += __shfl_xor(s, 2); s += __shfl_xor(s, 4); rs[i] = 1.f / sqrtf(s * (1.f / 256.f) + EPS); }
#pragma unroll
    for (int hh = 0; hh < 4; ++hh)
#pragma unroll
        for (int i = 0; i < 4; ++i) { const int t = t0 + 32 * wave + tl0 + 8 * i; const float r = rs[i];
            const unsigned long long* yp = (const unsigned long long*)(Y2 + (size_t)t * 2048 + (4 * g + hh) * 64 + q8);
            const unsigned long long u0 = __hip_atomic_load(yp, __ATOMIC_RELAXED, __HIP_MEMORY_SCOPE_AGENT), u1 = __hip_atomic_load(yp + 1, __ATOMIC_RELAXED, __HIP_MEMORY_SCOPE_AGENT);
            const v4u w = {(unsigned)u0, (unsigned)(u0 >> 32), (unsigned)u1, (unsigned)(u1 >> 32)};
            if (cat_f8) {
            const unsigned long long o = (unsigned long long)pg8::pk4_fp8(bflo(w.x) * r, bfhi(w.x) * r, bflo(w.y) * r, bfhi(w.y) * r) | ((unsigned long long)pg8::pk4_fp8(bflo(w.z) * r, bfhi(w.z) * r, bflo(w.w) * r, bfhi(w.w) * r) << 32);
            *(GAS unsigned long long*)(CAT + (size_t)t * DM + 2048 + (4 * g + hh) * 64 + q8) = o; }
            else *(GAS v4u*)((bf16*)CAT + (size_t)t * DM + 2048 + (4 * g + hh) * 64 + q8) = (v4u){cvtpk(bflo(w.x) * r, bfhi(w.x) * r), cvtpk(bflo(w.y) * r, bfhi(w.y) * r), cvtpk(bflo(w.z) * r, bfhi(w.z) * r), cvtpk(bflo(w.w) * r, bfhi(w.w) * r)}; }
}

#define KSWZ(row, colB) ((row) * 256 + ((colB) ^ (((row) & 7) << 4)))
#define SBAR() __builtin_amdgcn_sched_barrier(0)
__device__ __forceinline__ int v_st(int k, int c) { const int kk = (k & ~0xC) | ((k & 4) << 1) | ((k & 8) >> 1); return ((kk >> 3) * 4 + (c >> 5)) * 512 + ((kk & 7) * 32 + (c & 31)) * 2; }
__device__ __forceinline__ int v_rd_base(int lane) { return ((lane & 3) << 3) | (((lane >> 2) & 3) << 6) | (((lane >> 4) & 1) << 5) | (((lane >> 5) & 1) << 8); }
constexpr int v_rd_off(int d0, int ks, int half) { return d0 * 512 + ks * 4096 + half * 2048; }
constexpr int AT_K = 0, AT_V = 49152, AT_WS = 98304, AT_IMP = AT_WS + 2048, AT_IMPLD = 129, AT_CARRY = AT_IMP + 64 * AT_IMPLD * 4, AT_BM = AT_CARRY + 2048, AT_END = AT_BM + 1024;
static_assert(AT_END <= LDSCTL_OFF, "attention lds");
constexpr float AT_THR = 11.5f;

__device__ __forceinline__ void at_qkt(f32x16& p0, f32x16& p1, const LAS unsigned char* Kt, int l32, int hi, const bf16x8 (&qr)[8], const f32x16& cinit) {
    const LAS unsigned char* kb[4];
#pragma unroll
    for (int dd = 0; dd < 4; ++dd) kb[dd] = Kt + KSWZ(l32, (dd * 16 + hi * 8) * 2);
#pragma unroll
    for (int d0 = 0; d0 < 8; ++d0) { const LAS unsigned char* a = kb[d0 & 3] + (d0 >> 2) * 128;
        const bf16x8 b0 = *(const LAS bf16x8*)a, b1 = *(const LAS bf16x8*)(a + 32 * 256);
        if (d0 == 0) { p0 = __builtin_amdgcn_mfma_f32_32x32x16_bf16(b0, qr[0], cinit, 0, 0, 0); p1 = __builtin_amdgcn_mfma_f32_32x32x16_bf16(b1, qr[0], cinit, 0, 0, 0); }
        else { p0 = __builtin_amdgcn_mfma_f32_32x32x16_bf16(b0, qr[d0], p0, 0, 0, 0); p1 = __builtin_amdgcn_mfma_f32_32x32x16_bf16(b1, qr[d0], p1, 0, 0, 0); } }
}
__device__ __forceinline__ void at_pv(f32x16 (&o)[4], int vb, bf16x8 pa0, bf16x8 pa1, bf16x8 pa2, bf16x8 pa3) {
#define TRRD(dst, off) asm volatile("ds_read_b64_tr_b16 %0, %1 offset:%2" : "=&v"(dst) : "v"(vb), "i"(off) : "memory")
#define PV_D0(d0) do { s16x4 l0, l1, l2, l3, h0, h1, h2, h3; constexpr int b_ = v_rd_off(d0, 0, 0); \
        TRRD(l0, b_); TRRD(h0, b_ + 2048); TRRD(l1, b_ + 4096); TRRD(h1, b_ + 6144); TRRD(l2, b_ + 8192); TRRD(h2, b_ + 10240); TRRD(l3, b_ + 12288); TRRD(h3, b_ + 14336); \
        asm volatile("s_waitcnt lgkmcnt(0)" ::: "memory"); SBAR(); \
        o[d0] = __builtin_amdgcn_mfma_f32_32x32x16_bf16(pa0, (bf16x8){l0[0], l0[1], l0[2], l0[3], h0[0], h0[1], h0[2], h0[3]}, o[d0], 0, 0, 0); \
        o[d0] = __builtin_amdgcn_mfma_f32_32x32x16_bf16(pa1, (bf16x8){l1[0], l1[1], l1[2], l1[3], h1[0], h1[1], h1[2], h1[3]}, o[d0], 0, 0, 0); \
        o[d0] = __builtin_amdgcn_mfma_f32_32x32x16_bf16(pa2, (bf16x8){l2[0], l2[1], l2[2], l2[3], h2[0], h2[1], h2[2], h2[3]}, o[d0], 0, 0, 0); \
        o[d0] = __builtin_amdgcn_mfma_f32_32x32x16_bf16(pa3, (bf16x8){l3[0], l3[1], l3[2], l3[3], h3[0], h3[1], h3[2], h3[3]}, o[d0], 0, 0, 0); } while (0)
    PV_D0(0); PV_D0(1); PV_D0(2); PV_D0(3);
#undef PV_D0
#undef TRRD
}
__device__ __forceinline__ float max3f(float a, float b, float c) { float r; asm("v_max3_f32 %0, %1, %2, %3" : "=v"(r) : "v"(a), "v"(b), "v"(c)); return r; }
__device__ __forceinline__ float at_softmax(f32x16& p0, f32x16& p1, float& m_reg, f32x16& negm, float& l_reg, bf16x8& pa0, bf16x8& pa1, bf16x8& pa2, bf16x8& pa3, bool rowsel, bool use_rowsel) {
    float ma = max3f(p0[0], p0[1], p0[2]), mb = max3f(p0[3], p0[4], p0[5]), mc = max3f(p0[6], p0[7], p0[8]), md = max3f(p0[9], p0[10], p0[11]);
    ma = max3f(ma, p0[12], p0[13]); mb = max3f(mb, p0[14], p0[15]); mc = max3f(mc, p1[0], p1[1]); md = max3f(md, p1[2], p1[3]);
    ma = max3f(ma, p1[4], p1[5]); mb = max3f(mb, p1[6], p1[7]); mc = max3f(mc, p1[8], p1[9]); md = max3f(md, p1[10], p1[11]);
    ma = max3f(ma, p1[12], p1[13]); mb = max3f(mb, p1[14], p1[15]);
    float pmax = fmaxf(max3f(ma, mb, mc), md);
    if (use_rowsel && !rowsel) pmax = -__builtin_inff();
    { auto rr = __builtin_amdgcn_permlane32_swap(__float_as_uint(pmax), __float_as_uint(pmax), false, false); pmax = fmaxf(__uint_as_float(rr[0]), __uint_as_float(rr[1])); }
    float alpha = 1.f;
    if (!__all(pmax <= AT_THR)) {
        const float d = fmaxf(pmax, 0.f); alpha = __builtin_amdgcn_exp2f(-d); m_reg += d;
#pragma unroll
        for (int r = 0; r < 16; ++r) { p0[r] -= d; p1[r] -= d; negm[r] = -m_reg; }
    }
    float s0 = 0.f, s1 = 0.f, s2 = 0.f, s3 = 0.f;
#pragma unroll
    for (int r = 0; r < 16; r += 4) { p0[r] = __builtin_amdgcn_exp2f(p0[r]); p0[r + 1] = __builtin_amdgcn_exp2f(p0[r + 1]); p0[r + 2] = __builtin_amdgcn_exp2f(p0[r + 2]); p0[r + 3] = __builtin_amdgcn_exp2f(p0[r + 3]);
        s0 += p0[r]; s1 += p0[r + 1]; s2 += p0[r + 2]; s3 += p0[r + 3]; }
#pragma unroll
    for (int r = 0; r < 16; r += 4) { p1[r] = __builtin_amdgcn_exp2f(p1[r]); p1[r + 1] = __builtin_amdgcn_exp2f(p1[r + 1]); p1[r + 2] = __builtin_amdgcn_exp2f(p1[r + 2]); p1[r + 3] = __builtin_amdgcn_exp2f(p1[r + 3]);
        s0 += p1[r]; s1 += p1[r + 1]; s2 += p1[r + 2]; s3 += p1[r + 3]; }
    float ps = (s0 + s1) + (s2 + s3);
    if (use_rowsel && !rowsel) ps = 0.f;
    { auto rr = __builtin_amdgcn_permlane32_swap(__float_as_uint(ps), __float_as_uint(ps), false, false); ps = __uint_as_float(rr[0]) + __uint_as_float(rr[1]); }
    l_reg = l_reg * alpha + ps;
    const unsigned keep = (use_rowsel && !rowsel) ? 0u : 0xffffffffu;
#define PK4(P, B_, OUT) do { unsigned a0 = cvtpk(P[B_+0], P[B_+1]), a1 = cvtpk(P[B_+2], P[B_+3]); unsigned b0 = cvtpk(P[B_+4], P[B_+5]), b1 = cvtpk(P[B_+6], P[B_+7]); \
        if (use_rowsel) { a0 &= keep; a1 &= keep; b0 &= keep; b1 &= keep; } \
        auto r0 = __builtin_amdgcn_permlane32_swap(a0, b0, false, false); auto r1 = __builtin_amdgcn_permlane32_swap(a1, b1, false, false); \
        v4u w = {r0[0], r1[0], r0[1], r1[1]}; OUT = __builtin_bit_cast(bf16x8, w); } while (0)
    PK4(p0, 0, pa0); PK4(p0, 8, pa1); PK4(p1, 0, pa2); PK4(p1, 8, pa3);
#undef PK4
    return alpha;
}
template <int MODE>
__device__ __forceinline__ void at_mask(f32x16& p0, f32x16& p1, int kb, int hi, int tq, int lim, bool rowsel) {
    const float NEG = -__builtin_inff();
#pragma unroll
    for (int r = 0; r < 16; ++r) { const int k0 = kb + (r & 3) + 8 * (r >> 2) + 4 * hi, k1 = k0 + 32;
        bool v0, v1;
        if (MODE == 0) { v0 = k0 <= lim; v1 = k1 <= lim; }
        else if (MODE == 1) { v0 = rowsel && k0 <= tq; v1 = rowsel && k1 <= tq; }
        else { v0 = (unsigned)(tq - k0) < (unsigned)WIN; v1 = (unsigned)(tq - k1) < (unsigned)WIN; }
        if (!v0) p0[r] = NEG; if (!v1) p1[r] = NEG; }
}
template <int MODE>
__device__ __forceinline__ void at_branch(LAS unsigned char* lds, const bf16x8 (&qr)[8], const bf16* Kb, const bf16* Vb, int ld, int jlo, int NT, int tq, int lim, const LAS unsigned* bmrow,
                                          bf16* Obase, float& m_out, float& l_out, int tid_in) {
    int tid = tid_in; asm volatile("" : "+v"(tid));
    const int lane = tid & 63, wave = __builtin_amdgcn_readfirstlane(tid >> 6), l32 = lane & 31, hi = lane >> 5;
    LAS unsigned char* K_lds = lds + AT_K; LAS unsigned char* V_lds = lds + AT_V;
    LAS float* wsl = (LAS float*)(lds + AT_WS) + wave * 64;
    const int vb0 = (int)(unsigned)(size_t)V_lds + v_rd_base(lane);
    const int ksr = tid >> 4, kslc = (tid & 15) ^ (ksr & 7);
    const int vkk = (tid >> 7) * 8 + ((tid & 31) >> 2), vk = (vkk & ~0xC) | ((vkk & 4) << 1) | ((vkk & 8) >> 1), vc = ((tid >> 5) & 3) * 32 + (tid & 3) * 8;
    const char* ksrc = (const char*)(Kb + (size_t)ksr * ld + 8 * kslc); const char* vsrc = (const char*)(Vb + (size_t)vk * ld + vc);
    const size_t half_b = (size_t)32 * ld * 2, tile_b = (size_t)64 * ld * 2; const unsigned ldsw = (unsigned)wave * 1024u;
#define AT_ISSUE(j, stg) do { const size_t jo_ = (size_t)(j) * tile_b; \
        __builtin_amdgcn_global_load_lds((const GAS unsigned*)(ksrc + jo_), (LAS unsigned*)(K_lds + (stg) * 16384 + ldsw), 16, 0, 0); \
        __builtin_amdgcn_global_load_lds((const GAS unsigned*)(ksrc + jo_ + half_b), (LAS unsigned*)(K_lds + (stg) * 16384 + 8192 + ldsw), 16, 0, 0); \
        __builtin_amdgcn_global_load_lds((const GAS unsigned*)(vsrc + jo_), (LAS unsigned*)(V_lds + (stg) * 16384 + ldsw), 16, 0, 0); \
        __builtin_amdgcn_global_load_lds((const GAS unsigned*)(vsrc + jo_ + half_b), (LAS unsigned*)(V_lds + (stg) * 16384 + 8192 + ldsw), 16, 0, 0); } while (0)
    float m_reg = -1e4f, l_reg = 0.f; f32x16 o[4] = {};
    f32x16 negm;
#pragma unroll
    for (int r = 0; r < 16; ++r) negm[r] = 1e4f;
    const int tq_min = __builtin_amdgcn_readfirstlane(tq), lim_min = (tq_min - 31) >> 4;
    asm volatile("s_waitcnt vmcnt(0) lgkmcnt(0)" ::: "memory"); __builtin_amdgcn_s_barrier(); asm volatile("" ::: "memory");
    AT_ISSUE(jlo, 0); if (NT > 1) AT_ISSUE(jlo + 1, 1);
    int stg = 0;
    for (int t = 0; t < NT; ++t) {
        const int j = jlo + t; const int buf = stg;
        if (t + 1 < NT) asm volatile("s_waitcnt vmcnt(4)" ::: "memory"); else asm volatile("s_waitcnt vmcnt(0)" ::: "memory");
        __builtin_amdgcn_s_barrier(); asm volatile("" ::: "memory");
        if (t + 2 < NT) { const int s2 = stg == 0 ? 2 : stg - 1; AT_ISSUE(j + 2, s2); }
        bool rowsel = true;
        if (MODE == 1) rowsel = ((bmrow[j >> 5] >> (j & 31)) & 1u) != 0u;
        if (MODE != 1 || __any(rowsel)) {
        f32x16 p0, p1;
        at_qkt(p0, p1, K_lds + buf * 16384, l32, hi, qr, negm);
        const bool need_mask = MODE == 0 ? (64 * j + 63 > lim_min) : (MODE == 1 ? (64 * j + 63 > tq_min) : (64 * j + 63 > tq_min || 64 * j <= tq_min + 7 - WIN));
        if (need_mask) at_mask<MODE>(p0, p1, 64 * j, hi, tq, lim, true);
        bf16x8 pa0, pa1, pa2, pa3;
        const float alpha = at_softmax(p0, p1, m_reg, negm, l_reg, pa0, pa1, pa2, pa3, rowsel, MODE == 1);
        if (__any(alpha < 1.f)) { if (hi == 0) wsl[l32] = alpha; asm volatile("s_waitcnt lgkmcnt(0)" ::: "memory");
#pragma unroll
            for (int d = 0; d < 4; ++d)
#pragma unroll
                for (int r = 0; r < 16; ++r) o[d][r] *= wsl[crow(r, hi)]; }
        at_pv(o, vb0 + buf * 16384, pa0, pa1, pa2, pa3);
        }
        stg = stg == 2 ? 0 : stg + 1;
    }
    asm volatile("s_waitcnt lgkmcnt(0)" ::: "memory");
    if (hi == 0) wsl[32 + l32] = l_reg > 0.f ? 1.f / l_reg : 0.f;
    asm volatile("s_waitcnt lgkmcnt(0)" ::: "memory");
#pragma unroll
    for (int r = 0; r < 16; ++r) { const int q = crow(r, hi); const float rli = wsl[32 + q]; bf16* op = Obase + (size_t)(8 * wave + (q >> 2)) * 2048 + (q & 3) * 128 + l32;
#pragma unroll
        for (int d0 = 0; d0 < 4; ++d0) op[d0 * 32] = (bf16)f2bf(o[d0][r] * rli); }
    m_out = m_reg; l_out = l_reg;
#undef AT_ISSUE
}
__device__ __forceinline__ void at_importance(LAS unsigned char* lds, const bf16x8 (&qr)[8], const bf16* Kb, int nct, int lim, float m_reg, float l_reg, int tid_in) {
    int tid = tid_in; asm volatile("" : "+v"(tid));
    const int lane = tid & 63, wave = __builtin_amdgcn_readfirstlane(tid >> 6), l32 = lane & 31, hi = lane >> 5;
    LAS unsigned char* K_lds = lds + AT_K;
    LAS float* S4L = (LAS float*)(lds + AT_V); LAS float* LASTL = (LAS float*)(lds + AT_V + 16384);
    LAS float* imp = (LAS float*)(lds + AT_IMP); LAS float* carry = (LAS float*)(lds + AT_CARRY);
    const int sr = tid >> 4, sc = (tid & 15) * 8, kws = KSWZ(sr, sc * 2);
    const int head = l32 & 3, tok = 8 * wave + (l32 >> 2);
    const float linv = l_reg > 0.f ? 1.f / l_reg : 0.f; const f32x16 zero16 = {};
    bf16x8 st_k0, st_k1;
    __syncthreads();
    if (tid < 256) carry[tid] = 0.f;
    { const bf16* kp_ = Kb + (size_t)sr * 128 + sc; st_k0 = *(const GAS bf16x8*)kp_; st_k1 = *(const GAS bf16x8*)(kp_ + 32 * 128); }
    *(LAS bf16x8*)(K_lds + kws) = st_k0; *(LAS bf16x8*)(K_lds + kws + 32 * 256) = st_k1;
    __syncthreads();
    for (int t = 0; t < nct; ++t) {
        const int buf = t & 1;
        if (t + 1 < nct) { const bf16* kp_ = Kb + (size_t)(64 * (t + 1) + sr) * 128 + sc; st_k0 = *(const GAS bf16x8*)kp_; st_k1 = *(const GAS bf16x8*)(kp_ + 32 * 128); }
        f32x16 p0, p1;
        at_qkt(p0, p1, K_lds + buf * 16384, l32, hi, qr, zero16);
        at_mask<0>(p0, p1, 64 * t, hi, 0, lim, true);
#pragma unroll
        for (int r = 0; r < 16; ++r) { p0[r] = __builtin_amdgcn_exp2f(p0[r] - m_reg) * linv; p1[r] = __builtin_amdgcn_exp2f(p1[r] - m_reg) * linv; }
        LAS float* sp = S4L + (head * 64 + tok) * 16 + hi; LAS float* lp = LASTL + (head * 64 + tok) * 16 + hi;
#pragma unroll
        for (int q = 0; q < 4; ++q) { sp[2 * q] = (p0[4 * q] + p0[4 * q + 1]) + (p0[4 * q + 2] + p0[4 * q + 3]); lp[2 * q] = p0[4 * q + 3];
                                      sp[8 + 2 * q] = (p1[4 * q] + p1[4 * q + 1]) + (p1[4 * q + 2] + p1[4 * q + 3]); lp[8 + 2 * q] = p1[4 * q + 3]; }
        if (t + 1 < nct) { *(LAS bf16x8*)(K_lds + (buf ^ 1) * 16384 + kws) = st_k0; *(LAS bf16x8*)(K_lds + (buf ^ 1) * 16384 + kws + 32 * 256) = st_k1; }
        __syncthreads();
#pragma unroll
        for (int i = 0; i < 2; ++i) { const int item = tid + 512 * i, tk = item >> 4, gq = item & 15; float a = 0.f;
#pragma unroll
            for (int h = 0; h < 4; ++h) a += S4L[(h * 64 + tk) * 16 + gq] + (gq > 0 ? LASTL[(h * 64 + tk) * 16 + gq - 1] : carry[(t & 1) * 256 + h * 64 + tk]);
            imp[tk * AT_IMPLD + 16 * t + gq] = a; }
        if (tid < 256) carry[((t + 1) & 1) * 256 + tid] = LASTL[tid * 16 + 15];
        __syncthreads();
    }
}
__device__ __forceinline__ void at_topk(LAS unsigned char* lds, int tb, int tid_in) {
    int tid = tid_in; asm volatile("" : "+v"(tid));
    const int lane = tid & 63, wave = __builtin_amdgcn_readfirstlane(tid >> 6);
    const LAS float* imp = (const LAS float*)(lds + AT_IMP); LAS unsigned* bm = (LAS unsigned*)(lds + AT_BM);
    const int nforced = tb >= 2 ? 3 : tb + 1, nfree = SELTOP - nforced, ncand = tb - 2 > 0 ? tb - 2 : 0;
    const int j0 = lane, j1 = lane + 64;
    const bool c0 = j0 >= 1 && j0 <= tb - 2, c1 = j1 <= tb - 2;
    const bool f0 = (j0 == 0) || (j0 == tb) || (j0 == tb - 1), f1 = (j1 == tb) || (j1 == tb - 1);
    for (int i = 0; i < 8; ++i) { const int tk = wave * 8 + i;
        const unsigned k0 = c0 ? __float_as_uint(imp[tk * AT_IMPLD + j0]) + 1u : 0u, k1 = c1 ? __float_as_uint(imp[tk * AT_IMPLD + j1]) + 1u : 0u;
        bool s0, s1;
        if (ncand <= nfree) { s0 = c0; s1 = c1; }
        else {
            unsigned T = 0u;
            for (int b = 31; b >= 0; --b) { const unsigned cnd = T | (1u << b); const int cnt = __popcll(__ballot(k0 >= cnd)) + __popcll(__ballot(k1 >= cnd)); if (cnt >= nfree) T = cnd; }
            const bool g0 = k0 > T, g1 = k1 > T; const int ngt = __popcll(__ballot(g0)) + __popcll(__ballot(g1)); const int need = nfree - ngt;
            const unsigned long long e0 = __ballot(k0 == T), e1 = __ballot(k1 == T); const unsigned long long below = (1ull << lane) - 1ull;
            const int rk0 = __popcll(e0 & below), rk1 = __popcll(e0) + __popcll(e1 & below);
            s0 = g0 || (k0 == T && rk0 < need); s1 = g1 || (k1 == T && rk1 < need);
        }
        const unsigned long long m0 = __ballot(s0 || f0), m1 = __ballot(s1 || f1);
        if (lane == 0) { bm[tk * 4 + 0] = (unsigned)m0; bm[tk * 4 + 1] = (unsigned)(m0 >> 32); bm[tk * 4 + 2] = (unsigned)m1; bm[tk * 4 + 3] = (unsigned)(m1 >> 32); }
    }
}
__device__ __forceinline__ void attn_unit(LAS unsigned char* lds, int g, int tb, const bf16* PROJ, const bf16* KC, const bf16* VC, bf16* AO, int tid) {
    const int lane = tid & 63, wave = __builtin_amdgcn_readfirstlane(tid >> 6), l32 = lane & 31, hi = lane >> 5;
    const int tokl = 8 * wave + (l32 >> 2), head = 4 * g + (l32 & 3), T0 = 64 * tb, tq = T0 + tokl;
    bf16x8 qr[8];
#pragma unroll
    for (int d0 = 0; d0 < 8; ++d0) qr[d0] = *(const GAS bf16x8*)(PROJ + (size_t)tq * NPROJ + OFF_Q + head * 128 + d0 * 16 + hi * 8);
    bf16* Orow0 = AO + (size_t)T0 * 2048 + 4 * g * 128;
    const int nct = tb / 16 + 1; const int lim = (tq - 31) >> 4;
    float m_c, l_c, m_d, l_d;
    at_branch<0>(lds, qr, KC + (size_t)g * 512 * 128, VC + (size_t)g * 512 * 128, 128, 0, nct, tq, lim, nullptr, Orow0, m_c, l_c, tid);
    at_importance(lds, qr, KC + (size_t)g * 512 * 128, nct, lim, m_c, l_c, tid);
    __syncthreads();
    at_topk(lds, tb, tid);
    __syncthreads();
    const LAS unsigned* bmrow = (const LAS unsigned*)(lds + AT_BM) + tokl * 4;
    at_branch<1>(lds, qr, PROJ + OFF_KS + g * 128, PROJ + OFF_VS + g * 128, NPROJ, 0, tb + 1, tq, 0, bmrow, Orow0 + (size_t)S * 2048, m_d, l_d, tid);
    const int jlo = tb - 8 > 0 ? tb - 8 : 0;
    at_branch<2>(lds, qr, PROJ + OFF_KW + g * 128, PROJ + OFF_VW + g * 128, NPROJ, jlo, tb - jlo + 1, tq, 0, nullptr, Orow0 + (size_t)2 * S * 2048, m_d, l_d, tid);
    __syncthreads();
}


constexpr int CM_RED = 0, CM_H = 16384, CM_HLD = 136;
constexpr int CM_STG = 8192 + 32768, CM_NSTG = 3;
static_assert(CM_NSTG * CM_STG <= 131072, "compression ring");
__device__ __forceinline__ void cmp_unit(LAS unsigned char* lds, int kv, int g, int ib, const bf16* PROJ, const bf16* W1T, const bf16* W2T, const float* B1P, bf16* OUT, int tid_in) {
    int tid = tid_in; asm volatile("" : "+v"(tid));
    const int lane = tid & 63, wave = __builtin_amdgcn_readfirstlane(tid >> 6), l32 = lane & 31, hi = lane >> 5, nt = wave & 3, kh = wave >> 2;
    LAS float* red = (LAS float*)(lds + CM_RED); LAS bf16* Hs = (LAS bf16*)(lds + CM_H);
    const int coff = (kv == 0 ? OFF_KC : OFF_VC) + g * 128;
    const int sr = tid >> 4, spc = tid & 15, slc = spc ^ (sr & 7);
    const int ia = 32 * ib + sr, iac = ia < 510 ? ia : 510;
    const char* asrc = (const char*)(PROJ + (size_t)(16 * iac) * NPROJ + coff + 8 * slc);
    const char* bsrc = (const char*)(W1T + (size_t)sr * 4096 + 8 * slc);
    const unsigned ldsw = (unsigned)wave * 1024u;
#define CM_ISSUE(l_, stg_) do { LAS unsigned char* sb_ = lds + (stg_) * CM_STG; \
        __builtin_amdgcn_global_load_lds((const unsigned*)(asrc + (size_t)(l_) * (NPROJ * 2)), (LAS unsigned*)(sb_ + ldsw), 16, 0, 0); \
        _Pragma("unroll") for (int q_ = 0; q_ < 4; ++q_) \
            __builtin_amdgcn_global_load_lds((const unsigned*)(bsrc + (size_t)q_ * (32 * 4096 * 2) + (size_t)(l_) * 256), (LAS unsigned*)(sb_ + 8192 + q_ * 8192 + ldsw), 16, 0, 0); } while (0)
    f32x16 acc = {};
    asm volatile("s_waitcnt vmcnt(0) lgkmcnt(0)" ::: "memory"); __builtin_amdgcn_s_barrier();
    CM_ISSUE(0, 0); CM_ISSUE(1, 1);
    const int sw = l32 & 7;
    for (int l = 0; l < 32; ++l) { const int stg = l % CM_NSTG;
        if (l + 1 < 32) asm volatile("s_waitcnt vmcnt(5)" ::: "memory"); else asm volatile("s_waitcnt vmcnt(0)" ::: "memory");
        __builtin_amdgcn_s_barrier(); asm volatile("" ::: "memory");
        if (l + 2 < 32) CM_ISSUE(l + 2, (l + 2) % CM_NSTG);
        const LAS unsigned char* ap = lds + stg * CM_STG + l32 * 256; const LAS unsigned char* bp = lds + stg * CM_STG + 8192 + (32 * nt + l32) * 256;
#pragma unroll
        for (int kk = 0; kk < 4; ++kk) { const int c = (2 * (4 * kh + kk) + hi) ^ sw;
            const bf16x8 a = *(const LAS bf16x8*)(ap + 16 * c), b = *(const LAS bf16x8*)(bp + 16 * c); acc = __builtin_amdgcn_mfma_f32_32x32x16_bf16(a, b, acc, 0, 0, 0); }
    }
#undef CM_ISSUE
    asm volatile("s_waitcnt lgkmcnt(0)" ::: "memory"); __builtin_amdgcn_s_barrier(); asm volatile("" ::: "memory");
    if (kh == 1) {
#pragma unroll
        for (int r = 0; r < 16; ++r) red[(nt * 16 + r) * 64 + lane] = acc[r]; }
    __syncthreads();
    if (kh == 0) { const int n = 32 * nt + l32; float b1 = 0.f;
#pragma unroll
        for (int kc = 0; kc < 16; ++kc) b1 += B1P[kc * 128 + n];
#pragma unroll
        for (int r = 0; r < 16; ++r) { float v = acc[r] + red[(nt * 16 + r) * 64 + lane] + b1; v = v / (1.f + __expf(-v)); Hs[crow(r, hi) * CM_HLD + n] = (bf16)f2bf(v); } }
    __syncthreads();
    if (wave < 4) { f32x16 a2 = {};
#pragma unroll
        for (int kk = 0; kk < 8; ++kk) { const bf16x8 a = *(const LAS bf16x8*)(Hs + l32 * CM_HLD + 16 * kk + 8 * hi), b = *(const GAS bf16x8*)(W2T + (size_t)(32 * wave + l32) * 128 + 16 * kk + 8 * hi);
            a2 = __builtin_amdgcn_mfma_f32_32x32x16_bf16(a, b, a2, 0, 0, 0); }
#pragma unroll
        for (int r = 0; r < 16; ++r) { const int irow = 32 * ib + crow(r, hi); OUT[(size_t)irow * 128 + 32 * wave + l32] = irow < NCMP ? (bf16)f2bf(a2[r]) : (bf16)0; } }
    __syncthreads();
}

struct Args { const float* in[18]; float* out; unsigned char* ws; };


__global__ void __launch_bounds__(NWAVES * 64, 2) hybrid_fwd(Args args) {
    extern __shared__ __attribute__((aligned(16))) unsigned char lds[];
    Frame F;
    F.lds = (LAS unsigned char*)lds;
    F.MISC = (volatile LAS unsigned*)(F.lds + MISC_OFF);
    F.tid = threadIdx.x; F.lane = F.tid & 63; F.wave = __builtin_amdgcn_readfirstlane(F.tid >> 6);
    F.G = gridDim.x; { const int bx = blockIdx.x; F.vcu = (F.G % 8 == 0) ? (bx % 8) * (F.G / 8) + bx / 8 : bx; }
    unsigned char* ws = args.ws;
    F.ctl = (gu32*)(ws + WS_CTL);
    for (int u = F.tid; u < (LDS_BYTES - LDSCTL_OFF) / 4; u += NWAVES * 64) ((LAS unsigned*)(F.lds + LDSCTL_OFF))[u] = 0u;
    __syncthreads();
    (void)xcd_barrier_post((unsigned*)(F.ctl + CW_BAR), F.MISC + 8);
#define GRID_BAR() do { unsigned long long wz_ = 0; asm volatile("" : "+s"(wz_)); unsigned char* wsb_ = args.ws + wz_;     XcdBarrier b_; b_.bar = (unsigned*)((gu32*)(wsb_ + WS_CTL) + CW_BAR); b_.x = xb_xcc_id(); b_.st = (volatile LAS unsigned*)(F.lds + MISC_OFF) + 8; xcd_barrier(b_); } while (0)
#define PHASE_IDS() int tid_l_ = threadIdx.x; asm volatile("" : "+v"(tid_l_)); const int tid = tid_l_, lane = tid & 63, wave = __builtin_amdgcn_readfirstlane(tid >> 6); \
    const int gw = F.vcu * NWAVES + wave, NGW = F.G * NWAVES, gt = F.vcu * (NWAVES * 64) + tid, NGT = F.G * NWAVES * 64; (void)gw; (void)NGW; (void)gt; (void)NGT; (void)lane

    const float* x_in = args.in[0];
    bf16* XN = (bf16*)(ws + WS_XN); float* COS = (float*)(ws + WS_COS); float* SIN = (float*)(ws + WS_SIN);
    {
        PHASE_IDS();
        LAS float* scr = (LAS float*)(F.lds + RING_OFF + wave * 16384);
        constexpr int I_IN = (DM / 64) * (NPROJ / 32), I_O = (DM / 64) * (DM / 32), I_UP = (DM / 64) * (FF / 32), I_DN = (FF / 64) * (DM / 32);
        constexpr int I_L = I_IN + I_O + I_UP + I_DN;
        for (int rep = 0; rep < REP_PRO; ++rep)
        for (int it = gw; it < DEPTH * I_L; it += NGW) {
            const int l = it / I_L; int r = it % I_L;
            if (r < I_IN) { if (l >= PROJ_F8_FROM) p0_transpose_item_f8<true, 1>(args.in[2] + (size_t)l * DM * NSRC, DM, NSRC, NPROJ / 32, (unsigned char*)(ws + WS_WIN + l * SZ_WIN), WUP8_SCALE, args.in[1] + l * DM, args.in[1] + l * DM, DM, scr, r, lane);
                else p0_transpose_item<1, true>(args.in[2] + (size_t)l * DM * NSRC, DM, NSRC, NPROJ / 32, (bf16*)(ws + WS_WIN + l * SZ_WIN), args.in[1] + l * DM, args.in[1] + l * DM, DM, scr, r, lane); continue; } r -= I_IN;
            if (r < I_O) { if (l >= WO_F8_FROM) p0_transpose_item_f8<true>(args.in[13] + (size_t)l * DM * DM, DM, DM, DM / 32, (unsigned char*)(ws + WS_WO + l * SZ_WO), 64.f, args.in[6] + l * 2048, args.in[12] + l * 2048, 2048, scr, r, lane);
                else p0_transpose_item<0, true>(args.in[13] + (size_t)l * DM * DM, DM, DM, DM / 32, (bf16*)(ws + WS_WO + l * SZ_WO), args.in[6] + l * 2048, args.in[12] + l * 2048, 2048, scr, r, lane); continue; } r -= I_O;
            if (r < I_UP) { p0_transpose_item_f8<true>(args.in[15] + (size_t)l * DM * FF, DM, FF, FF / 32, (unsigned char*)(ws + WS_WUP + l * SZ_WUP), WUP8_SCALE, args.in[14] + l * DM, args.in[14] + l * DM, DM, scr, r, lane); continue; } r -= I_UP;
            p0_transpose_item_f8<false>(args.in[16] + (size_t)l * FF * DM, FF, DM, DM / 32, (unsigned char*)(ws + WS_WDN + l * SZ_WDN), 128.f, args.in[16], args.in[16], 0, scr, r, lane);
        }
        for (int it = gw; it < DEPTH * 2 * (256 + 8); it += NGW) { const int lk = it / 264, r = it % 264, kvv = lk & 1;
            const float* w1 = args.in[4] + (size_t)lk * 4096 * 128; const float* w2 = args.in[5] + (size_t)lk * 128 * 128;
            bf16* w1t = (bf16*)(ws + WS_W1T) + (size_t)lk * 128 * 4096; bf16* w2t = (bf16*)(ws + WS_W2T) + (size_t)lk * 128 * 128;
            if (r < 256) { if (kvv == 0) p0_transpose_item<0, false, true>(w1, 4096, 128, 4, w1t, w1, w1, 0, scr, r, lane); else p0_transpose_item<0, false, false>(w1, 4096, 128, 4, w1t, w1, w1, 0, scr, r, lane); }
            else { if (kvv == 0) p0_transpose_item<2, false, false>(w2, 128, 128, 4, w2t, w2, w2, 0, scr, r - 256, lane); else p0_transpose_item<0, false, false>(w2, 128, 128, 4, w2t, w2, w2, 0, scr, r - 256, lane); } }
        for (int e = gt; e < DEPTH * 2 * 16 * 128; e += NGT) { const int n = e & 127, kc = (e >> 7) & 15, lk = e >> 11;
            const float* w1 = args.in[4] + ((size_t)lk * 4096 + kc * 256) * 128 + n; const float* ps = args.in[3] + (size_t)lk * 4096 + kc * 256; float a = 0.f;
#pragma unroll 32
            for (int k = 0; k < 256; ++k) a += ps[k] * w1[(size_t)k * 128];
            ((float*)(ws + WS_B1P))[e] = a; }
        for (int e = gt; e < S * 64; e += NGT) { const int t = e >> 6, i = e & 63;
            const float inv = 1.0f / powf(10000.0f, (float)i * (1.0f / 64.0f)); const float ang = (float)t * inv;
            COS[e] = cosf(ang); SIN[e] = sinf(ang); }
        if (F.G == 256) { rms2f_to_bf16(x_in, XN, gw, NGW, lane); rms2f_to_bf16(x_in, XN, gw + 2 * NGW, NGW, lane); }
        else for (int m = gw; m < S; m += NGW) rms_row_to_bf16(x_in + (size_t)m * DM, XN + (size_t)m * DM, lane);
    }
    GRID_BAR();

    for (int L = 0; L < DEPTH; ++L) {
        { unsigned long long wz = 0; asm volatile("" : "+s"(wz)); ws = args.ws + wz; }
        bf16* Hres = (bf16*)(ws + WS_H);     static_assert(DEPTH == 2 && WO_F8_FROM == 1 && PROJ_F8_FROM == 1, "the phase instantiations below are written for this precision plan");
        bf16* XN = (bf16*)(ws + WS_XN); bf16* PROJ = (bf16*)(ws + WS_PROJ); bf16* ACT = (bf16*)(ws + WS_ACT); unsigned char* CAT = (unsigned char*)(ws + WS_CAT);     const bool wo_f8 = L >= WO_F8_FROM;
        float* ATT = (float*)(ws + WS_ATT); bf16* XBC = (bf16*)(ws + WS_XBC); bf16* Y = (bf16*)(ws + WS_Y);
        bf16* KC = (bf16*)(ws + WS_KC); bf16* VC = (bf16*)(ws + WS_VC); float* DT = (float*)(ws + WS_DT); float* ADT = (float*)(ws + WS_ADT);
        float* COS = (float*)(ws + WS_COS); float* SIN = (float*)(ws + WS_SIN); unsigned* BMP = (unsigned*)(ws + WS_BMP);
        bf16* AO = (bf16*)(ws + WS_ACT);     float* STT = (float*)(ws + WS_ST); bf16* PREVB = (bf16*)(ws + WS_PREV);     float* ACSG = (float*)(ws + WS_ACSG); float* DEC = (float*)(ws + WS_DEC);

        {
            const bool split = (L < PROJ_F8_FROM) && (F.G == 256);
            if (L >= PROJ_F8_FROM) { pg8::StaticOrder So; So.init(S, NPROJ, F.G, (int)blockIdx.x); pg8::Gemm g{XN, (const bf16*)(ws + WS_WIN + L * SZ_WIN), S, NPROJ, DM / 2};
                pg8::EpiProj E{PROJ, NPROJ, COS, SIN, QSCALE, 1.f / (XN8_SCALE * WUP8_SCALE), 0};
                pg8::gemm_phase<pg8::EpiProj, pg8::StaticOrder, true, true, true>(F.lds + RING_OFF, g, So, E); }
            else {
#pragma unroll 1
                for (int part = 0; part < (split ? 2 : 1); ++part) { const int c0p = part ? P1_SPLIT : 0, ncp = split ? (part ? NPROJ - P1_SPLIT : P1_SPLIT) : NPROJ;
                    pg8::StaticOrder So; So.init(S, ncp, F.G, (int)blockIdx.x); pg8::Gemm g{XN, (const bf16*)(ws + WS_WIN + L * SZ_WIN) + (size_t)c0p * DM, S, ncp, DM};
                    pg8::EpiProj E{PROJ, NPROJ, COS, SIN, QSCALE, 1.f, c0p / 256};
                    pg8::gemm_phase<pg8::EpiProj, pg8::StaticOrder, true, true>(F.lds + RING_OFF, g, So, E);
                    if (split && part == 0) GRID_BAR(); } }
        }
        {
            const bool split = (L < PROJ_F8_FROM) && (F.G == 256); const int bxp = bx_l(); const bool early = split && bxp >= (NPROJ - P1_SPLIT) / 256 * 32;
            const int ew = ((F.vcu >> 5) * 12 + ((F.vcu & 31) - 20));
#pragma unroll 1
            for (int pass = 0; pass < 2; ++pass) {
                const bool run = pass == 0 ? early : !split;
                if (run) {
                    PHASE_IDS();
#pragma unroll 1
                    for (int pv = (pass == 0 ? ew : F.vcu); pv < (pass == 0 ? 256 : F.vcu + 1); pv += 96) {
                        asm volatile("s_waitcnt vmcnt(0) lgkmcnt(0)" ::: "memory"); __syncthreads();
            for (int rep = 0; rep < REP_CMP; ++rep)
            for (int u = pv; u < 2 * NKV * 16; u += F.G) { const int kvv = u >> 6, g = (u >> 4) & 3, ib = u & 15; const int lk = L * 2 + kvv;
                cmp_unit(F.lds + RING_OFF, kvv, g, ib, PROJ, (const bf16*)(ws + WS_W1T) + (size_t)lk * 128 * 4096, (const bf16*)(ws + WS_W2T) + (size_t)lk * 128 * 128,
                         (const float*)(ws + WS_B1P) + (size_t)lk * 16 * 128, (kvv == 0 ? KC : VC) + (size_t)g * 512 * 128, tid); }
            { const float* cvw = args.in[7] + (size_t)L * 4 * CONVD; const float* cvb = args.in[8] + (size_t)L * CONVD; const int c0 = 8 * tid;
              float wv[4][8], bv[8];
#pragma unroll
              for (int j = 0; j < 8; ++j) bv[j] = cvb[c0 + j];
#pragma unroll
              for (int k = 0; k < 4; ++k)
#pragma unroll
                  for (int j = 0; j < 8; ++j) wv[k][j] = cvw[k * CONVD + c0 + j];
              const bool cv_w = (F.G == 256); const int nblk = cv_w ? (pv < 128 ? 1 : 7) : 1, blk0 = cv_w ? (pv < 128 ? pv : 128 + 7 * (pv - 128)) : pv, bstep = cv_w ? 1 : F.G, bend = cv_w ? blk0 + nblk : S / 8;
              for (int rep = 0; rep < REP_CONV; ++rep)
              for (int blk = blk0; blk < bend; blk += bstep) { const int t0 = 8 * blk;
                v4u rw[11];
#pragma unroll
                for (int i = 0; i < 11; ++i) { const int tt = t0 - 3 + i; rw[i] = tt >= 0 ? *(const GAS v4u*)(PROJ + (size_t)tt * NPROJ + OFF_XBC + c0) : (v4u){0u, 0u, 0u, 0u}; }
#pragma unroll
                for (int o8 = 0; o8 < 8; ++o8) { float a[8];
#pragma unroll
                    for (int j = 0; j < 8; ++j) a[j] = bv[j];
#pragma unroll
                    for (int k = 0; k < 4; ++k) { const v4u w = rw[o8 + k];
                        const float f[8] = {bflo(w.x), bfhi(w.x), bflo(w.y), bfhi(w.y), bflo(w.z), bfhi(w.z), bflo(w.w), bfhi(w.w)};
#pragma unroll
                        for (int j = 0; j < 8; ++j) a[j] += f[j] * wv[k][j]; }
#pragma unroll
                    for (int j = 0; j < 8; ++j) a[j] = a[j] / (1.f + __expf(-a[j]));
                    v4u o; o.x = pk2(a[0], a[1]); o.y = pk2(a[2], a[3]); o.z = pk2(a[4], a[5]); o.w = pk2(a[6], a[7]);
                    *(GAS v4u*)(XBC + (size_t)(t0 + o8) * CONVD + c0) = o; } } }
                    }
                }
                if (pass == 0) { GRID_BAR(); for (int rb = 0; rb < REP_BAR; ++rb) GRID_BAR(); }
            }
        }
        if (!((L < PROJ_F8_FROM) && (F.G == 256))) GRID_BAR();
        {
            PHASE_IDS();
            for (int rep = 0; rep < REP_ATTN; ++rep)
            for (int u = F.vcu; u < 256; u += F.G) { const int g = u & 3, tbp = u >> 2;
#pragma unroll 1
                for (int uu = 0; uu < 2; ++uu) attn_unit(F.lds + RING_OFF, g, uu ? tbp : 127 - tbp, PROJ, KC, VC, AO, tid); }
        }
        __syncthreads();
        {
            PHASE_IDS();
            for (int rep = 0; rep < REP_SSD; ++rep)
            for (int u = F.vcu; u < NCHUNK * SSM_G; u += F.G) ssd1_unit(F.lds + RING_OFF, u >> 3, u & 7, XBC, PROJ, args.in[9] + L * 32, args.in[10] + L * 32, Y, STT, DEC, ACSG, tid);
        }
        GRID_BAR();
        {
            PHASE_IDS();
            if (F.G == 256) {
#pragma unroll 1
                for (int pr = 0; pr < 2; ++pr) {
                f32x4 v[2][8]; float sq[2];
#pragma unroll
                for (int i = 0; i < 2; ++i) { const int t = gw + (2 * pr + i) * NGW; float s = 0.f;
#pragma unroll
                    for (int j = 0; j < 8; ++j) { const int hd = 2 * j + (lane >> 5); const bf16* gp = PROJ + (size_t)t * NPROJ + OFF_G + hd;
                        const float g0 = 1.f / (1.f + __expf(-bf2f(gp[0]))), g1 = 1.f / (1.f + __expf(-bf2f(gp[16]))), g2 = 1.f / (1.f + __expf(-bf2f(gp[32])));
                        const size_t off = (size_t)t * 2048 + 256 * j + 4 * lane;
                        const unsigned long long u0 = *(const GAS unsigned long long*)(AO + off), u1 = *(const GAS unsigned long long*)(AO + (size_t)S * 2048 + off), u2 = *(const GAS unsigned long long*)(AO + (size_t)2 * S * 2048 + off);
                        const f32x4 a0 = {bflo((unsigned)u0), bfhi((unsigned)u0), bflo((unsigned)(u0 >> 32)), bfhi((unsigned)(u0 >> 32))}, a1 = {bflo((unsigned)u1), bfhi((unsigned)u1), bflo((unsigned)(u1 >> 32)), bfhi((unsigned)(u1 >> 32))},
                                    a2 = {bflo((unsigned)u2), bfhi((unsigned)u2), bflo((unsigned)(u2 >> 32)), bfhi((unsigned)(u2 >> 32))};
                        v[i][j] = a0 * g0 + a1 * g1 + a2 * g2; s += (v[i][j].x * v[i][j].x + v[i][j].y * v[i][j].y) + (v[i][j].z * v[i][j].z + v[i][j].w * v[i][j].w); }
                    sq[i] = s; }
                asm volatile("" ::: "memory");
#pragma unroll
                for (int i = 0; i < 2; ++i) { const int t = gw + (2 * pr + i) * NGW; const float rstd = 1.f / sqrtf(wave_sum(sq[i]) * (1.f / 2048.f) + EPS);
                    if (wo_f8) { GAS unsigned* o4 = (GAS unsigned*)(CAT + (size_t)t * DM) + lane;
#pragma unroll
                        for (int j = 0; j < 8; ++j) o4[64 * j] = pg8::pk4_fp8(v[i][j].x * rstd, v[i][j].y * rstd, v[i][j].z * rstd, v[i][j].w * rstd); }
                    else { GAS unsigned long long* o8 = (GAS unsigned long long*)((bf16*)CAT + (size_t)t * DM) + lane;
#pragma unroll
                        for (int j = 0; j < 8; ++j) o8[64 * j] = (unsigned long long)pk2(v[i][j].x * rstd, v[i][j].y * rstd) | ((unsigned long long)pk2(v[i][j].z * rstd, v[i][j].w * rstd) << 32); } }
                }
            } else
            for (int rep = 0; rep < REP_AN; ++rep)
            for (int t = gw; t < S; t += NGW) {
                f32x4 v[8]; float s = 0.f;
#pragma unroll
                for (int j = 0; j < 8; ++j) { const int hd = 2 * j + (lane >> 5); const bf16* gp = PROJ + (size_t)t * NPROJ + OFF_G + hd;
                    const float g0 = 1.f / (1.f + __expf(-bf2f(gp[0]))), g1 = 1.f / (1.f + __expf(-bf2f(gp[16]))), g2 = 1.f / (1.f + __expf(-bf2f(gp[32])));
                    const size_t off = (size_t)t * 2048 + 256 * j + 4 * lane;
                    const unsigned long long u0 = *(const GAS unsigned long long*)(AO + off), u1 = *(const GAS unsigned long long*)(AO + (size_t)S * 2048 + off), u2 = *(const GAS unsigned long long*)(AO + (size_t)2 * S * 2048 + off);
                    const f32x4 a0 = {bflo((unsigned)u0), bfhi((unsigned)u0), bflo((unsigned)(u0 >> 32)), bfhi((unsigned)(u0 >> 32))}, a1 = {bflo((unsigned)u1), bfhi((unsigned)u1), bflo((unsigned)(u1 >> 32)), bfhi((unsigned)(u1 >> 32))},
                                a2 = {bflo((unsigned)u2), bfhi((unsigned)u2), bflo((unsigned)(u2 >> 32)), bfhi((unsigned)(u2 >> 32))};
                    v[j] = a0 * g0 + a1 * g1 + a2 * g2; s += (v[j].x * v[j].x + v[j].y * v[j].y) + (v[j].z * v[j].z + v[j].w * v[j].w); }
                const float rstd = 1.f / sqrtf(wave_sum(s) * (1.f / 2048.f) + EPS);
                if (wo_f8) { GAS unsigned* o4 = (GAS unsigned*)(CAT + (size_t)t * DM) + lane;
#pragma unroll
                    for (int j = 0; j < 8; ++j) o4[64 * j] = pg8::pk4_fp8(v[j].x * rstd, v[j].y * rstd, v[j].z * rstd, v[j].w * rstd); }
                else { GAS unsigned long long* o8 = (GAS unsigned long long*)((bf16*)CAT + (size_t)t * DM) + lane;
#pragma unroll
                    for (int j = 0; j < 8; ++j) o8[64 * j] = (unsigned long long)pk2(v[j].x * rstd, v[j].y * rstd) | ((unsigned long long)pk2(v[j].z * rstd, v[j].w * rstd) << 32); }
            }
            for (int rep = 0; rep < REP_SCAN; ++rep)
            for (int e = gt; e < SSM_H * SSM_P * SSM_N; e += NGT) { const int h = e >> 13; float st = 0.f; float sv[NCHUNK], dv[NCHUNK];
#pragma unroll
                for (int c = 0; c < NCHUNK; ++c) { sv[c] = STT[(size_t)c * (SSM_H * SSM_P * SSM_N) + e]; dv[c] = DEC[c * 32 + h]; }
#pragma unroll
                for (int c = 0; c < NCHUNK; ++c) { PREVB[(size_t)c * (SSM_H * SSM_P * SSM_N) + e] = (bf16)f2bf(st); st = dv[c] * st + sv[c]; } }
        }
        GRID_BAR();
        {
            PHASE_IDS();
            const float* dsk = args.in[11] + L * 32;
            for (int rep = 0; rep < REP_SSD3; ++rep)
            for (int u = F.vcu; u < NCHUNK * SSM_G; u += F.G) ssd3_unit(F.lds + RING_OFF, u >> 3, u & 7, XBC, PROJ, Y, (bf16*)ATT, PREVB, ACSG, dsk, CAT, wo_f8, tid);
        }
        GRID_BAR();
        {
            pg8::StaticOrder So; So.init(S, DM, F.G, (int)blockIdx.x);
            if (wo_f8) { pg8::Gemm g{(const bf16*)CAT, (const bf16*)(ws + WS_WO + L * SZ_WO), S, DM, DM / 2};
                pg8::EpiResidH<false> E{Hres, (pg8::bf16_t*)Hres, DM, 1.f / 64.f};
                pg8::gemm_phase<pg8::EpiResidH<false>, pg8::StaticOrder, true, true, true>(F.lds + RING_OFF, g, So, E); }
            else { pg8::Gemm g{(const bf16*)CAT, (const bf16*)(ws + WS_WO + L * SZ_WO), S, DM, DM};
                pg8::EpiResidH<true> E{x_in, (pg8::bf16_t*)Hres, DM, 1.f};
                pg8::gemm_phase<pg8::EpiResidH<true>, pg8::StaticOrder, true, true>(F.lds + RING_OFF, g, So, E); }
        }
        GRID_BAR();
        { PHASE_IDS(); if (F.G == 256) rms4h_to_fp8(Hres, (unsigned char*)XN, gw, NGW, lane); else for (int m = gw; m < S; m += NGW) rms_rowh_to_fp8(Hres + (size_t)m * DM, (unsigned char*)XN + (size_t)m * DM, lane); }
        GRID_BAR();
        {
            pg8::Gemm g{XN, (const bf16*)(ws + WS_WUP + L * SZ_WUP), S, FF, DM / 2}; pg8::StaticOrder So; So.init(S, FF, F.G, (int)blockIdx.x);
            pg8::EpiRelu2F8 E{(unsigned char*)ACT, FF, 1.f / (XN8_SCALE * WUP8_SCALE)};
            for (int rep = 0; rep < REP_UP; ++rep)
            pg8::gemm_phase<pg8::EpiRelu2F8, pg8::StaticOrder, true, true, true>(F.lds + RING_OFF, g, So, E);
        }
        GRID_BAR();
        {
            pg8::Gemm g{ACT, (const bf16*)(ws + WS_WDN + L * SZ_WDN), S, DM, FF / 2}; pg8::StaticOrder So; So.init(S, DM, F.G, (int)blockIdx.x);
            pg8::EpiResidH<false> E{Hres, (pg8::bf16_t*)Hres, DM, 1.f / 128.f};
            pg8::gemm_phase<pg8::EpiResidH<false>, pg8::StaticOrder, true, true, true>(F.lds + RING_OFF, g, So, E);
        }
        GRID_BAR();
        if (L + 1 < DEPTH) { PHASE_IDS(); if (F.G == 256) rms4h_to_fp8(Hres, (unsigned char*)XN, gw, NGW, lane); else for (int m = gw; m < S; m += NGW) rms_rowh_to_fp8(Hres + (size_t)m * DM, (unsigned char*)XN + (size_t)m * DM, lane); GRID_BAR(); }
        else {
            PHASE_IDS();
            const float* nf = args.in[17];
            if (F.G == 256) { final2h(Hres, args.out, nf, gw, NGW, lane); final2h(Hres, args.out, nf, gw + 2 * NGW, NGW, lane); }
            else
            for (int m = gw; m < S; m += NGW) {
                const GAS v4u* xr = (const GAS v4u*)(Hres + (size_t)m * DM) + lane; v4u v[8]; float s = 0.f;
#pragma unroll
                for (int j = 0; j < 8; ++j) { v[j] = xr[64 * j]; const float a0 = bflo(v[j].x), a1 = bfhi(v[j].x), a2 = bflo(v[j].y), a3 = bfhi(v[j].y), a4 = bflo(v[j].z), a5 = bfhi(v[j].z), a6 = bflo(v[j].w), a7 = bfhi(v[j].w);
                    s += ((a0 * a0 + a1 * a1) + (a2 * a2 + a3 * a3)) + ((a4 * a4 + a5 * a5) + (a6 * a6 + a7 * a7)); }
                const float rstd = 1.f / sqrtf(wave_sum(s) * (1.f / DM) + EPS);
                GAS f32x4* o4 = (GAS f32x4*)(args.out + (size_t)m * DM) + 2 * lane; const GAS f32x4* w4 = (const GAS f32x4*)nf + 2 * lane;
#pragma unroll
                for (int j = 0; j < 8; ++j) { const f32x4 g0 = w4[128 * j], g1 = w4[128 * j + 1];
                    o4[128 * j] = (f32x4){bflo(v[j].x), bfhi(v[j].x), bflo(v[j].y), bfhi(v[j].y)} * rstd * g0; o4[128 * j + 1] = (f32x4){bflo(v[j].z), bfhi(v[j].z), bflo(v[j].w), bfhi(v[j].w)} * rstd * g1; }
            }
        }
    }
}

extern "C" void kernel_launch(void* const* d_in, const int* in_sizes, int n_in, void* d_out, int out_size, void* d_ws, size_t ws_size, hipStream_t stream) {
    static int grid = 0;
    if (grid == 0) {
        if (n_in != 18 || in_sizes[0] != S * DM || out_size != S * DM || ws_size < WS_END) { fprintf(stderr, "kernel_launch: shape/workspace mismatch: n_in %d in0 %d out %d ws %zu (need %zu)\n", n_in, n_in > 0 ? in_sizes[0] : -1, out_size, ws_size, (size_t)WS_END); grid = -1; return; }
        int dev = 0, cus = 0, per_cu = 0;
        if (hipGetDevice(&dev) != hipSuccess || hipDeviceGetAttribute(&cus, hipDeviceAttributeMultiprocessorCount, dev) != hipSuccess) { grid = -1; return; }
        if (hipFuncSetAttribute((const void*)hybrid_fwd, hipFuncAttributeMaxDynamicSharedMemorySize, LDS_BYTES) != hipSuccess) { fprintf(stderr, "kernel_launch: hipFuncSetAttribute failed\n"); grid = -1; return; }
        if (hipOccupancyMaxActiveBlocksPerMultiprocessor(&per_cu, (const void*)hybrid_fwd, NWAVES * 64, LDS_BYTES) != hipSuccess || per_cu < 1) fprintf(stderr, "kernel_launch: occupancy query reports %d\n", per_cu);
        (void)hipGetLastError();
        grid = cus;
    }
    if (grid < 0) return;
    if (hipMemsetAsync((char*)d_ws + WS_CTL, 0, CTL_ZERO_BYTES, stream) != hipSuccess) return;
    Args a{};
    for (int i = 0; i < 18; ++i) a.in[i] = (const float*)d_in[i];
    a.out = (float*)d_out; a.ws = (unsigned char*)d_ws;
    hipLaunchKernelGGL(hybrid_fwd, dim3(grid), dim3(NWAVES * 64), LDS_BYTES, stream, a);
}
```
